# Optimizing an MI355X kernel written in HIP

```python
import math
import jax, jax.numpy as jnp
from jax import lax
import numpy as np

D_MODEL = 2048
BATCH = 4
SEQ = 2048
DEPTH = 1
DEC_BATCH = 8
DEC_SEQ = 8
PAST_LEN = 16384
PAGE_SIZE = 128

N_HEADS = 16
HEAD_DIM = 64
N_KV = 4
GROUP = N_HEADS // N_KV
CMP_LEN = 32
CMP_STRIDE = 16
SEL_BLOCK = 64
SEL_TOP = 16
WINDOW = 512
Q_CHUNK = 64
WIN_QBLK = 128
SSM_WIDTH = D_MODEL // 2
SSM_GROUP = 16
SSM_NGROUPS = SSM_WIDTH // SSM_GROUP
SSM_STATE = 64
D_FF = ((-(-8 * D_MODEL // 3)) + 255) // 256 * 256

Q_COLS = N_HEADS * HEAD_DIM
KV_COLS = N_KV * HEAD_DIM
IN_COLS = Q_COLS + 6 * KV_COLS + 3 * N_HEADS + SSM_WIDTH + 2 * D_MODEL
EPS = 1e-6
NEG = -1e30
FORCE_SCORE = 1e4

kernel_name = 'nsa_s5_gated_hybrid_step'


def _rmsnorm(x, g):
    xf = x.astype(jnp.float32)
    y = xf * lax.rsqrt(jnp.mean(xf * xf, axis=-1, keepdims=True) + EPS)
    return (y * g.astype(jnp.float32)).astype(x.dtype)


def _alibi_slopes():
    return jnp.exp2(-8.0 * jnp.arange(1, N_HEADS + 1, dtype=jnp.float32) / N_HEADS).reshape(N_KV, GROUP)


def _in_proj(x, g_mix, w_in):
    B, T = x.shape[:2]
    z = _rmsnorm(x, g_mix) @ w_in
    cuts = np.cumsum([Q_COLS, 6 * KV_COLS, 3 * N_HEADS, SSM_WIDTH]).tolist()
    q, kv, gt, u, mg = jnp.split(z, cuts, axis=-1)
    return (q.reshape(B, T, N_HEADS, HEAD_DIM),
            kv.reshape(B, T, 6, N_KV, HEAD_DIM),
            jax.nn.sigmoid(gt.reshape(B, T, 3, N_HEADS)),
            u,
            mg.reshape(B, T, 2, D_MODEL))


def _compress(x, pe, pool, phi):
    B, Tp = x.shape[:2]
    r = CMP_LEN // CMP_STRIDE
    nsub = Tp // CMP_STRIDE
    nc = nsub - r + 1
    sub = x.reshape(B, nsub, CMP_STRIDE, N_KV, HEAD_DIM)
    parts = jnp.einsum('bnsgd,ms->bmngd', sub, pool.reshape(r, CMP_STRIDE))
    pooled = parts[:, 0, :nc]
    for m in range(1, r):
        pooled = pooled + parts[:, m, m:m + nc]
    pooled = pooled + jnp.einsum('l,ld->d', pool, pe)
    return jax.nn.gelu(pooled) @ phi


def _cmp_sel_attend(q, q_pos, kv4, pe, pool, phi, slopes):
    B, Tq = q.shape[:2]
    Tk = kv4.shape[1]
    Tp = -(-Tk // SEL_BLOCK) * SEL_BLOCK
    kv4 = jnp.pad(kv4, ((0, 0), (0, Tp - Tk), (0, 0), (0, 0), (0, 0)))
    k_cmp = _compress(kv4[:, :, 0], pe[0], pool[0], phi[0])
    v_cmp = _compress(kv4[:, :, 1], pe[1], pool[1], phi[1])
    nc = k_cmp.shape[1]
    cmp_end = jnp.arange(nc, dtype=jnp.int32) * CMP_STRIDE + (CMP_LEN - 1)
    ns = Tp // SEL_BLOCK
    sel_start = jnp.arange(ns, dtype=jnp.int32) * SEL_BLOCK
    overlap = ((cmp_end[:, None] - (CMP_LEN - 1) < sel_start[None, :] + SEL_BLOCK)
               & (cmp_end[:, None] >= sel_start[None, :])).astype(jnp.float32)
    k_blk = kv4[:, :, 2].reshape(B, ns, SEL_BLOCK, N_KV, HEAD_DIM).transpose(0, 3, 1, 2, 4)
    v_blk = kv4[:, :, 3].reshape(B, ns, SEL_BLOCK, N_KV, HEAD_DIM).transpose(0, 3, 1, 2, 4)
    n_top = min(SEL_TOP, ns)
    scale = HEAD_DIM ** -0.5
    bi = jnp.arange(B)[:, None, None, None]
    gi = jnp.arange(N_KV)[None, :, None, None]
    blk_ids = jnp.arange(ns, dtype=jnp.int32)
    qc_len = math.gcd(Tq, Q_CHUNK)
    nch = Tq // qc_len

    def chunk(args):
        qc, pc = args
        qg = qc.reshape(B, qc_len, N_KV, GROUP, HEAD_DIM)
        s = jnp.einsum('bqgnd,bcgd->bgnqc', qg, k_cmp, preferred_element_type=jnp.float32) * scale
        dist = (pc[:, None] - cmp_end[None, :]).astype(jnp.float32)
        valid = cmp_end[None, :] <= pc[:, None]
        s = s - slopes[:, :, None, None] * dist
        p = jax.nn.softmax(jnp.where(valid, s, NEG), axis=-1) * valid
        o_c = jnp.einsum('bgnqc,bcgd->bqgnd', p.astype(v_cmp.dtype), v_cmp)
        imp = jnp.einsum('bgnqc,cs->bgqs', p, overlap)
        cur = pc // SEL_BLOCK
        forced = (blk_ids[None, :] == 0) | (blk_ids[None, :] == cur[:, None]) | (blk_ids[None, :] == cur[:, None] - 1)
        imp = jnp.where(forced, FORCE_SCORE, imp)
        imp = jnp.where(blk_ids[None, :] <= cur[:, None], imp, -1.0)
        _, idx = lax.top_k(imp, n_top)
        kg = k_blk[bi, gi, idx]
        vg = v_blk[bi, gi, idx]
        kpos = idx[..., None] * SEL_BLOCK + jnp.arange(SEL_BLOCK, dtype=jnp.int32)
        dsel = pc[None, None, :, None, None] - kpos
        s2 = jnp.einsum('bqgnd,bgqksd->bgnqks', qg, kg, preferred_element_type=jnp.float32) * scale
        s2 = s2 - slopes[None, :, :, None, None, None] * dsel[:, :, None].astype(jnp.float32)
        s2 = jnp.where(dsel[:, :, None] >= 0, s2, NEG)
        sh = s2.shape
        p2 = jax.nn.softmax(s2.reshape(*sh[:-2], -1), axis=-1).reshape(sh)
        o_s = jnp.einsum('bgnqks,bgqksd->bqgnd', p2.astype(vg.dtype), vg)
        return (o_c.reshape(B, qc_len, N_HEADS, HEAD_DIM), o_s.reshape(B, qc_len, N_HEADS, HEAD_DIM))

    qs = q.reshape(B, nch, qc_len, N_HEADS, HEAD_DIM).transpose(1, 0, 2, 3, 4)
    ps = q_pos.reshape(nch, qc_len)
    o_c, o_s = lax.map(chunk, (qs, ps))
    o_c = o_c.transpose(1, 0, 2, 3, 4).reshape(B, Tq, N_HEADS, HEAD_DIM)
    o_s = o_s.transpose(1, 0, 2, 3, 4).reshape(B, Tq, N_HEADS, HEAD_DIM)
    return o_c, o_s


def _window_attend(q, q_pos, kw, vw, k_pos, slopes):
    B, Tq = q.shape[:2]
    qg = q.reshape(B, Tq, N_KV, GROUP, HEAD_DIM)
    s = jnp.einsum('bqgnd,bkgd->bgnqk', qg, kw, preferred_element_type=jnp.float32) * (HEAD_DIM ** -0.5)
    dist = q_pos[:, None] - k_pos[None, :]
    valid = (dist >= 0) & (dist < WINDOW) & (k_pos[None, :] >= 0)
    s = s - slopes[:, :, None, None] * dist.astype(jnp.float32)
    p = jax.nn.softmax(jnp.where(valid, s, NEG), axis=-1)
    o = jnp.einsum('bgnqk,bkgd->bqgnd', p.astype(vw.dtype), vw)
    return o.reshape(B, Tq, N_HEADS, HEAD_DIM)


def _window_prompt(q, kvw, slopes):
    B, T = q.shape[:2]
    kpad = jnp.pad(kvw, ((0, 0), (WINDOW, 0), (0, 0), (0, 0), (0, 0)))
    span = WINDOW + WIN_QBLK

    def blk(i):
        q0 = i * WIN_QBLK
        qb = lax.dynamic_slice_in_dim(q, q0, WIN_QBLK, axis=1)
        kb = lax.dynamic_slice_in_dim(kpad, q0, span, axis=1)
        qpos = q0 + jnp.arange(WIN_QBLK, dtype=jnp.int32)
        kpos = q0 - WINDOW + jnp.arange(span, dtype=jnp.int32)
        return _window_attend(qb, qpos, kb[:, :, 0], kb[:, :, 1], kpos, slopes)

    o = lax.map(blk, jnp.arange(T // WIN_QBLK, dtype=jnp.int32))
    return o.transpose(1, 0, 2, 3, 4).reshape(B, T, N_HEADS, HEAD_DIM)


def _cplx_affine_combine(e1, e2):
    a1r, a1i, b1r, b1i = e1
    a2r, a2i, b2r, b2i = e2
    return (a2r * a1r - a2i * a1i, a2r * a1i + a2i * a1r,
            a2r * b1r - a2i * b1i + b2r, a2r * b1i + a2i * b1r + b2i)


def _ssm_scan(u, h0_re, h0_im, lam_re, lam_im, log_dt, b_re, b_im, c_re, c_im, d_skip):
    f32 = jnp.float32
    B, T = u.shape[:2]
    uf = u.astype(f32).reshape(B, T, SSM_NGROUPS, SSM_GROUP)
    dt = jnp.exp(log_dt.astype(f32))[:, None]
    lr = lam_re.astype(f32)
    li = lam_im.astype(f32)
    mag = jnp.exp(lr * dt)
    ar = mag * jnp.cos(li * dt)
    ai = mag * jnp.sin(li * dt)
    den = lr * lr + li * li
    fr = ((ar - 1.0) * lr + ai * li) / den
    fi = (ai * lr - (ar - 1.0) * li) / den
    br = b_re.astype(f32)
    bim = b_im.astype(f32)
    bbr = fr[..., None] * br - fi[..., None] * bim
    bbi = fr[..., None] * bim + fi[..., None] * br
    xr = jnp.einsum('btgc,gpc->btgp', uf, bbr)
    xi = jnp.einsum('btgc,gpc->btgp', uf, bbi)
    xr = jnp.concatenate([h0_re.astype(f32)[:, None], xr], axis=1)
    xi = jnp.concatenate([h0_im.astype(f32)[:, None], xi], axis=1)
    a_r = jnp.broadcast_to(ar, xr.shape)
    a_i = jnp.broadcast_to(ai, xr.shape)
    _, _, hr, hi = lax.associative_scan(_cplx_affine_combine, (a_r, a_i, xr, xi), axis=1)
    hr = hr[:, 1:]
    hi = hi[:, 1:]
    y = (jnp.einsum('btgp,gcp->btgc', hr, c_re.astype(f32))
         - jnp.einsum('btgp,gcp->btgc', hi, c_im.astype(f32))
         + d_skip.astype(f32).reshape(SSM_NGROUPS, SSM_GROUP) * uf)
    return y.reshape(B, T, SSM_WIDTH).astype(u.dtype), hr[:, -1], hi[:, -1]


def _merge_ffn(x, o_heads, y_ssm, mg, w_attn_out, w_glu, w_out, g_ffn, w_gate, w_up, w_down):
    B, T = x.shape[:2]
    ya = o_heads.reshape(B, T, Q_COLS) @ w_attn_out
    yg = jax.nn.gelu(y_ssm) @ w_glu
    yb = yg[..., :D_MODEL] * jax.nn.sigmoid(yg[..., D_MODEL:])
    m = jax.nn.sigmoid(mg[:, :, 0]) * ya + jax.nn.sigmoid(mg[:, :, 1]) * yb
    x = x + m @ w_out
    h = _rmsnorm(x, g_ffn)
    return x + (jax.nn.silu(h @ w_gate) * (h @ w_up)) @ w_down


def _layer_prompt(x, lw, slopes):
    (g_mix, w_in, pe, pool, phi, w_attn_out, lam_re, lam_im, log_dt, b_re, b_im, c_re, c_im,
     d_skip, w_glu, w_out, g_ffn, w_gate, w_up, w_down) = lw
    B, T = x.shape[:2]
    q, kv, gates, u, mg = _in_proj(x, g_mix, w_in)
    pos = jnp.arange(T, dtype=jnp.int32)
    o_c, o_s = _cmp_sel_attend(q, pos, kv[:, :, :4], pe, pool, phi, slopes)
    o_w = _window_prompt(q, kv[:, :, 4:], slopes)
    o = gates[:, :, 0, :, None] * o_c + gates[:, :, 1, :, None] * o_s + gates[:, :, 2, :, None] * o_w
    h0 = jnp.zeros((B, SSM_NGROUPS, SSM_STATE), jnp.float32)
    y_ssm, h_re, h_im = _ssm_scan(u, h0, h0, lam_re, lam_im, log_dt, b_re, b_im, c_re, c_im, d_skip)
    y = _merge_ffn(x, o, y_ssm, mg, w_attn_out, w_glu, w_out, g_ffn, w_gate, w_up, w_down)
    n_win = min(WINDOW, T)
    return y, kv[:, :, :4], kv[:, T - n_win:, 4:], h_re, h_im


def _layer_sample(x, kv_past, win_buf, h_re, h_im, lw, slopes):
    (g_mix, w_in, pe, pool, phi, w_attn_out, lam_re, lam_im, log_dt, b_re, b_im, c_re, c_im,
     d_skip, w_glu, w_out, g_ffn, w_gate, w_up, w_down) = lw
    B, T = x.shape[:2]
    past_len = kv_past.shape[1]
    q, kv, gates, u, mg = _in_proj(x, g_mix, w_in)
    pos = past_len + jnp.arange(T, dtype=jnp.int32)
    kv4 = jnp.concatenate([kv_past, kv[:, :, :4].astype(kv_past.dtype)], axis=1)
    o_c, o_s = _cmp_sel_attend(q, pos, kv4, pe, pool, phi, slopes)
    n_buf = win_buf.shape[1]
    kvw = jnp.concatenate([win_buf, kv[:, :, 4:].astype(win_buf.dtype)], axis=1)
    kpos = past_len - n_buf + jnp.arange(n_buf + T, dtype=jnp.int32)
    o_w = _window_attend(q, pos, kvw[:, :, 0], kvw[:, :, 1], kpos, slopes)
    o = gates[:, :, 0, :, None] * o_c + gates[:, :, 1, :, None] * o_s + gates[:, :, 2, :, None] * o_w
    y_ssm, hr, hi = _ssm_scan(u, h_re, h_im, lam_re, lam_im, log_dt, b_re, b_im, c_re, c_im, d_skip)
    y = _merge_ffn(x, o, y_ssm, mg, w_attn_out, w_glu, w_out, g_ffn, w_gate, w_up, w_down)
    n_keep = min(WINDOW, n_buf + T)
    return y, kv[:, :, :4], kvw[:, n_buf + T - n_keep:], hr, hi


def setup_inputs(seed: int = 0) -> dict:
    key = jax.random.key(seed)
    ks = iter(jax.random.split(key, 32))
    f32 = jnp.float32

    def nrm(shape, s=1.0):
        return jax.random.normal(next(ks), shape, f32) * s

    L = DEPTH
    n_pages = PAST_LEN // PAGE_SIZE
    n_pool = (DEC_BATCH * n_pages * 5) // 4
    n_win = min(WINDOW, PAST_LEN)
    x_prompt = nrm((BATCH, SEQ, D_MODEL))
    x_sample = nrm((DEC_BATCH, DEC_SEQ, D_MODEL))
    cache_kv = nrm((L, n_pool, PAGE_SIZE, 4, N_KV, HEAD_DIM))
    state_win = nrm((L, DEC_BATCH, n_win, 2, N_KV, HEAD_DIM))
    state_ssm_re = nrm((L, DEC_BATCH, SSM_NGROUPS, SSM_STATE), 0.1)
    state_ssm_im = nrm((L, DEC_BATCH, SSM_NGROUPS, SSM_STATE), 0.1)
    perm = jax.random.permutation(next(ks), n_pool)
    page_table = perm[:DEC_BATCH * n_pages].reshape(DEC_BATCH, n_pages).astype(jnp.int32)
    g_mix = 1.0 + nrm((L, D_MODEL), 0.01)
    w_in = nrm((L, D_MODEL, IN_COLS), D_MODEL ** -0.5)
    w_cmp_pe = nrm((L, 2, CMP_LEN, HEAD_DIM), 0.1)
    w_cmp_pool = (1.0 + nrm((L, 2, CMP_LEN), 0.1)) * CMP_LEN ** -0.5
    w_cmp_phi = nrm((L, 2, HEAD_DIM, HEAD_DIM), HEAD_DIM ** -0.5)
    w_attn_out = nrm((L, Q_COLS, D_MODEL), Q_COLS ** -0.5)
    ssm_lam_re = -0.5 + nrm((L, SSM_NGROUPS, SSM_STATE), 0.01)
    ssm_lam_im = jnp.pi * jnp.arange(SSM_STATE, dtype=f32) + nrm((L, SSM_NGROUPS, SSM_STATE), 0.01)
    ssm_log_dt = jax.random.uniform(next(ks), (L, SSM_NGROUPS), f32, math.log(1e-3), math.log(1e-1))
    ssm_b_re = nrm((L, SSM_NGROUPS, SSM_STATE, SSM_GROUP), (2.0 * SSM_GROUP) ** -0.5)
    ssm_b_im = nrm((L, SSM_NGROUPS, SSM_STATE, SSM_GROUP), (2.0 * SSM_GROUP) ** -0.5)
    ssm_c_re = nrm((L, SSM_NGROUPS, SSM_GROUP, SSM_STATE), (2.0 * SSM_STATE) ** -0.5)
    ssm_c_im = nrm((L, SSM_NGROUPS, SSM_GROUP, SSM_STATE), (2.0 * SSM_STATE) ** -0.5)
    ssm_d = nrm((L, SSM_WIDTH))
    w_glu = nrm((L, SSM_WIDTH, 2 * D_MODEL), SSM_WIDTH ** -0.5)
    w_out = nrm((L, D_MODEL, D_MODEL), D_MODEL ** -0.5)
    g_ffn = 1.0 + nrm((L, D_MODEL), 0.01)
    w_gate = nrm((L, D_MODEL, D_FF), D_MODEL ** -0.5)
    w_up = nrm((L, D_MODEL, D_FF), D_MODEL ** -0.5)
    w_down = nrm((L, D_FF, D_MODEL), D_FF ** -0.5)
    g_final = 1.0 + nrm((D_MODEL,), 0.01)
    return {'x_prompt': x_prompt, 'x_sample': x_sample, 'cache_kv': cache_kv, 'state_win': state_win,
            'state_ssm_re': state_ssm_re, 'state_ssm_im': state_ssm_im, 'page_table': page_table,
            'g_mix': g_mix, 'w_in': w_in, 'w_cmp_pe': w_cmp_pe, 'w_cmp_pool': w_cmp_pool, 'w_cmp_phi': w_cmp_phi,
            'w_attn_out': w_attn_out, 'ssm_lam_re': ssm_lam_re, 'ssm_lam_im': ssm_lam_im, 'ssm_log_dt': ssm_log_dt,
            'ssm_b_re': ssm_b_re, 'ssm_b_im': ssm_b_im, 'ssm_c_re': ssm_c_re, 'ssm_c_im': ssm_c_im, 'ssm_d': ssm_d,
            'w_glu': w_glu, 'w_out': w_out, 'g_ffn': g_ffn, 'w_gate': w_gate, 'w_up': w_up, 'w_down': w_down,
            'g_final': g_final}


def reference(x_prompt, x_sample, cache_kv, state_win, state_ssm_re, state_ssm_im, page_table,
              g_mix, w_in, w_cmp_pe, w_cmp_pool, w_cmp_phi, w_attn_out, ssm_lam_re, ssm_lam_im, ssm_log_dt,
              ssm_b_re, ssm_b_im, ssm_c_re, ssm_c_im, ssm_d, w_glu, w_out, g_ffn, w_gate, w_up, w_down, g_final):
    slopes = _alibi_slopes()
    n_seq, n_pages = page_table.shape
    page = cache_kv.shape[2]
    xp, xs = x_prompt, x_sample
    kvp_l, winp_l, hrp_l, hip_l = [], [], [], []
    kvs_l, wins_l, hrs_l, his_l = [], [], [], []
    for l in range(DEPTH):
        lw = (g_mix[l], w_in[l], w_cmp_pe[l], w_cmp_pool[l], w_cmp_phi[l], w_attn_out[l],
              ssm_lam_re[l], ssm_lam_im[l], ssm_log_dt[l], ssm_b_re[l], ssm_b_im[l], ssm_c_re[l], ssm_c_im[l],
              ssm_d[l], w_glu[l], w_out[l], g_ffn[l], w_gate[l], w_up[l], w_down[l])
        xp, kvp, winp, hrp, hip = _layer_prompt(xp, lw, slopes)
        kv_past = cache_kv[l][page_table].reshape(n_seq, n_pages * page, 4, N_KV, HEAD_DIM)
        xs, kvs, wins, hrs, his = _layer_sample(xs, kv_past, state_win[l], state_ssm_re[l], state_ssm_im[l], lw, slopes)
        kvp_l.append(kvp); winp_l.append(winp); hrp_l.append(hrp); hip_l.append(hip)
        kvs_l.append(kvs); wins_l.append(wins); hrs_l.append(hrs); his_l.append(his)
    y_prompt = _rmsnorm(xp, g_final)
    y_sample = _rmsnorm(xs, g_final)
    kv_rows_prompt = jnp.stack(kvp_l)
    win_prompt = jnp.stack(winp_l)
    ssm_re_prompt = jnp.stack(hrp_l)
    ssm_im_prompt = jnp.stack(hip_l)
    kv_rows_sample = jnp.stack(kvs_l)
    win_sample = jnp.stack(wins_l)
    ssm_re_sample = jnp.stack(hrs_l)
    ssm_im_sample = jnp.stack(his_l)
    return (y_prompt, y_sample, kv_rows_prompt, win_prompt, ssm_re_prompt, ssm_im_prompt,
            kv_rows_sample, win_sample, ssm_re_sample, ssm_im_sample)
```

```cpp
#include <hip/hip_runtime.h>
#include <hip/hip_bf16.h>
#include <cstdio>
#include <cstdint>
#define MK_N_LAUNCHES 10

constexpr int D_MODEL = 2048, BATCH = 4, SEQ = 2048, DEC_B = 8, DEC_T = 8, PAST = 16384, PAGE = 128, NPAGES = PAST / PAGE;
constexpr int NH = 16, HD = 64, NKV = 4, GRP = 4;
constexpr int SSM_W = 1024, SSM_NG = 64, SSM_P = 64, SSM_C = 16;
constexpr int DFF = 5632;
constexpr int MP = BATCH * SEQ, MS = DEC_B * DEC_T, MROWS = MP + MS, MPAD = 8448;
constexpr int IN_COLS = 7728, NIN = 7936;
constexpr int NC_P = 127, NCP_P = 128, NC_S = 1023, NCP_S = 1024;
constexpr float EPS = 1e-6f;
constexpr size_t O_YP = 0, O_YS = 16777216, O_KVP = 16908288, O_WINP = 25296896, O_HRP = 26345472, O_HIP = 26361856, O_KVS = 26378240, O_WINS = 26443776, O_HRS = 28540928, O_HIS = 28573696;
constexpr size_t al256(size_t x) { return (x + 255) & ~(size_t)255; }
constexpr size_t WS_CTL = 0, CTL_ZERO_BYTES = 1u << 20;
constexpr int CW_TMO = 0, CW_BAR = 4096, CW_SS2 = 65536, CW_SS3 = 81920;
constexpr size_t WS_WIN = CTL_ZERO_BYTES;
constexpr size_t WS_WA = WS_WIN + al256((size_t)NIN * 2048 * 2);
constexpr size_t WS_WGLU = WS_WA + al256((size_t)2048 * 1024 * 2);
constexpr size_t WS_WOUT = WS_WGLU + al256((size_t)4096 * 1024 * 2);
constexpr size_t WS_WGU = WS_WOUT + al256((size_t)2048 * 2048 * 2);
constexpr size_t WS_WDN = WS_WGU + al256((size_t)2 * DFF * 2048 * 2);
constexpr size_t WS_XN = WS_WDN + al256((size_t)2048 * DFF * 2);
constexpr size_t WS_RSTD1 = WS_XN + al256((size_t)MPAD * 2048 * 2);
constexpr size_t WS_QB = WS_RSTD1 + al256((size_t)MPAD * 4);
constexpr size_t WS_KVB = WS_QB + al256((size_t)MPAD * 1024 * 2);
constexpr size_t WS_U = WS_KVB + al256((size_t)MPAD * 1536 * 2);
constexpr size_t WS_MG = WS_U + al256((size_t)MPAD * 1024 * 4);
constexpr size_t WS_GT = WS_MG + al256((size_t)MPAD * 4096 * 2);
constexpr size_t WS_KCP = WS_GT + al256((size_t)MPAD * 64 * 4);
constexpr size_t WS_KCS = WS_KCP + al256((size_t)BATCH * NCP_P * 512 * 4);
constexpr size_t WS_GY = WS_KCS + al256((size_t)DEC_B * NCP_S * 512 * 4);
constexpr size_t WS_OB = WS_GY + al256((size_t)MPAD * 1024 * 2);
constexpr size_t WS_MB = WS_OB + al256((size_t)MPAD * 1024 * 2);
constexpr size_t WS_X2 = WS_MB + al256((size_t)MPAD * 2048 * 2);
constexpr size_t WS_HH = WS_X2 + al256((size_t)MPAD * 2048 * 4);
constexpr size_t WS_Y = WS_HH + al256((size_t)MPAD * DFF * 2);
constexpr size_t WS_END = WS_Y + al256((size_t)MPAD * 2048 * 4);
namespace pg8 {
#define PG8_LAS __attribute__((address_space(3)))
typedef unsigned short bf16_t;
typedef short bf16x8 __attribute__((ext_vector_type(8)));
typedef float f32x4 __attribute__((ext_vector_type(4)));
typedef unsigned u32x4 __attribute__((ext_vector_type(4)));
constexpr int BM = 256, BK = 64, HALF = 128, HTB = HALF * BK * 2  , STAGE_BYTES = 8 * HTB, NXCD = 8, WGM = 8;

__host__ __device__ __forceinline__ int lds_byte(int r, int c) { const int st = (r >> 4) * 2 + (c >> 5), rr = r & 15, cc = c & 31, ob = rr * 64 + cc * 2; return st * 1024 + (ob ^ (((ob >> 9) & 1) << 5)); }
__host__ __device__ __forceinline__ void stage_rc(int b, int& R, int& C) { const int st = b / 1024, sb = b % 1024, swz = sb ^ (((sb >> 9) & 1) << 5); R = (st >> 1) * 16 + swz / 64; C = (st & 1) * 32 + (swz % 64) / 2; }
__host__ __device__ __forceinline__ int perm32(int rho) { const int n = rho >> 4, i = rho & 15; return 8 * (i >> 2) + 4 * n + (i & 3); }

struct Unit { int pm, pn; };
struct Gemm { const bf16_t* A; const bf16_t* Bt; int M, N, K; };

struct StaticOrder {
    int nM, nN, nwg, G, c;
    __host__ __device__ void init(int M, int N, int G_, int c_) { nM = M / BM; nN = N / BM; nwg = nM * nN; G = G_; c = c_; }
    __host__ __device__ bool next(int i, Unit& u) const {
        const long L = (long)i * G + c; if (L >= nwg) return false;
        int wgid = (int)L; { const int q = nwg / NXCD, r = nwg % NXCD, xcd = wgid % NXCD, off = wgid / NXCD; wgid = (xcd < r ? xcd * (q + 1) : r * (q + 1) + (xcd - r) * q) + off; }
        const int nig = WGM * nN, gid = wgid / nig, fm = gid * WGM, gsz = (nM - fm) < WGM ? (nM - fm) : WGM;
        u.pm = fm + ((wgid % nig) % gsz); u.pn = (wgid % nig) / gsz; return true;
    }
    __device__ __forceinline__ void a_ready(const Unit&) const {}
    __device__ __forceinline__ void done(const Unit&) const {}
};

typedef float f32x2_cv __attribute__((ext_vector_type(2))); typedef __bf16 bf16x2_cv __attribute__((ext_vector_type(2)));
__device__ __forceinline__ unsigned cvt_pk_bf16(float lo, float hi) { f32x2_cv v = {lo, hi}; bf16x2_cv b = __builtin_convertvector(v, bf16x2_cv); return __builtin_bit_cast(unsigned, b); }
template <class Epi, class Sched, bool ALIGN_EPI = false, bool SP2 = false>
__device__ __forceinline__ void gemm_phase(PG8_LAS unsigned char* lds, const Gemm g, const Sched& S, const Epi& E) {
    const int tid = threadIdx.x, wid = __builtin_amdgcn_readfirstlane(tid >> 6), lane = tid & 63, wr = wid >> 2, wc = wid & 3, fr = lane & 15, fq = lane >> 4;
    const int K = g.K, nt = K / BK;
    unsigned voffA[2], voffB[2];
#pragma unroll
    for (int i = 0; i < 2; ++i) { int R, C; stage_rc(tid * 16 + i * 8192, R, C); const int Rb = Epi::PERM ? ((R & ~31) + perm32(R & 31)) : R;
        voffA[i] = (unsigned)(R * K + C) * 2u; voffB[i] = (unsigned)(Rb * K + C) * 2u; }
    const size_t kstep = (size_t)(BK * 2);
    const size_t hstep = (size_t)HALF * K * 2;
    const size_t tstep = 2 * hstep;
    const unsigned ldsw = (unsigned)wid * 1024u;
    const int aoff = lds_byte(wr * 64 + fr, fq * 8), boff = lds_byte(wc * 32 + fr, fq * 8);
#define PG8_SA(b, h) (((b) * 2 + (h)) * HTB)
#define PG8_SB(b, h) ((4 + (b) * 2 + (h)) * HTB)
#define PG8_STAGE(bufoff, gbase, voff) do { _Pragma("unroll") for (int _i = 0; _i < 2; ++_i) \
        __builtin_amdgcn_global_load_lds((const unsigned*)((const char*)(gbase) + (voff)[_i]), (PG8_LAS unsigned*)(lds + (bufoff) + ldsw + _i * 8192), 16, 0, 0); } while (0)
#define PG8_LDA(dst, b, h) do { _Pragma("unroll") for (int m = 0; m < 4; ++m) _Pragma("unroll") for (int k = 0; k < 2; ++k) dst[m][k] = *(const PG8_LAS bf16x8*)(lds + PG8_SA(b, h) + aoff + m * 2048 + k * 1024); } while (0)
#define PG8_LDB(dst, b, h) do { _Pragma("unroll") for (int n = 0; n < 2; ++n) _Pragma("unroll") for (int k = 0; k < 2; ++k) dst[n][k] = *(const PG8_LAS bf16x8*)(lds + PG8_SB(b, h) + boff + n * 2048 + k * 1024); } while (0)
#define PG8_MMA(ai, bj, At, Bt) do { __builtin_amdgcn_s_setprio(1); _Pragma("unroll") for (int m = 0; m < 4; ++m) _Pragma("unroll") for (int n = 0; n < 2; ++n) _Pragma("unroll") for (int k = 0; k < 2; ++k) \
        acc[ai][bj][m][n] = __builtin_amdgcn_mfma_f32_16x16x32_bf16(Bt[n][k], At[m][k], acc[ai][bj][m][n], 0, 0, 0); __builtin_amdgcn_s_setprio(0); } while (0)
#define PG8_WAIT_V(n) asm volatile("s_waitcnt vmcnt(" #n ")" ::: "memory")
#define PG8_WAIT_L(n) asm volatile("s_waitcnt lgkmcnt(" #n ")" ::: "memory")
#define PG8_BAR __builtin_amdgcn_s_barrier()
#define PG8_SCHED __builtin_amdgcn_sched_barrier(0)
    Unit cur, nxt; int ui = 0;
    if (!S.next(0, cur)) return;
    f32x4 acc[2][2][4][2];
#pragma unroll
    for (int a = 0; a < 2; ++a)
#pragma unroll
        for (int b = 0; b < 2; ++b)
#pragma unroll
            for (int m = 0; m < 4; ++m)
#pragma unroll
                for (int n = 0; n < 2; ++n) acc[a][b][m][n] = (f32x4){0.f, 0.f, 0.f, 0.f};
    bf16x8 At[4][2], B0[2][2], B1[2][2];
    const char* cA = (const char*)g.A + (size_t)cur.pm * tstep; const char* cB = (const char*)g.Bt + (size_t)cur.pn * tstep;
    S.a_ready(cur);
    if constexpr (SP2) {
        PG8_STAGE(PG8_SB(0, 0), cB, voffB); PG8_STAGE(PG8_SB(0, 1), cB + hstep, voffB); PG8_STAGE(PG8_SA(0, 0), cA, voffA); PG8_STAGE(PG8_SA(0, 1), cA + hstep, voffA);
        if (wr == 1) PG8_BAR;
        PG8_WAIT_V(2); PG8_BAR;
        PG8_STAGE(PG8_SB(1, 0), cB + kstep, voffB); PG8_STAGE(PG8_SA(1, 0), cA + kstep, voffA); PG8_STAGE(PG8_SB(1, 1), cB + hstep + kstep, voffB);
        PG8_WAIT_V(6); PG8_BAR;
    } else {
        PG8_STAGE(PG8_SB(0, 0), cB, voffB); PG8_STAGE(PG8_SA(0, 0), cA, voffA); PG8_STAGE(PG8_SB(0, 1), cB + hstep, voffB); PG8_STAGE(PG8_SA(0, 1), cA + hstep, voffA);
        if (wr == 1) PG8_BAR;
        PG8_WAIT_V(4); PG8_BAR;
        PG8_STAGE(PG8_SB(1, 0), cB + kstep, voffB); PG8_STAGE(PG8_SA(1, 0), cA + kstep, voffA); PG8_STAGE(PG8_SB(1, 1), cB + hstep + kstep, voffB);
        PG8_WAIT_V(6); PG8_BAR;
    }
    for (;;) {
        const bool has_next = S.next(ui + 1, nxt);
        const char* nA = has_next ? (const char*)g.A + (size_t)nxt.pm * tstep : cA; const char* nB = has_next ? (const char*)g.Bt + (size_t)nxt.pn * tstep : cB;
        for (int t = 0; t < nt; t += 2) {
            const bool last = (t == nt - 2);
            const char* a1 = cA + (size_t)(t + 1) * kstep;
            const char* a2 = last ? nA : cA + (size_t)(t + 2) * kstep; const char* b2 = last ? nB : cB + (size_t)(t + 2) * kstep;
            const char* a3 = a2 + kstep; const char* b3 = b2 + kstep;
            if (last && has_next) S.a_ready(nxt);
            if constexpr (SP2) {
            PG8_LDB(B0, 0, 0); PG8_LDB(B1, 0, 1); PG8_SCHED; PG8_LDA(At, 0, 0); PG8_STAGE(PG8_SA(1, 1), a1 + hstep, voffA);
            PG8_WAIT_V(8); PG8_WAIT_L(0); PG8_BAR; PG8_MMA(0, 0, At, B0); PG8_MMA(0, 1, At, B1); PG8_BAR; PG8_SCHED;
            PG8_LDA(At, 0, 1); PG8_STAGE(PG8_SB(0, 0), b2, voffB); PG8_STAGE(PG8_SB(0, 1), b2 + hstep, voffB); PG8_STAGE(PG8_SA(0, 0), a2, voffA);
            PG8_WAIT_V(8); PG8_WAIT_L(0); PG8_BAR; PG8_MMA(1, 0, At, B0); PG8_MMA(1, 1, At, B1); PG8_BAR; PG8_SCHED;
            PG8_LDB(B0, 1, 0); PG8_LDB(B1, 1, 1); PG8_SCHED; PG8_LDA(At, 1, 0); PG8_STAGE(PG8_SA(0, 1), a2 + hstep, voffA);
            PG8_WAIT_V(8); PG8_WAIT_L(0); PG8_BAR; PG8_MMA(0, 0, At, B0); PG8_MMA(0, 1, At, B1); PG8_BAR; PG8_SCHED;
            PG8_LDA(At, 1, 1); PG8_STAGE(PG8_SB(1, 0), b3, voffB); PG8_STAGE(PG8_SB(1, 1), b3 + hstep, voffB); PG8_STAGE(PG8_SA(1, 0), a3, voffA);
            PG8_WAIT_V(8); PG8_WAIT_L(0); PG8_BAR; PG8_MMA(1, 0, At, B0); PG8_MMA(1, 1, At, B1); PG8_BAR; PG8_SCHED;
            } else {
            PG8_LDB(B0, 0, 0); PG8_SCHED; PG8_LDA(At, 0, 0); PG8_STAGE(PG8_SA(1, 1), a1 + hstep, voffA);
            PG8_WAIT_L(8); PG8_BAR; PG8_WAIT_L(0); PG8_MMA(0, 0, At, B0); PG8_BAR; PG8_SCHED;
            PG8_LDB(B1, 0, 1); PG8_STAGE(PG8_SB(0, 0), b2, voffB);
            PG8_BAR; PG8_WAIT_L(0); PG8_MMA(0, 1, At, B1); PG8_BAR;
            PG8_LDA(At, 0, 1); PG8_STAGE(PG8_SA(0, 0), a2, voffA);
            PG8_BAR; PG8_WAIT_L(0); PG8_MMA(1, 0, At, B0); PG8_BAR; PG8_SCHED;
            PG8_STAGE(PG8_SB(0, 1), b2 + hstep, voffB);
            PG8_WAIT_V(6); PG8_BAR; PG8_MMA(1, 1, At, B1); PG8_BAR;
            PG8_LDB(B0, 1, 0); PG8_SCHED; PG8_LDA(At, 1, 0); PG8_STAGE(PG8_SA(0, 1), a2 + hstep, voffA);
            PG8_WAIT_L(8); PG8_BAR; PG8_WAIT_L(0); PG8_MMA(0, 0, At, B0); PG8_BAR; PG8_SCHED;
            PG8_LDB(B1, 1, 1); PG8_STAGE(PG8_SB(1, 0), b3, voffB);
            PG8_BAR; PG8_WAIT_L(0); PG8_MMA(0, 1, At, B1); PG8_BAR;
            PG8_LDA(At, 1, 1); PG8_STAGE(PG8_SA(1, 0), a3, voffA);
            PG8_BAR; PG8_WAIT_L(0); PG8_MMA(1, 0, At, B0); PG8_BAR; PG8_SCHED;
            PG8_STAGE(PG8_SB(1, 1), b3 + hstep, voffB);
            PG8_WAIT_V(6); PG8_BAR; PG8_MMA(1, 1, At, B1); PG8_BAR;
            }
        }
        if constexpr (ALIGN_EPI) { if (wr == 0) PG8_BAR; }
        if constexpr (!Epi::AFTER_DRAIN) { E(acc, cur, wr, wc, fr, fq); S.done(cur); }
        if (!has_next) break;
#pragma unroll
        for (int a = 0; a < 2; ++a)
#pragma unroll
            for (int b = 0; b < 2; ++b)
#pragma unroll
                for (int m = 0; m < 4; ++m)
#pragma unroll
                    for (int n = 0; n < 2; ++n) acc[a][b][m][n] = (f32x4){0.f, 0.f, 0.f, 0.f};
        cur = nxt; cA = nA; cB = nB; ++ui;
        if constexpr (ALIGN_EPI) { if (wr == 1) PG8_BAR; }
    }
    PG8_WAIT_V(0);
    if constexpr (!ALIGN_EPI) { if (wr == 0) PG8_BAR; }
    PG8_BAR;
    if constexpr (Epi::AFTER_DRAIN) { E.fused(acc, cur, wr, wc, fr, fq, lds, wid, lane); S.done(cur); }
#undef PG8_SA
#undef PG8_SB
#undef PG8_STAGE
#undef PG8_LDA
#undef PG8_LDB
#undef PG8_MMA
#undef PG8_WAIT_V
#undef PG8_WAIT_L
#undef PG8_BAR
#undef PG8_SCHED
}
}
#define GAS __attribute__((address_space(1)))
#define LAS __attribute__((address_space(3)))
typedef unsigned short bf16;
typedef unsigned v4u __attribute__((ext_vector_type(4)));
typedef float f32x4 __attribute__((ext_vector_type(4)));
typedef short bf16x8 __attribute__((ext_vector_type(8)));
typedef GAS unsigned gu32;
typedef GAS unsigned long long gu64;
#define RLX_AGENT __ATOMIC_RELAXED, __HIP_MEMORY_SCOPE_AGENT
#define LDS_WAIT() asm volatile("s_waitcnt lgkmcnt(0)" ::: "memory")
#define VM_WAIT() asm volatile("s_waitcnt vmcnt(0)" ::: "memory")
__device__ __forceinline__ unsigned long long rt() { return __builtin_amdgcn_s_memrealtime(); }
__device__ __forceinline__ unsigned f2bf(float f) { unsigned u = __builtin_bit_cast(unsigned, f); return (u + 0x7fffu + ((u >> 16) & 1u)) >> 16; }
__device__ __forceinline__ unsigned pk2(float lo, float hi) { return f2bf(lo) | (f2bf(hi) << 16); }

#define XB_TMO      128
#define XB_XCNT(j)  (256  + 64 * (j))
#define XB_XSUB(j)  (1280 + 64 * (j))
#define XB_XGEN(j)  (2304 + 64 * (j))
#define XB_TOP      3328
#define XB_TOPGEN   3392
#define XCD_BAR_WORDS 3456
#define XB_SPIN_CAP (1u << 18)

__device__ __forceinline__ unsigned xb_ld(unsigned* p)              { return __hip_atomic_load(p, __ATOMIC_RELAXED, __HIP_MEMORY_SCOPE_AGENT); }
__device__ __forceinline__ unsigned xb_add(unsigned* p, unsigned v) { return __hip_atomic_fetch_add(p, v, __ATOMIC_RELAXED, __HIP_MEMORY_SCOPE_AGENT); }
__device__ __forceinline__ unsigned xb_xcc_id() { return (unsigned)__builtin_amdgcn_s_getreg((3 << 11) | 20) & 0xFu; }
#define XB_SPIN(cond, bar) do { unsigned _sp = 0; while (cond) { __builtin_amdgcn_s_sleep(1); \
    if ((++_sp & 255u) == 0u) { if (xb_ld(&(bar)[XB_TMO])) break; if (_sp > XB_SPIN_CAP) { atomicAdd(&(bar)[XB_TMO], 1u); break; } } } } while (0)

struct XcdBarrier {
    unsigned* bar; unsigned x;
    volatile LAS unsigned* st;
};

__device__ __forceinline__ XcdBarrier xcd_barrier_post(unsigned* bar, volatile LAS unsigned* st) {
    XcdBarrier b; b.bar = bar; b.x = xb_xcc_id(); b.st = st;
    if (threadIdx.x == 0) (void)xb_add(&bar[XB_XCNT(b.x)], 1u);
    return b;
}
__device__ __forceinline__ void xcd_barrier_complete(unsigned* bar, unsigned x, unsigned& nloc, unsigned& nx) {
    const unsigned G = gridDim.x * gridDim.y * gridDim.z;
    unsigned sum, cnt, mine, sp = 0u;
    for (;;) {
        sum = 0u; cnt = 0u; mine = 0u;
#pragma unroll
        for (unsigned j = 0; j < 16; ++j) { const unsigned c = xb_ld(&bar[XB_XCNT(j)]); sum += c; cnt += (c > 0u) ? 1u : 0u; mine = (j == x) ? c : mine; }
        if (sum == G) break;
        __builtin_amdgcn_s_sleep(1);
        if ((++sp & 255u) == 0u) { if (xb_ld(&bar[XB_TMO])) break; if (sp > XB_SPIN_CAP) { atomicAdd(&bar[XB_TMO], 1u); break; } }
    }
    nloc = mine > 0u ? mine : 1u; nx = cnt > 0u ? cnt : 1u;
}

__device__ __forceinline__ void xcd_barrier(const XcdBarrier& b) {
    asm volatile("s_waitcnt vmcnt(0)" ::: "memory");
    __syncthreads();
    if (threadIdx.x == 0) {
        unsigned* bar = b.bar;
        __builtin_amdgcn_s_waitcnt(0);
        unsigned nloc = b.st[0], nx = b.st[1];
        if (nloc == 0u) { xcd_barrier_complete(bar, b.x, nloc, nx); b.st[0] = nloc; b.st[1] = nx; }
        const unsigned old = xb_add(&bar[XB_XSUB(b.x)], 1u);
        const unsigned gen = old / nloc;
        if (old + 1u == (gen + 1u) * nloc) {
            __builtin_amdgcn_fence(__ATOMIC_RELEASE, "agent");
            asm volatile("s_waitcnt vmcnt(0)" ::: "memory");
            const unsigned og = xb_add(&bar[XB_TOP], 1u);
            const unsigned tg = og / nx;
            if (og + 1u == (tg + 1u) * nx) xb_add(&bar[XB_TOPGEN], 1u);
            else XB_SPIN(xb_ld(&bar[XB_TOPGEN]) == tg, bar);
            __builtin_amdgcn_fence(__ATOMIC_ACQUIRE, "agent");
            xb_add(&bar[XB_XGEN(b.x)], 1u);
            asm volatile("s_waitcnt vmcnt(0)" ::: "memory");
        } else {
            XB_SPIN(xb_ld(&bar[XB_XGEN(b.x)]) == gen, bar);
            __builtin_amdgcn_fence(__ATOMIC_ACQUIRE, "agent");
            asm volatile("s_waitcnt vmcnt(0)" ::: "memory");
        }
    }
    __syncthreads();
}
namespace epi {
using pg8::f32x4; using pg8::Unit; using pg8::bf16_t; using pg8::u32x4; using pg8::cvt_pk_bf16;
__device__ __forceinline__ float sigm(float x) { return __builtin_amdgcn_rcpf(1.f + __builtin_amdgcn_exp2f(-1.4426950408889634f * x)); }
__device__ __forceinline__ f32x4 sigm4(f32x4 v) { return (f32x4){sigm(v[0]), sigm(v[1]), sigm(v[2]), sigm(v[3])}; }
__device__ __forceinline__ u32x4 pack8(f32x4 a, f32x4 b) { u32x4 w; w.x = cvt_pk_bf16(a[0], a[1]); w.y = cvt_pk_bf16(a[2], a[3]); w.z = cvt_pk_bf16(b[0], b[1]); w.w = cvt_pk_bf16(b[2], b[3]); return w; }
__device__ __forceinline__ void unpack8(u32x4 w, f32x4& a, f32x4& b) {
    a[0] = __uint_as_float(w.x << 16); a[1] = __uint_as_float(w.x & 0xffff0000u); a[2] = __uint_as_float(w.y << 16); a[3] = __uint_as_float(w.y & 0xffff0000u);
    b[0] = __uint_as_float(w.z << 16); b[1] = __uint_as_float(w.z & 0xffff0000u); b[2] = __uint_as_float(w.w << 16); b[3] = __uint_as_float(w.w & 0xffff0000u); }

struct EpiInProj { static constexpr bool PERM = true, AFTER_DRAIN = false;
    bf16_t* Qb; bf16_t* KVb; float* U; bf16_t* MG; float* GT; const float* rstd; float* out;
    __device__ __forceinline__ void operator()(const f32x4 (&acc)[2][2][4][2], const Unit& u, int wr, int wc, int fr, int fq) const {
        const int pn = u.pn, row0 = u.pm * 256 + wr * 64 + fr, c0 = wc * 32 + 8 * fq;
#pragma unroll
        for (int ai = 0; ai < 2; ++ai)
#pragma unroll
            for (int m = 0; m < 4; ++m) { const int r = row0 + ai * 128 + m * 16; const bool ok = r < MROWS; const float rs = rstd[r];
#pragma unroll
                for (int bj = 0; bj < 2; ++bj) { f32x4 v0 = acc[ai][bj][m][0] * rs, v1 = acc[ai][bj][m][1] * rs; const int c = c0 + bj * 128;
                    if (!ok) continue;
                    if (pn < 4) { *(u32x4*)(Qb + (size_t)r * 1024 + pn * 256 + c) = pack8(v0, v1); }
                    else if (pn < 10) { const int slot = pn - 4; *(u32x4*)(KVb + (size_t)r * 1536 + slot * 256 + c) = pack8(v0, v1);
                        float* dst = nullptr;
                        if (slot < 4) dst = (r < MP) ? out + O_KVP + (size_t)r * 1024 + slot * 256 + c : out + O_KVS + (size_t)(r - MP) * 1024 + slot * 256 + c;
                        else if (r < MP) { const int t = r & (SEQ - 1); if (t >= SEQ - 512) dst = out + O_WINP + ((size_t)((r >> 11) * 512 + (t - (SEQ - 512))) * 2 + (slot - 4)) * 256 + c; }
                        else { const int q = r - MP; dst = out + O_WINS + ((size_t)((q >> 3) * 512 + 504 + (q & 7)) * 2 + (slot - 4)) * 256 + c; }
                        if (dst) { *(f32x4*)dst = v0; *(f32x4*)(dst + 4) = v1; } }
                    else if (pn < 14) { float* dst = U + (size_t)r * 1024 + (pn - 10) * 256 + c; *(f32x4*)dst = v0; *(f32x4*)(dst + 4) = v1; }
                    else if (pn < 30) { *(u32x4*)(MG + (size_t)r * 4096 + (pn - 14) * 256 + c) = pack8(sigm4(v0), sigm4(v1)); }
                    else if (c < 48) { float* dst = GT + (size_t)r * 64 + c; *(f32x4*)dst = sigm4(v0); *(f32x4*)(dst + 4) = sigm4(v1); } } }
    }
};
struct EpiGlu { static constexpr bool PERM = true, AFTER_DRAIN = false;
    const bf16_t* MG; bf16_t* MB;
    __device__ __forceinline__ void operator()(const f32x4 (&acc)[2][2][4][2], const Unit& u, int wr, int wc, int fr, int fq) const {
        const int row0 = u.pm * 256 + wr * 64 + fr, col = u.pn * 128 + wc * 32 + 8 * fq;
#pragma unroll
        for (int ai = 0; ai < 2; ++ai)
#pragma unroll
            for (int m = 0; m < 4; ++m) { const int r = row0 + ai * 128 + m * 16; if (r >= MROWS) continue;
                f32x4 s0, s1; unpack8(*(const u32x4*)(MG + (size_t)r * 4096 + 2048 + col), s0, s1);
                const f32x4 y0 = acc[ai][0][m][0] * sigm4(acc[ai][1][m][0]) * s0, y1 = acc[ai][0][m][1] * sigm4(acc[ai][1][m][1]) * s1;
                *(u32x4*)(MB + (size_t)r * 2048 + col) = pack8(y0, y1); }
    }
};
struct EpiAttnOut { static constexpr bool PERM = true, AFTER_DRAIN = false;
    const bf16_t* MG; bf16_t* MB;
    __device__ __forceinline__ void operator()(const f32x4 (&acc)[2][2][4][2], const Unit& u, int wr, int wc, int fr, int fq) const {
        const int row0 = u.pm * 256 + wr * 64 + fr, col0 = u.pn * 256 + wc * 32 + 8 * fq;
#pragma unroll
        for (int ai = 0; ai < 2; ++ai)
#pragma unroll
            for (int m = 0; m < 4; ++m) { const int r = row0 + ai * 128 + m * 16; if (r >= MROWS) continue;
#pragma unroll
                for (int bj = 0; bj < 2; ++bj) { const int col = col0 + bj * 128;
                    f32x4 s0, s1, b0, b1; unpack8(*(const u32x4*)(MG + (size_t)r * 4096 + col), s0, s1); unpack8(*(const u32x4*)(MB + (size_t)r * 2048 + col), b0, b1);
                    *(u32x4*)(MB + (size_t)r * 2048 + col) = pack8(b0 + s0 * acc[ai][bj][m][0], b1 + s1 * acc[ai][bj][m][1]); } }
    }
};
struct EpiWout { static constexpr bool PERM = true, AFTER_DRAIN = false;
    const float* xp; const float* xs; float* X2; bf16_t* XN; float* ss;
    __device__ __forceinline__ void operator()(const f32x4 (&acc)[2][2][4][2], const Unit& u, int wr, int wc, int fr, int fq) const {
        const int row0 = u.pm * 256 + wr * 64 + fr, col0 = u.pn * 256 + wc * 32 + 8 * fq;
#pragma unroll
        for (int ai = 0; ai < 2; ++ai)
#pragma unroll
            for (int m = 0; m < 4; ++m) { const int r = row0 + ai * 128 + m * 16; const bool ok = r < MROWS; float s = 0.f;
                const float* xr = (r < MP) ? xp + (size_t)r * 2048 : xs + (size_t)(ok ? r - MP : 0) * 2048;
#pragma unroll
                for (int bj = 0; bj < 2; ++bj) { const int col = col0 + bj * 128;
                    f32x4 v0 = acc[ai][bj][m][0], v1 = acc[ai][bj][m][1];
                    if (ok) { v0 += *(const f32x4*)(xr + col); v1 += *(const f32x4*)(xr + col + 4);
                        float* d = X2 + (size_t)r * 2048 + col; *(f32x4*)d = v0; *(f32x4*)(d + 4) = v1; *(u32x4*)(XN + (size_t)r * 2048 + col) = pack8(v0, v1); }
                    s += (v0[0] * v0[0] + v0[1] * v0[1]) + (v0[2] * v0[2] + v0[3] * v0[3]) + (v1[0] * v1[0] + v1[1] * v1[1]) + (v1[2] * v1[2] + v1[3] * v1[3]); }
                s += __shfl_xor(s, 16); s += __shfl_xor(s, 32);
                if (ok && fq == 0) atomicAdd(ss + r, s); }
    }
};
struct EpiGateUp { static constexpr bool PERM = true, AFTER_DRAIN = false;
    const float* ss; bf16_t* HH;
    __device__ __forceinline__ void operator()(const f32x4 (&acc)[2][2][4][2], const Unit& u, int wr, int wc, int fr, int fq) const {
        const int row0 = u.pm * 256 + wr * 64 + fr, col = u.pn * 128 + wc * 32 + 8 * fq;
#pragma unroll
        for (int ai = 0; ai < 2; ++ai)
#pragma unroll
            for (int m = 0; m < 4; ++m) { const int r = row0 + ai * 128 + m * 16; if (r >= MROWS) continue;
                const float rs = 1.0f / sqrtf(ss[r] * (1.0f / 2048.0f) + EPS);
                const f32x4 g0 = acc[ai][0][m][0] * rs, g1 = acc[ai][0][m][1] * rs, u0 = acc[ai][1][m][0] * rs, u1 = acc[ai][1][m][1] * rs;
                *(u32x4*)(HH + (size_t)r * DFF + col) = pack8(g0 * sigm4(g0) * u0, g1 * sigm4(g1) * u1); }
    }
};
struct EpiDown { static constexpr bool PERM = true, AFTER_DRAIN = false;
    const float* X2; float* Y; float* ss;
    __device__ __forceinline__ void operator()(const f32x4 (&acc)[2][2][4][2], const Unit& u, int wr, int wc, int fr, int fq) const {
        const int row0 = u.pm * 256 + wr * 64 + fr, col0 = u.pn * 256 + wc * 32 + 8 * fq;
#pragma unroll
        for (int ai = 0; ai < 2; ++ai)
#pragma unroll
            for (int m = 0; m < 4; ++m) { const int r = row0 + ai * 128 + m * 16; const bool ok = r < MROWS; float s = 0.f;
#pragma unroll
                for (int bj = 0; bj < 2; ++bj) { const int col = col0 + bj * 128;
                    f32x4 v0 = acc[ai][bj][m][0], v1 = acc[ai][bj][m][1];
                    if (ok) { const float* xr = X2 + (size_t)r * 2048 + col; v0 += *(const f32x4*)xr; v1 += *(const f32x4*)(xr + 4);
                        float* d = Y + (size_t)r * 2048 + col; *(f32x4*)d = v0; *(f32x4*)(d + 4) = v1; }
                    s += (v0[0] * v0[0] + v0[1] * v0[1]) + (v0[2] * v0[2] + v0[3] * v0[3]) + (v1[0] * v1[0] + v1[1] * v1[1]) + (v1[2] * v1[2] + v1[3] * v1[3]); }
                s += __shfl_xor(s, 16); s += __shfl_xor(s, 32);
                if (ok && fq == 0) atomicAdd(ss + r, s); }
    }
};
}
constexpr int RING_OFF = 0, RING_BYTES = 131072;
constexpr int LDSCTL_OFF = RING_BYTES, MISC_OFF = LDSCTL_OFF + 320;
constexpr int LDS_BYTES = 147456;
constexpr int NWAVES = 8;
typedef float f32x2v __attribute__((ext_vector_type(2)));

#define WSYNC() do { asm volatile("s_waitcnt lgkmcnt(0)" ::: "memory"); __builtin_amdgcn_wave_barrier(); asm volatile("" ::: "memory"); } while (0)
__device__ __forceinline__ int vgpr_i(int x) { asm volatile("" : "+v"(x)); return x; }
__device__ __forceinline__ float bf2f(unsigned short h) { return __uint_as_float((unsigned)h << 16); }
__device__ __forceinline__ float wave_sum(float v) {
#pragma unroll
    for (int o = 1; o < 64; o <<= 1) v += __shfl_xor(v, o);
    return v; }
__device__ __forceinline__ float wave_max(float v) {
#pragma unroll
    for (int o = 1; o < 64; o <<= 1) v = fmaxf(v, __shfl_xor(v, o));
    return v; }
__device__ __forceinline__ float fsigm(float x) { return __builtin_amdgcn_rcpf(1.f + __builtin_amdgcn_exp2f(-1.4426950408889634f * x)); }
__device__ __forceinline__ float gelu_tanh(float x) { return x * fsigm(1.5957691216057308f * (x + 0.044715f * x * x * x)); }
__device__ __forceinline__ float fexp(float x) { return __builtin_amdgcn_exp2f(1.4426950408889634f * x); }

struct TrJob { const float* W0; const float* W1; const float* g; bf16* WT; int K, Nsrc, Ndst, kind; };
__device__ __forceinline__ const float* tr_src(const TrJob& j, int n) {
    switch (j.kind) {
    default: return n < j.Nsrc ? j.W0 + n : nullptr;
    case 1: { if (n < 2560) return j.W0 + n; if (n < 3584) return j.W0 + 2608 + (n - 2560); if (n < 7680) return j.W0 + 3632 + (n - 3584); if (n < 7728) return j.W0 + 2560 + (n - 7680); return nullptr; }
    case 2: { const int pn = n >> 8, w = n & 255; return j.W0 + (w < 128 ? 128 * pn + w : 2048 + 128 * pn + (w - 128)); }
    case 3: { const int pn = n >> 8, w = n & 255; return w < 128 ? j.W0 + 128 * pn + w : j.W1 + 128 * pn + (w - 128); }
    }
}
__device__ __forceinline__ void tr_item(const TrJob& j, int item, LAS unsigned* scr, int lane) {
    const int nblk = j.Ndst / 64, kb = item / nblk, nb = item % nblk, k0 = 64 * kb, n0 = 64 * nb;
    const float* src = tr_src(j, n0 + lane); const float msk = src ? 1.f : 0.f; if (!src) src = j.W0;
    src += (size_t)k0 * j.Nsrc;
#pragma unroll 8
    for (int i = 0; i < 32; ++i) { float a = src[(size_t)(2 * i) * j.Nsrc] * msk, b = src[(size_t)(2 * i + 1) * j.Nsrc] * msk;
        if (j.g) { a *= j.g[k0 + 2 * i]; b *= j.g[k0 + 2 * i + 1]; }
        scr[i * 65 + lane] = pk2(a, b); }
    LDS_WAIT(); __builtin_amdgcn_wave_barrier(); asm volatile("" ::: "memory");
    const int c = lane & 7;
#pragma unroll
    for (int jj = 0; jj < 8; ++jj) { const int n = 8 * jj + (lane >> 3); const LAS unsigned* s = scr + (4 * c) * 65 + n;
        v4u o; o.x = s[0]; o.y = s[65]; o.z = s[130]; o.w = s[195];
        *(GAS v4u*)(j.WT + (size_t)(n0 + n) * j.K + k0 + 8 * c) = o; }
    LDS_WAIT(); __builtin_amdgcn_wave_barrier(); asm volatile("" ::: "memory");
}
__device__ __forceinline__ void xn_row(const float* xrow, bf16* orow, float* rstd_out, int lane) {
    GAS unsigned long long* o8 = (GAS unsigned long long*)orow + lane;
    if (!xrow) {
#pragma unroll
        for (int j = 0; j < 8; ++j) o8[64 * j] = 0ull;
        if (lane == 0) *rstd_out = 0.f; return; }
    const GAS f32x4* xr = (const GAS f32x4*)xrow + lane; f32x4 v[8]; float s = 0.f;
#pragma unroll
    for (int j = 0; j < 8; ++j) { v[j] = xr[64 * j]; s += (v[j].x * v[j].x + v[j].y * v[j].y) + (v[j].z * v[j].z + v[j].w * v[j].w); }
    s = wave_sum(s);
#pragma unroll
    for (int j = 0; j < 8; ++j) o8[64 * j] = (unsigned long long)pk2(v[j].x, v[j].y) | ((unsigned long long)pk2(v[j].z, v[j].w) << 32);
    if (lane == 0) *rstd_out = 1.0f / sqrtf(s * (1.0f / D_MODEL) + EPS);
}

constexpr int CMP_PHI = 0, CMP_POOL = 8192, CMP_CST = 8256, CMP_GS = 8384;
__device__ __forceinline__ void compress_setup(const float* pe, const float* pool, const float* phi, LAS float* L, int tid) {
    for (int i = tid; i < 8192; i += NWAVES * 64) L[CMP_PHI + i] = phi[i];
    if (tid < 64) L[CMP_POOL + tid] = pool[tid];
    if (tid < 128) { const int w = tid >> 6, d = tid & 63; float s = 0.f;
        for (int j = 0; j < 32; ++j) s += pool[w * 32 + j] * pe[(w * 32 + j) * 64 + d];
        L[CMP_CST + tid] = s; }
    __syncthreads();
}
template <bool SAMPLE> __device__ __forceinline__ void compress_item(const float* rows, const int* pt, int b, int i, int nc, bf16* KC, LAS float* L, int wave, int lane) {
    const int which = lane >> 5;
    f32x4 plo0 = {0.f, 0.f, 0.f, 0.f}, plo1 = plo0;
    const int m_end = (8 * i + 8 < nc) ? 8 * i + 8 : nc;
    for (int m = 8 * i; m <= m_end; ++m) {
        const float* base;
        if (SAMPLE) { const int pos = 16 * m; const int phys = pt[b * NPAGES + (pos >> 7)]; base = rows + ((size_t)phys * PAGE + (pos & (PAGE - 1))) * 1024 + 8 * lane; }
        else base = rows + ((size_t)b * SEQ + 16 * m) * 1024 + 8 * lane;
        f32x4 lo0 = {0.f, 0.f, 0.f, 0.f}, lo1 = lo0, hi0 = lo0, hi1 = lo0;
#pragma unroll
        for (int j = 0; j < 16; ++j) { const f32x4 v0 = *(const f32x4*)(base + (size_t)j * 1024), v1 = *(const f32x4*)(base + (size_t)j * 1024 + 4);
            const float pl = L[CMP_POOL + which * 32 + j], ph = L[CMP_POOL + which * 32 + 16 + j];
            lo0 += pl * v0; lo1 += pl * v1; hi0 += ph * v0; hi1 += ph * v1; }
        if (m > 8 * i) { const int c = m - 1;
            const f32x4 c0 = *(const LAS f32x4*)(L + CMP_CST + which * 64 + 8 * (lane & 7)), c1 = *(const LAS f32x4*)(L + CMP_CST + which * 64 + 8 * (lane & 7) + 4);
            f32x4 g0 = plo0 + hi0 + c0, g1 = plo1 + hi1 + c1;
#pragma unroll
            for (int e = 0; e < 4; ++e) { g0[e] = gelu_tanh(g0[e]); g1[e] = gelu_tanh(g1[e]); }
            LAS float* Gs = L + CMP_GS + wave * 512;
            *(LAS f32x4*)(Gs + 8 * lane) = g0; *(LAS f32x4*)(Gs + 8 * lane + 4) = g1;
            WSYNC();
            f32x4 a0 = {0.f, 0.f, 0.f, 0.f}, a1 = a0; const LAS float* gr = Gs + (lane >> 3) * 64; const LAS float* ph = L + CMP_PHI + which * 4096 + 8 * (lane & 7);
#pragma unroll 8
            for (int d = 0; d < 64; ++d) { const float gv = gr[d]; a0 += gv * *(const LAS f32x4*)(ph + d * 64); a1 += gv * *(const LAS f32x4*)(ph + d * 64 + 4); }
            { v4u w; w.x = pk2(a0[0], a0[1]); w.y = pk2(a0[2], a0[3]); w.z = pk2(a1[0], a1[1]); w.w = pk2(a1[2], a1[3]); *(GAS v4u*)(KC + (size_t)c * 512 + 8 * lane) = w; }
            WSYNC(); }
        plo0 = lo0; plo1 = lo1;
    }
}

struct SsmIn { const float *lam_re, *lam_im, *log_dt, *b_re, *b_im, *c_re, *c_im, *dsk; };
struct SsmC { float ar, ai, dsk; f32x2v bb[16]; float cm[32]; };
__device__ __forceinline__ void ssm_consts(const SsmIn& I, int g, int lane, SsmC& C) {
    const int p = lane; const float dt = expf(I.log_dt[g]), lr = I.lam_re[g * 64 + p], li = I.lam_im[g * 64 + p];
    const float mag = expf(lr * dt); float sn, cs; sincosf(li * dt, &sn, &cs);
    C.ar = mag * cs; C.ai = mag * sn;
    const float den = lr * lr + li * li, fr = ((C.ar - 1.f) * lr + C.ai * li) / den, fi = (C.ai * lr - (C.ar - 1.f) * li) / den;
#pragma unroll
    for (int c4 = 0; c4 < 4; ++c4) { const f32x4 br = *(const f32x4*)(I.b_re + (size_t)(g * 64 + p) * 16 + 4 * c4), bi = *(const f32x4*)(I.b_im + (size_t)(g * 64 + p) * 16 + 4 * c4);
#pragma unroll
        for (int e = 0; e < 4; ++e) C.bb[4 * c4 + e] = (f32x2v){fr * br[e] - fi * bi[e], fr * bi[e] + fi * br[e]}; }
    const int c = lane & 15, q = lane >> 4;
#pragma unroll
    for (int k4 = 0; k4 < 4; ++k4) { const f32x4 cr = *(const f32x4*)(I.c_re + (size_t)(g * 16 + c) * 64 + 16 * q + 4 * k4), ci = *(const f32x4*)(I.c_im + (size_t)(g * 16 + c) * 64 + 16 * q + 4 * k4);
#pragma unroll
        for (int e = 0; e < 4; ++e) { C.cm[8 * k4 + 2 * e] = cr[e]; C.cm[8 * k4 + 2 * e + 1] = -ci[e]; } }
    C.dsk = I.dsk[g * 16 + c];
}
__device__ __forceinline__ f32x4 ssm_y16(const LAS float* Hs, const SsmC& C, int lane) {
    const int trow = lane & 15, q = lane >> 4; f32x4 d = {0.f, 0.f, 0.f, 0.f};
#pragma unroll
    for (int k4 = 0; k4 < 8; ++k4) { const f32x4 a = *(const LAS f32x4*)(Hs + trow * 132 + 32 * q + 4 * k4);
#pragma unroll
        for (int e = 0; e < 4; ++e) d = __builtin_amdgcn_mfma_f32_16x16x4f32(a[e], C.cm[4 * k4 + e], d, 0, 0, 0); }
    return d;
}
constexpr int SSM_US = 0, SSM_HS = 16384, SSM_HEND = SSM_HS + 8 * 8448;
__device__ __forceinline__ void ssm_prompt_item(const SsmIn& I, int b, int g, const float* U, bf16* GY, float* out, LAS unsigned char* lds, int wave, int lane) {
    SsmC C; ssm_consts(I, g, lane, C);
    float a32r = C.ar, a32i = C.ai;
#pragma unroll
    for (int s = 0; s < 5; ++s) { const float nr = a32r * a32r - a32i * a32i, ni = 2.f * a32r * a32i; a32r = nr; a32i = ni; }
    LAS float* uS = (LAS float*)(lds + SSM_US) + wave * 512; LAS float* Hs = (LAS float*)(lds + SSM_HS) + wave * 2112; LAS float* hend = (LAS float*)(lds + SSM_HEND);
    float cr = 0.f, ci = 0.f;
#pragma unroll 1
    for (int sb = 0; sb < SEQ / 256; ++sb) {
        const int row0 = b * SEQ + sb * 256 + wave * 32;
#pragma unroll
        for (int h = 0; h < 2; ++h) { const int tt = (lane >> 2) + 16 * h; *(LAS f32x4*)(uS + tt * 16 + 4 * (lane & 3)) = *(const f32x4*)(U + (size_t)(row0 + tt) * 1024 + g * 16 + 4 * (lane & 3)); }
        WSYNC();
        f32x2v x[32];
#pragma unroll
        for (int i = 0; i < 32; ++i) { f32x2v sx = {0.f, 0.f}; asm volatile("" ::: "memory");
#pragma unroll
            for (int c4 = 0; c4 < 4; ++c4) { const f32x4 u4 = *(const LAS f32x4*)(uS + i * 16 + 4 * c4);
#pragma unroll
                for (int e = 0; e < 4; ++e) sx += u4[e] * C.bb[4 * c4 + e]; }
            x[i] = sx; }
        const f32x2v A1 = {C.ar, C.ar}, A2 = {-C.ai, C.ai};
        f32x2v h = {0.f, 0.f};
#pragma unroll
        for (int i = 0; i < 32; ++i) { const f32x2v hs = __builtin_shufflevector(h, h, 1, 0); h = A1 * h + (A2 * hs + x[i]); }
        const float hr = h.x, hi = h.y;
        *(LAS f32x2v*)(hend + (wave * 64 + lane) * 2) = (f32x2v){hr, hi};
        __syncthreads();
        float chr = cr, chi = ci, cinr = 0.f, cini = 0.f;
#pragma unroll
        for (int w = 0; w < 8; ++w) { if (w == wave) { cinr = chr; cini = chi; }
            const f32x2v e = *(const LAS f32x2v*)(hend + (w * 64 + lane) * 2);
            const float nr = a32r * chr - a32i * chi + e.x, ni = a32r * chi + a32i * chr + e.y; chr = nr; chi = ni; }
        cr = chr; ci = chi; h = (f32x2v){cinr, cini};
#pragma unroll
        for (int half = 0; half < 2; ++half) {
#pragma unroll
            for (int i = 0; i < 16; ++i) { const int ii = half * 16 + i; const f32x2v hs = __builtin_shufflevector(h, h, 1, 0); h = A1 * h + (A2 * hs + x[ii]);
                *(LAS f32x2v*)(Hs + i * 132 + 2 * lane) = h; }
            WSYNC();
            const f32x4 d = ssm_y16(Hs, C, lane); const int c = lane & 15, q = lane >> 4;
#pragma unroll
            for (int r = 0; r < 4; ++r) { const int tt = half * 16 + 4 * q + r; const float y = d[r] + C.dsk * uS[tt * 16 + c];
                GY[(size_t)(row0 + tt) * 1024 + g * 16 + c] = (bf16)f2bf(gelu_tanh(y)); }
            WSYNC();
        }
        __syncthreads();
    }
    if (wave == 0) { out[O_HRP + (size_t)(b * 64 + g) * 64 + lane] = cr; out[O_HIP + (size_t)(b * 64 + g) * 64 + lane] = ci; }
}
__device__ __forceinline__ void ssm_sample_item(const SsmIn& I, int b, int g, const float* U, const float* h0r, const float* h0i, bf16* GY, float* out, LAS unsigned char* lds, int wave, int lane) {
    SsmC C; ssm_consts(I, g, lane, C);
    LAS float* uS = (LAS float*)(lds + SSM_US) + wave * 512; LAS float* Hs = (LAS float*)(lds + SSM_HS) + wave * 2112;
    const int row0 = MP + b * DEC_T;
    if (lane < 32) { const int tt = lane >> 2; *(LAS f32x4*)(uS + tt * 16 + 4 * (lane & 3)) = *(const f32x4*)(U + (size_t)(row0 + tt) * 1024 + g * 16 + 4 * (lane & 3)); }
    WSYNC();
    float hr = h0r[(size_t)(b * 64 + g) * 64 + lane], hi = h0i[(size_t)(b * 64 + g) * 64 + lane];
#pragma unroll
    for (int i = 0; i < 16; ++i) {
        if (i < DEC_T) { f32x2v sx = {0.f, 0.f};
#pragma unroll
            for (int c4 = 0; c4 < 4; ++c4) { const f32x4 u4 = *(const LAS f32x4*)(uS + i * 16 + 4 * c4);
#pragma unroll
                for (int e = 0; e < 4; ++e) sx += u4[e] * C.bb[4 * c4 + e]; }
            const float nr = C.ar * hr - C.ai * hi + sx.x, ni = C.ar * hi + C.ai * hr + sx.y; hr = nr; hi = ni; }
        *(LAS f32x2v*)(Hs + i * 132 + 2 * lane) = (i < DEC_T) ? (f32x2v){hr, hi} : (f32x2v){0.f, 0.f}; }
    WSYNC();
    out[O_HRS + (size_t)(b * 64 + g) * 64 + lane] = hr; out[O_HIS + (size_t)(b * 64 + g) * 64 + lane] = hi;
    const f32x4 d = ssm_y16(Hs, C, lane); const int c = lane & 15, q = lane >> 4;
#pragma unroll
    for (int r = 0; r < 4; ++r) { const int tt = 4 * q + r; if (tt < DEC_T) { const float y = d[r] + C.dsk * uS[tt * 16 + c];
        GY[(size_t)(row0 + tt) * 1024 + g * 16 + c] = (bf16)f2bf(gelu_tanh(y)); } }
    WSYNC();
}

constexpr int AS_QS = 0, AS_PS = 256, AS_PSUM = 512, AS_IMP = 1536, AS_SEL = 1800, AS_WORDS = 2048;
__device__ __forceinline__ void ld8(bool bf, const void* base, size_t off, float (&k)[8]) {
    if (bf) { const v4u w = *(const v4u*)((const bf16*)base + off);
        k[0] = __uint_as_float(w.x << 16); k[1] = __uint_as_float(w.x & 0xffff0000u); k[2] = __uint_as_float(w.y << 16); k[3] = __uint_as_float(w.y & 0xffff0000u);
        k[4] = __uint_as_float(w.z << 16); k[5] = __uint_as_float(w.z & 0xffff0000u); k[6] = __uint_as_float(w.w << 16); k[7] = __uint_as_float(w.w & 0xffff0000u); }
    else { const f32x4 a = *(const f32x4*)((const float*)base + off), b = *(const f32x4*)((const float*)base + off + 4);
        k[0] = a[0]; k[1] = a[1]; k[2] = a[2]; k[3] = a[3]; k[4] = b[0]; k[5] = b[1]; k[6] = b[2]; k[7] = b[3]; }
}
__device__ __forceinline__ float ld1(bool bf, const void* base, size_t off) { return bf ? bf2f(((const bf16*)base)[off]) : ((const float*)base)[off]; }
template <int MODE> __device__ __forceinline__ void att_chunk(bool bf, const void* kb, int stride, int c_lo, int c_hi, int kp0, int kstep, int pc,
        const float (&sl)[4], LAS float* W, float (&m)[4], float (&l)[4], float (&acc)[4], LAS float* psum, int lane) {
    const bool valid = lane >= c_lo && lane < c_hi;
    float s[4] = {0.f, 0.f, 0.f, 0.f};
    if (valid) {
#pragma unroll 1
        for (int hh = 0; hh < 2; ++hh) {
            float kk[4][8];
#pragma unroll
            for (int i = 0; i < 4; ++i) ld8(bf, kb, (size_t)lane * stride + 32 * hh + 8 * i, kk[i]);
#pragma unroll
            for (int i = 0; i < 4; ++i) { const float (&k)[8] = kk[i];
#pragma unroll
                for (int n = 0; n < 4; ++n) { asm volatile("" ::: "memory");
                    const f32x4 qa = *(const LAS f32x4*)(W + AS_QS + n * 64 + 32 * hh + 8 * i), qb = *(const LAS f32x4*)(W + AS_QS + n * 64 + 32 * hh + 8 * i + 4);
                    s[n] += (k[0] * qa[0] + k[1] * qa[1]) + (k[2] * qa[2] + k[3] * qa[3]) + (k[4] * qb[0] + k[5] * qb[1]) + (k[6] * qb[2] + k[7] * qb[3]); } }
            asm volatile("" ::: "memory"); } }
    const float dist = (float)(pc - (kp0 + kstep * lane));
#pragma unroll
    for (int n = 0; n < 4; ++n) s[n] = valid ? s[n] * 0.125f - sl[n] * dist : -INFINITY;
    if (MODE == 1) {
#pragma unroll
        for (int n = 0; n < 4; ++n) { const float mn = fmaxf(m[n], wave_max(s[n])); const float sc = (m[n] == -INFINITY) ? 0.f : fexp(m[n] - mn);
            l[n] = l[n] * sc + wave_sum(valid ? fexp(s[n] - mn) : 0.f); m[n] = mn; }
        return; }
    f32x4 p;
    if (MODE == 0) {
#pragma unroll
        for (int n = 0; n < 4; ++n) { const float mn = fmaxf(m[n], wave_max(s[n])); const float sc = (m[n] == -INFINITY) ? 0.f : fexp(m[n] - mn);
            p[n] = valid ? fexp(s[n] - mn) : 0.f; l[n] = l[n] * sc + wave_sum(p[n]); acc[n] *= sc; m[n] = mn; }
    } else {
#pragma unroll
        for (int n = 0; n < 4; ++n) p[n] = valid ? fexp(s[n] - m[n]) * l[n] : 0.f;
        psum[lane] = (p[0] + p[1]) + (p[2] + p[3]);
    }
    *(LAS f32x4*)(W + AS_PS + 4 * lane) = p;
    WSYNC();
#pragma unroll 2
    for (int c = c_lo; c < c_hi; ++c) { const float v = ld1(bf, kb, (size_t)c * stride + 256 + lane); const f32x4 pp = *(const LAS f32x4*)(W + AS_PS + 4 * c);
#pragma unroll
        for (int n = 0; n < 4; ++n) acc[n] += pp[n] * v; }
    WSYNC();
}
struct AttnP { const bf16* Qb; const bf16* KVb; const bf16* KCP; const bf16* KCS; const float* GT; const float* cache; const float* swin; const int* pt; bf16* OB; };
__device__ __forceinline__ void attn_item_simple(const AttnP& P, int r, int g, LAS float* W, int lane) {
    const bool sample = r >= MP; const int q_ = r - MP;
    const int b = sample ? (q_ >> 3) : (r >> 11), t = sample ? (q_ & 7) : (r & (SEQ - 1)), pc = sample ? PAST + t : t;
    const int rowbase = sample ? MP + b * DEC_T : b * SEQ;
    float sl[4];
#pragma unroll
    for (int n = 0; n < 4; ++n) { W[AS_QS + n * 64 + lane] = bf2f(P.Qb[(size_t)r * 1024 + (4 * g + n) * 64 + lane]); sl[n] = exp2f(-0.5f * (float)(4 * g + n + 1)); }
    WSYNC();
    float ot[4] = {0.f, 0.f, 0.f, 0.f};
    const int gi = vgpr_i(r * 64 + 4 * g);
    const int ncmax = sample ? NC_S : NC_P; int ncv = pc >= 31 ? (pc - 31) / 16 + 1 : 0; if (ncv > ncmax) ncv = ncmax;
    const bf16* kc = sample ? P.KCS + (size_t)b * NCP_S * 512 : P.KCP + (size_t)b * NCP_P * 512;
    if (ncv > 0) { float m[4] = {-INFINITY, -INFINITY, -INFINITY, -INFINITY}, l[4] = {0.f, 0.f, 0.f, 0.f}, oc[4] = {0.f, 0.f, 0.f, 0.f};
#pragma unroll 1
        for (int c0 = 0; c0 < ncv; c0 += 64) att_chunk<1>(true, kc + (size_t)c0 * 512 + g * 64, 512, 0, (ncv - c0 < 64) ? ncv - c0 : 64, 16 * c0 + 31, 16, pc, sl, W, m, l, oc, nullptr, lane);
#pragma unroll
        for (int n = 0; n < 4; ++n) l[n] = 1.0f / l[n];
#pragma unroll 1
        for (int c0 = 0; c0 < ncv; c0 += 64) att_chunk<2>(true, kc + (size_t)c0 * 512 + g * 64, 512, 0, (ncv - c0 < 64) ? ncv - c0 : 64, 16 * c0 + 31, 16, pc, sl, W, m, l, oc, W + AS_PSUM + c0, lane);
#pragma unroll
        for (int n = 0; n < 4; ++n) ot[n] = P.GT[gi + n] * oc[n]; }
    const int ns = sample ? 257 : 32, cur = pc >> 6;
    for (int s = lane; s < ns; s += 64) { float v;
        if (s > cur) v = -1.f; else if (s == 0 || s == cur || s == cur - 1) v = 1e4f;
        else { v = 0.f; for (int c = 4 * s - 1; c <= 4 * s + 3; ++c) v += W[AS_PSUM + c]; }
        W[AS_IMP + s] = v; }
    WSYNC();
    int nsel = 0;
#pragma unroll 1
    for (int it = 0; it < 16; ++it) { float bv = -3.f; int bi = 1 << 30;
        for (int s = lane; s < ns; s += 64) { const float v = W[AS_IMP + s]; if (v > bv) { bv = v; bi = s; } }
#pragma unroll
        for (int o = 1; o < 64; o <<= 1) { const float ov = __shfl_xor(bv, o); const int oi = __shfl_xor(bi, o); if (ov > bv || (ov == bv && oi < bi)) { bv = ov; bi = oi; } }
        if (bv < 0.f) break;
        if (lane == 0) { ((LAS int*)W)[AS_SEL + nsel] = bi; W[AS_IMP + bi] = -2.f; }
        WSYNC(); ++nsel; }
    const int lo = pc - 511 > 0 ? pc - 511 : 0;
#pragma unroll 1
    for (int br = 0; br < 2; ++br) {
        float m[4] = {-INFINITY, -INFINITY, -INFINITY, -INFINITY}, l[4] = {0.f, 0.f, 0.f, 0.f}, o[4] = {0.f, 0.f, 0.f, 0.f};
        int nch;
        if (br == 0) nch = nsel; else if (!sample) nch = (pc >> 6) - (lo >> 6) + 1; else nch = (512 - ((t + 1) & ~63)) / 64 + 1;
#pragma unroll 1
        for (int i = 0; i < nch; ++i) {
            bool bf = true; const void* kb; int stride = 1536, c_lo = 0, c_hi = 64, kp0;
            const bf16* newrows = P.KVb + (size_t)rowbase * 1536 + (2 + 2 * br) * 256 + g * 64;
            if (br == 0) { const int blk = __builtin_amdgcn_readfirstlane(((LAS int*)W)[AS_SEL + i]); kp0 = blk * 64;
                if (!sample) { kb = newrows + (size_t)kp0 * 1536; c_hi = (pc - kp0 + 1 < 64) ? pc - kp0 + 1 : 64; }
                else if (blk == 256) { kb = newrows; c_hi = t + 1; }
                else { const int phys = P.pt[b * NPAGES + (kp0 >> 7)]; kb = P.cache + ((size_t)phys * PAGE + (kp0 & (PAGE - 1))) * 1024 + 2 * 256 + g * 64; bf = false; stride = 1024; } }
            else if (!sample) { kp0 = (lo & ~63) + 64 * i; kb = newrows + (size_t)kp0 * 1536; c_lo = lo - kp0 > 0 ? lo - kp0 : 0; c_hi = (pc - kp0 + 1 < 64) ? pc - kp0 + 1 : 64; }
            else if (i < nch - 1) { const int i0 = ((t + 1) & ~63) + 64 * i; kb = P.swin + ((size_t)(b * 512 + i0) * 2) * 256 + g * 64; bf = false; stride = 512; c_lo = t + 1 - i0 > 0 ? t + 1 - i0 : 0; kp0 = PAST - 512 + i0; }
            else { kb = newrows; c_hi = t + 1; kp0 = PAST; }
            att_chunk<0>(bf, kb, stride, c_lo, c_hi, kp0, 1, pc, sl, W, m, l, o, nullptr, lane);
        }
#pragma unroll
        for (int n = 0; n < 4; ++n) ot[n] += P.GT[gi + 16 * (br + 1) + n] * o[n] / l[n];
    }
#pragma unroll
    for (int n = 0; n < 4; ++n) P.OB[(size_t)r * 1024 + (4 * g + n) * 64 + lane] = (bf16)f2bf(ot[n]);
    WSYNC();
}
#ifndef MK_N_LAUNCHES
#define MK_N_LAUNCHES 1
#endif
constexpr int N_PHASES = 10;
#ifndef PHASE_MASK
#define PHASE_MASK 0x3ff
#endif
struct Args { const void* in[28]; float* out; unsigned char* ws; int ph_lo, ph_hi; };
__global__ void __launch_bounds__(NWAVES * 64, 2) mega_fwd(Args args) {
    extern __shared__ __attribute__((aligned(16))) unsigned char lds_raw[];
    LAS unsigned char* lds = (LAS unsigned char*)lds_raw;
    volatile LAS unsigned* MISC = (volatile LAS unsigned*)(lds + MISC_OFF);
    const int tid = threadIdx.x, lane = tid & 63, wave = __builtin_amdgcn_readfirstlane(tid >> 6);
    const int G = gridDim.x; const int bx = blockIdx.x; const int vcu = (G % 8 == 0) ? (bx % 8) * (G / 8) + bx / 8 : bx;
    const int gw = vcu * NWAVES + wave, NGW = G * NWAVES;
    unsigned char* ws = args.ws; float* out = args.out;
    gu32* ctl = (gu32*)(ws + WS_CTL);
    const float* x_prompt = (const float*)args.in[0]; const float* x_sample = (const float*)args.in[1]; const float* cache_kv = (const float*)args.in[2]; const float* state_win = (const float*)args.in[3];
    const float* st_re = (const float*)args.in[4]; const float* st_im = (const float*)args.in[5]; const int* page_table = (const int*)args.in[6];
    const float* g_mix = (const float*)args.in[7]; const float* w_in = (const float*)args.in[8]; const float* cmp_pe = (const float*)args.in[9]; const float* cmp_pool = (const float*)args.in[10]; const float* cmp_phi = (const float*)args.in[11];
    const float* w_attn_out = (const float*)args.in[12];
    const SsmIn SI{(const float*)args.in[13], (const float*)args.in[14], (const float*)args.in[15], (const float*)args.in[16], (const float*)args.in[17], (const float*)args.in[18], (const float*)args.in[19], (const float*)args.in[20]};
    const float* w_glu = (const float*)args.in[21]; const float* w_out = (const float*)args.in[22]; const float* g_ffn = (const float*)args.in[23];
    const float* w_gate = (const float*)args.in[24]; const float* w_up = (const float*)args.in[25]; const float* w_down = (const float*)args.in[26]; const float* g_final = (const float*)args.in[27];
    bf16* WIN = (bf16*)(ws + WS_WIN); bf16* WA = (bf16*)(ws + WS_WA); bf16* WGLU = (bf16*)(ws + WS_WGLU); bf16* WOUT = (bf16*)(ws + WS_WOUT); bf16* WGU = (bf16*)(ws + WS_WGU); bf16* WDN = (bf16*)(ws + WS_WDN);
    bf16* XN = (bf16*)(ws + WS_XN); float* RSTD1 = (float*)(ws + WS_RSTD1); bf16* QB = (bf16*)(ws + WS_QB); bf16* KVB = (bf16*)(ws + WS_KVB); float* U = (float*)(ws + WS_U);
    bf16* MG = (bf16*)(ws + WS_MG); float* GT = (float*)(ws + WS_GT); bf16* KCP = (bf16*)(ws + WS_KCP); bf16* KCS = (bf16*)(ws + WS_KCS); bf16* GY = (bf16*)(ws + WS_GY);
    bf16* OB = (bf16*)(ws + WS_OB); bf16* MB = (bf16*)(ws + WS_MB); float* X2 = (float*)(ws + WS_X2); bf16* HH = (bf16*)(ws + WS_HH); float* Y = (float*)(ws + WS_Y);
    float* SS2 = (float*)(ws + WS_CTL) + CW_SS2; float* SS3 = (float*)(ws + WS_CTL) + CW_SS3;

    for (int u = tid; u < (LDS_BYTES - LDSCTL_OFF) / 4; u += NWAVES * 64) ((LAS unsigned*)(lds + LDSCTL_OFF))[u] = 0u;
    __syncthreads();
    const int lo = args.ph_lo, hi = args.ph_hi;
    XcdBarrier bar; bar.bar = (unsigned*)(ctl + CW_BAR); bar.x = 0; bar.st = nullptr;
    if (hi - lo > 1) bar = xcd_barrier_post((unsigned*)(ctl + CW_BAR), MISC + 8);
#define IN(k) (lo <= (k) && (k) < hi)
#define SEAM(k) do { if (IN(k) && IN((k) + 1)) xcd_barrier(bar); } while (0)

    if (((PHASE_MASK >> 0) & 1) && IN(0)) {
        LAS unsigned* scr = (LAS unsigned*)(lds + RING_OFF) + wave * (32 * 65);
        constexpr int I0 = 32 * 124, I1 = 16 * 32, I2 = 16 * 64, I3 = 32 * 32, I4 = 32 * 176, I5 = 88 * 32, ITOT = I0 + I1 + I2 + I3 + I4 + I5;
        for (int it = gw; it < ITOT; it += NGW) { int r = it;
            if (r < I0) { const TrJob j{w_in, nullptr, g_mix, WIN, 2048, IN_COLS, NIN, 1}; tr_item(j, r, scr, lane); continue; } r -= I0;
            if (r < I1) { const TrJob j{w_attn_out, nullptr, nullptr, WA, 1024, 2048, 2048, 0}; tr_item(j, r, scr, lane); continue; } r -= I1;
            if (r < I2) { const TrJob j{w_glu, nullptr, nullptr, WGLU, 1024, 4096, 4096, 2}; tr_item(j, r, scr, lane); continue; } r -= I2;
            if (r < I3) { const TrJob j{w_out, nullptr, nullptr, WOUT, 2048, 2048, 2048, 0}; tr_item(j, r, scr, lane); continue; } r -= I3;
            if (r < I4) { const TrJob j{w_gate, w_up, g_ffn, WGU, 2048, DFF, 2 * DFF, 3}; tr_item(j, r, scr, lane); continue; } r -= I4;
            { const TrJob j{w_down, nullptr, nullptr, WDN, DFF, 2048, 2048, 0}; tr_item(j, r, scr, lane); } }
        for (int m = gw; m < MPAD; m += NGW) xn_row(m < MP ? x_prompt + (size_t)m * D_MODEL : (m < MROWS ? x_sample + (size_t)(m - MP) * D_MODEL : nullptr), XN + (size_t)m * D_MODEL, RSTD1 + m, lane);
        for (int i4 = (vcu * NWAVES * 64 + tid); i4 < DEC_B * 504 * 128; i4 += G * NWAVES * 64) { const int b = i4 / (504 * 128), rem = i4 - b * (504 * 128);
            *(GAS f32x4*)(out + O_WINS + (size_t)b * 512 * 512 + (size_t)rem * 4) = *(const GAS f32x4*)(state_win + (size_t)b * 512 * 512 + 8 * 512 + (size_t)rem * 4); }
        __syncthreads();
        compress_setup(cmp_pe, cmp_pool, cmp_phi, (LAS float*)(lds + RING_OFF), tid);
        for (int it = gw; it < DEC_B * 128; it += NGW) { const int b = it >> 7, i = it & 127; compress_item<true>(cache_kv, page_table, b, i, NC_S, KCS + (size_t)b * NCP_S * 512, (LAS float*)(lds + RING_OFF), wave, lane); }
        __syncthreads();
    }
    SEAM(0);
    if (((PHASE_MASK >> 1) & 1) && IN(1)) {
        pg8::Gemm g{XN, WIN, MPAD, NIN, D_MODEL}; pg8::StaticOrder S; S.init(MPAD, NIN, G, bx);
        epi::EpiInProj E{QB, KVB, U, MG, GT, RSTD1, out};
        pg8::gemm_phase<epi::EpiInProj, pg8::StaticOrder, true, true>(lds + RING_OFF, g, S, E);
    }
    SEAM(1);
    if (((PHASE_MASK >> 2) & 1) && IN(2)) {
#ifndef NO_P2_CMP
        if (vcu < 8) { compress_setup(cmp_pe, cmp_pool, cmp_phi, (LAS float*)(lds + RING_OFF), tid);
            for (int it = gw; it < BATCH * 16; it += NGW) { const int b = it >> 4, i = it & 15; compress_item<false>(out + O_KVP, nullptr, b, i, NC_P, KCP + (size_t)b * NCP_P * 512, (LAS float*)(lds + RING_OFF), wave, lane); } }
#endif
        __syncthreads();
#ifndef NO_P2_SSMP
        for (int it = vcu; it < BATCH * SSM_NG; it += G) ssm_prompt_item(SI, it >> 6, it & 63, U, GY, out, lds + RING_OFF, wave, lane);
#endif
#ifndef NO_P2_SSMS
        for (int it = gw; it < DEC_B * SSM_NG; it += NGW) ssm_sample_item(SI, it >> 6, it & 63, U, st_re, st_im, GY, out, lds + RING_OFF, wave, lane);
#endif
        __syncthreads();
    }
    SEAM(2);
    if (((PHASE_MASK >> 3) & 1) && IN(3)) {
        const AttnP P{QB, KVB, KCP, KCS, GT, cache_kv, state_win, page_table, OB};
        LAS float* W = (LAS float*)(lds + RING_OFF) + wave * AS_WORDS;
        for (int it = gw; it < MROWS * NKV; it += NGW) attn_item_simple(P, it >> 2, it & 3, W, lane);
        __syncthreads();
    }
    SEAM(3);
    if (((PHASE_MASK >> 4) & 1) && IN(4)) {
        pg8::Gemm g{GY, WGLU, MPAD, 4096, 1024}; pg8::StaticOrder S; S.init(MPAD, 4096, G, bx);
        epi::EpiGlu E{MG, MB};
        pg8::gemm_phase<epi::EpiGlu, pg8::StaticOrder, true, true>(lds + RING_OFF, g, S, E);
    }
    SEAM(4);
    if (((PHASE_MASK >> 5) & 1) && IN(5)) {
        pg8::Gemm g{OB, WA, MPAD, 2048, 1024}; pg8::StaticOrder S; S.init(MPAD, 2048, G, bx);
        epi::EpiAttnOut E{MG, MB};
        pg8::gemm_phase<epi::EpiAttnOut, pg8::StaticOrder, true, true>(lds + RING_OFF, g, S, E);
    }
    SEAM(5);
    if (((PHASE_MASK >> 6) & 1) && IN(6)) {
        pg8::Gemm g{MB, WOUT, MPAD, 2048, 2048}; pg8::StaticOrder S; S.init(MPAD, 2048, G, bx);
        epi::EpiWout E{x_prompt, x_sample, X2, XN, SS2};
        pg8::gemm_phase<epi::EpiWout, pg8::StaticOrder, true, true>(lds + RING_OFF, g, S, E);
    }
    SEAM(6);
    if (((PHASE_MASK >> 7) & 1) && IN(7)) {
        pg8::Gemm g{XN, WGU, MPAD, 2 * DFF, 2048}; pg8::StaticOrder S; S.init(MPAD, 2 * DFF, G, bx);
        epi::EpiGateUp E{SS2, HH};
        pg8::gemm_phase<epi::EpiGateUp, pg8::StaticOrder, true, true>(lds + RING_OFF, g, S, E);
    }
    SEAM(7);
    if (((PHASE_MASK >> 8) & 1) && IN(8)) {
        pg8::Gemm g{HH, WDN, MPAD, 2048, DFF}; pg8::StaticOrder S; S.init(MPAD, 2048, G, bx);
        epi::EpiDown E{X2, Y, SS3};
        pg8::gemm_phase<epi::EpiDown, pg8::StaticOrder, true, true>(lds + RING_OFF, g, S, E);
    }
    SEAM(8);
    if (((PHASE_MASK >> 9) & 1) && IN(9)) {
        for (int r = gw; r < MROWS; r += NGW) {
            const float rs = 1.0f / sqrtf(SS3[vgpr_i(r)] * (1.0f / D_MODEL) + EPS);
#ifdef EXP_Y_FROM_X2
            const GAS f32x4* yr = (const GAS f32x4*)(X2 + (size_t)r * D_MODEL) + lane;
#else
            const GAS f32x4* yr = (const GAS f32x4*)(Y + (size_t)r * D_MODEL) + lane;
#endif
            const GAS f32x4* gf = (const GAS f32x4*)g_final + lane;
            GAS f32x4* o = (GAS f32x4*)(r < MP ? out + O_YP + (size_t)r * D_MODEL : out + O_YS + (size_t)(r - MP) * D_MODEL) + lane;
#pragma unroll
#ifdef EXP_Y_FROM_BF
            for (int j = 0; j < 8; ++j) { const int col = (4 * (lane + 64 * j)) % EXP_BF_LD; const bf16* sp = EXP_Y_FROM_BF + (size_t)r * EXP_BF_LD + col;
                o[64 * j] = (f32x4){bf2f(sp[0]), bf2f(sp[1]), bf2f(sp[2]), bf2f(sp[3])}; }
#elif defined(EXP_ZERO_Y)
            for (int j = 0; j < 8; ++j) o[64 * j] = (f32x4){0.f, 0.f, 0.f, 0.f};
#else
            for (int j = 0; j < 8; ++j) o[64 * j] = yr[64 * j] * rs * gf[64 * j];
#endif
        }
    }
#undef IN
#undef SEAM
}

extern "C" void kernel_launch(void* const* d_in, const int* in_sizes, int n_in, void* d_out, int out_size, void* d_ws, size_t ws_size, hipStream_t stream) {
    static int grid = 0;
    if (grid == 0) {
        if (n_in != 28 || ws_size < WS_END) { fprintf(stderr, "kernel_launch: unexpected inputs (n_in %d, ws %zu < %zu)\n", n_in, ws_size, (size_t)WS_END); grid = -1; return; }
        int dev = 0, cus = 0;
        if (hipGetDevice(&dev) != hipSuccess || hipDeviceGetAttribute(&cus, hipDeviceAttributeMultiprocessorCount, dev) != hipSuccess) { grid = -1; return; }
        if (hipFuncSetAttribute((const void*)mega_fwd, hipFuncAttributeMaxDynamicSharedMemorySize, LDS_BYTES) != hipSuccess) { fprintf(stderr, "kernel_launch: hipFuncSetAttribute failed\n"); grid = -1; return; }
        (void)hipGetLastError();
        grid = cus;
    }
    if (grid < 0) return;
    (void)hipMemsetAsync((char*)d_ws + WS_CTL, 0, CTL_ZERO_BYTES, stream);
    Args a{};
    for (int i = 0; i < 28; ++i) a.in[i] = d_in[i];
    a.out = (float*)d_out; a.ws = (unsigned char*)d_ws;
#if MK_N_LAUNCHES == 1
    a.ph_lo = 0; a.ph_hi = N_PHASES;
    hipLaunchKernelGGL(mega_fwd, dim3(grid), dim3(NWAVES * 64), LDS_BYTES, stream, a);
#else
#ifndef EXP_SKIP_LO
#define EXP_SKIP_LO 100
#define EXP_SKIP_HI 100
#endif
    for (int ph = 0; ph < N_PHASES; ++ph) { if (ph >= EXP_SKIP_LO && ph <= EXP_SKIP_HI) continue; a.ph_lo = ph; a.ph_hi = ph + 1; hipLaunchKernelGGL(mega_fwd, dim3(grid), dim3(NWAVES * 64), LDS_BYTES, stream, a); }
#endif
}
```

```cpp
#include <hip/hip_runtime.h>
#include <hip/hip_bf16.h>
#include <cstdio>
#include <cstdint>
constexpr int D_MODEL = 2048, BATCH = 4, SEQ = 2048, DEC_B = 8, DEC_T = 8, PAST = 16384, PAGE = 128, NPAGES = PAST / PAGE;
constexpr int NH = 16, HD = 64, NKV = 4, GRP = 4;
constexpr int SSM_W = 1024, SSM_NG = 64, SSM_P = 64, SSM_C = 16;
constexpr int DFF = 5632;
constexpr int MP = BATCH * SEQ, MS = DEC_B * DEC_T, MROWS = MP + MS, MPAD = 8448;
constexpr int IN_COLS = 7728, NIN = 7936;
constexpr int NC_P = 127, NCP_P = 128, NC_S = 1023, NCP_S = 1024;
constexpr float EPS = 1e-6f;
constexpr size_t O_YP = 0, O_YS = 16777216, O_KVP = 16908288, O_WINP = 25296896, O_HRP = 26345472, O_HIP = 26361856, O_KVS = 26378240, O_WINS = 26443776, O_HRS = 28540928, O_HIS = 28573696;
constexpr size_t al256(size_t x) { return (x + 255) & ~(size_t)255; }
constexpr size_t WS_CTL = 0, CTL_ZERO_BYTES = 1u << 20;
constexpr int CW_TMO = 0, CW_BAR = 4096, CW_SS2 = 65536, CW_SS3 = 81920;
constexpr size_t WS_WIN = CTL_ZERO_BYTES;
constexpr size_t WS_WA = WS_WIN + al256((size_t)NIN * 2048 * 2);
constexpr size_t WS_WGLU = WS_WA + al256((size_t)2048 * 1024 * 2);
constexpr size_t WS_WOUT = WS_WGLU + al256((size_t)4096 * 1024 * 2);
constexpr size_t WS_WGU = WS_WOUT + al256((size_t)2048 * 2048 * 2);
constexpr size_t WS_WDN = WS_WGU + al256((size_t)2 * DFF * 2048 * 2);
constexpr size_t WS_XN = WS_WDN + al256((size_t)2048 * DFF * 2);
constexpr size_t WS_RSTD1 = WS_XN + al256((size_t)MPAD * 2048 * 2);
constexpr size_t WS_QB = WS_RSTD1 + al256((size_t)MPAD * 4);
constexpr size_t WS_KVB = WS_QB + al256((size_t)MPAD * 1024 * 2);
constexpr size_t WS_U = WS_KVB + al256((size_t)MPAD * 1536 * 2);
constexpr size_t WS_MG = WS_U + al256((size_t)MPAD * 1024 * 4);
constexpr size_t WS_GT = WS_MG + al256((size_t)MPAD * 4096 * 2);
constexpr size_t WS_KCP = WS_GT + al256((size_t)MPAD * 64 * 4);
constexpr size_t WS_KCS = WS_KCP + al256((size_t)BATCH * NCP_P * 512 * 4);
constexpr size_t WS_GY = WS_KCS + al256((size_t)DEC_B * NCP_S * 512 * 4);
constexpr size_t WS_OB = WS_GY + al256((size_t)MPAD * 1024 * 2);
constexpr size_t WS_MB = WS_OB + al256((size_t)MPAD * 1024 * 2);
constexpr size_t WS_X2 = WS_MB + al256((size_t)MPAD * 2048 * 2);
constexpr size_t WS_HH = WS_X2 + al256((size_t)MPAD * 2048 * 4);
constexpr size_t WS_Y = WS_HH + al256((size_t)MPAD * DFF * 2);
constexpr size_t WS_END = WS_Y + al256((size_t)MPAD * 2048 * 4);
namespace pg8 {
#define PG8_LAS __attribute__((address_space(3)))
typedef unsigned short bf16_t;
typedef short bf16x8 __attribute__((ext_vector_type(8)));
typedef float f32x4 __attribute__((ext_vector_type(4)));
typedef unsigned u32x4 __attribute__((ext_vector_type(4)));
constexpr int BM = 256, BK = 64, HALF = 128, HTB = HALF * BK * 2  , STAGE_BYTES = 8 * HTB, NXCD = 8, WGM = 8;

__host__ __device__ __forceinline__ int lds_byte(int r, int c) { const int st = (r >> 4) * 2 + (c >> 5), rr = r & 15, cc = c & 31, ob = rr * 64 + cc * 2; return st * 1024 + (ob ^ (((ob >> 9) & 1) << 5)); }
__host__ __device__ __forceinline__ void stage_rc(int b, int& R, int& C) { const int st = b / 1024, sb = b % 1024, swz = sb ^ (((sb >> 9) & 1) << 5); R = (st >> 1) * 16 + swz / 64; C = (st & 1) * 32 + (swz % 64) / 2; }
__host__ __device__ __forceinline__ int perm32(int rho) { const int n = rho >> 4, i = rho & 15; return 8 * (i >> 2) + 4 * n + (i & 3); }

struct Unit { int pm, pn; };
struct Gemm { const bf16_t* A; const bf16_t* Bt; int M, N, K; };

struct StaticOrder {
    int nM, nN, nwg, G, c;
    __host__ __device__ void init(int M, int N, int G_, int c_) { nM = M / BM; nN = N / BM; nwg = nM * nN; G = G_; c = c_; }
    __host__ __device__ bool next(int i, Unit& u) const {
        const long L = (long)i * G + c; if (L >= nwg) return false;
        int wgid = (int)L; { const int q = nwg / NXCD, r = nwg % NXCD, xcd = wgid % NXCD, off = wgid / NXCD; wgid = (xcd < r ? xcd * (q + 1) : r * (q + 1) + (xcd - r) * q) + off; }
        const int nig = WGM * nN, gid = wgid / nig, fm = gid * WGM, gsz = (nM - fm) < WGM ? (nM - fm) : WGM;
        u.pm = fm + ((wgid % nig) % gsz); u.pn = (wgid % nig) / gsz; return true;
    }
    __device__ __forceinline__ void a_ready(const Unit&) const {}
    __device__ __forceinline__ void done(const Unit&) const {}
};

typedef float f32x2_cv __attribute__((ext_vector_type(2))); typedef __bf16 bf16x2_cv __attribute__((ext_vector_type(2)));
__device__ __forceinline__ unsigned cvt_pk_bf16(float lo, float hi) { f32x2_cv v = {lo, hi}; bf16x2_cv b = __builtin_convertvector(v, bf16x2_cv); return __builtin_bit_cast(unsigned, b); }
template <class Epi, class Sched, bool ALIGN_EPI = false, bool SP2 = false>
__device__ __forceinline__ void gemm_phase(PG8_LAS unsigned char* lds, const Gemm g, const Sched& S, const Epi& E) {
    const int tid = threadIdx.x, wid = __builtin_amdgcn_readfirstlane(tid >> 6), lane = tid & 63, wr = wid >> 2, wc = wid & 3, fr = lane & 15, fq = lane >> 4;
    const int K = g.K, nt = K / BK;
    unsigned voffA[2], voffB[2];
#pragma unroll
    for (int i = 0; i < 2; ++i) { int R, C; stage_rc(tid * 16 + i * 8192, R, C); const int Rb = Epi::PERM ? ((R & ~31) + perm32(R & 31)) : R;
        voffA[i] = (unsigned)(R * K + C) * 2u; voffB[i] = (unsigned)(Rb * K + C) * 2u; }
    const size_t kstep = (size_t)(BK * 2);
    const size_t hstep = (size_t)HALF * K * 2;
    const size_t tstep = 2 * hstep;
    const unsigned ldsw = (unsigned)wid * 1024u;
    const int aoff = lds_byte(wr * 64 + fr, fq * 8), boff = lds_byte(wc * 32 + fr, fq * 8);
#define PG8_SA(b, h) (((b) * 2 + (h)) * HTB)
#define PG8_SB(b, h) ((4 + (b) * 2 + (h)) * HTB)
#define PG8_STAGE(bufoff, gbase, voff) do { _Pragma("unroll") for (int _i = 0; _i < 2; ++_i) \
        __builtin_amdgcn_global_load_lds((const unsigned*)((const char*)(gbase) + (voff)[_i]), (PG8_LAS unsigned*)(lds + (bufoff) + ldsw + _i * 8192), 16, 0, 0); } while (0)
#define PG8_LDA(dst, b, h) do { _Pragma("unroll") for (int m = 0; m < 4; ++m) _Pragma("unroll") for (int k = 0; k < 2; ++k) dst[m][k] = *(const PG8_LAS bf16x8*)(lds + PG8_SA(b, h) + aoff + m * 2048 + k * 1024); } while (0)
#define PG8_LDB(dst, b, h) do { _Pragma("unroll") for (int n = 0; n < 2; ++n) _Pragma("unroll") for (int k = 0; k < 2; ++k) dst[n][k] = *(const PG8_LAS bf16x8*)(lds + PG8_SB(b, h) + boff + n * 2048 + k * 1024); } while (0)
#define PG8_MMA(ai, bj, At, Bt) do { __builtin_amdgcn_s_setprio(1); _Pragma("unroll") for (int m = 0; m < 4; ++m) _Pragma("unroll") for (int n = 0; n < 2; ++n) _Pragma("unroll") for (int k = 0; k < 2; ++k) \
        acc[ai][bj][m][n] = __builtin_amdgcn_mfma_f32_16x16x32_bf16(Bt[n][k], At[m][k], acc[ai][bj][m][n], 0, 0, 0); __builtin_amdgcn_s_setprio(0); } while (0)
#define PG8_WAIT_V(n) asm volatile("s_waitcnt vmcnt(" #n ")" ::: "memory")
#define PG8_WAIT_L(n) asm volatile("s_waitcnt lgkmcnt(" #n ")" ::: "memory")
#define PG8_BAR __builtin_amdgcn_s_barrier()
#define PG8_SCHED __builtin_amdgcn_sched_barrier(0)
    Unit cur, nxt; int ui = 0;
    if (!S.next(0, cur)) return;
    f32x4 acc[2][2][4][2];
#pragma unroll
    for (int a = 0; a < 2; ++a)
#pragma unroll
        for (int b = 0; b < 2; ++b)
#pragma unroll
            for (int m = 0; m < 4; ++m)
#pragma unroll
                for (int n = 0; n < 2; ++n) acc[a][b][m][n] = (f32x4){0.f, 0.f, 0.f, 0.f};
    bf16x8 At[4][2], B0[2][2], B1[2][2];
    const char* cA = (const char*)g.A + (size_t)cur.pm * tstep; const char* cB = (const char*)g.Bt + (size_t)cur.pn * tstep;
    S.a_ready(cur);
    if constexpr (SP2) {
        PG8_STAGE(PG8_SB(0, 0), cB, voffB); PG8_STAGE(PG8_SB(0, 1), cB + hstep, voffB); PG8_STAGE(PG8_SA(0, 0), cA, voffA); PG8_STAGE(PG8_SA(0, 1), cA + hstep, voffA);
        if (wr == 1) PG8_BAR;
        PG8_WAIT_V(2); PG8_BAR;
        PG8_STAGE(PG8_SB(1, 0), cB + kstep, voffB); PG8_STAGE(PG8_SA(1, 0), cA + kstep, voffA); PG8_STAGE(PG8_SB(1, 1), cB + hstep + kstep, voffB);
        PG8_WAIT_V(6); PG8_BAR;
    } else {
        PG8_STAGE(PG8_SB(0, 0), cB, voffB); PG8_STAGE(PG8_SA(0, 0), cA, voffA); PG8_STAGE(PG8_SB(0, 1), cB + hstep, voffB); PG8_STAGE(PG8_SA(0, 1), cA + hstep, voffA);
        if (wr == 1) PG8_BAR;
        PG8_WAIT_V(4); PG8_BAR;
        PG8_STAGE(PG8_SB(1, 0), cB + kstep, voffB); PG8_STAGE(PG8_SA(1, 0), cA + kstep, voffA); PG8_STAGE(PG8_SB(1, 1), cB + hstep + kstep, voffB);
        PG8_WAIT_V(6); PG8_BAR;
    }
    for (;;) {
        const bool has_next = S.next(ui + 1, nxt);
        const char* nA = has_next ? (const char*)g.A + (size_t)nxt.pm * tstep : cA; const char* nB = has_next ? (const char*)g.Bt + (size_t)nxt.pn * tstep : cB;
        for (int t = 0; t < nt; t += 2) {
            const bool last = (t == nt - 2);
            const char* a1 = cA + (size_t)(t + 1) * kstep;
            const char* a2 = last ? nA : cA + (size_t)(t + 2) * kstep; const char* b2 = last ? nB : cB + (size_t)(t + 2) * kstep;
            const char* a3 = a2 + kstep; const char* b3 = b2 + kstep;
            if (last && has_next) S.a_ready(nxt);
            if constexpr (SP2) {
            PG8_LDB(B0, 0, 0); PG8_LDB(B1, 0, 1); PG8_SCHED; PG8_LDA(At, 0, 0); PG8_STAGE(PG8_SA(1, 1), a1 + hstep, voffA);
            PG8_WAIT_V(8); PG8_WAIT_L(0); PG8_BAR; PG8_MMA(0, 0, At, B0); PG8_MMA(0, 1, At, B1); PG8_BAR; PG8_SCHED;
            PG8_LDA(At, 0, 1); PG8_STAGE(PG8_SB(0, 0), b2, voffB); PG8_STAGE(PG8_SB(0, 1), b2 + hstep, voffB); PG8_STAGE(PG8_SA(0, 0), a2, voffA);
            PG8_WAIT_V(8); PG8_WAIT_L(0); PG8_BAR; PG8_MMA(1, 0, At, B0); PG8_MMA(1, 1, At, B1); PG8_BAR; PG8_SCHED;
            PG8_LDB(B0, 1, 0); PG8_LDB(B1, 1, 1); PG8_SCHED; PG8_LDA(At, 1, 0); PG8_STAGE(PG8_SA(0, 1), a2 + hstep, voffA);
            PG8_WAIT_V(8); PG8_WAIT_L(0); PG8_BAR; PG8_MMA(0, 0, At, B0); PG8_MMA(0, 1, At, B1); PG8_BAR; PG8_SCHED;
            PG8_LDA(At, 1, 1); PG8_STAGE(PG8_SB(1, 0), b3, voffB); PG8_STAGE(PG8_SB(1, 1), b3 + hstep, voffB); PG8_STAGE(PG8_SA(1, 0), a3, voffA);
            PG8_WAIT_V(8); PG8_WAIT_L(0); PG8_BAR; PG8_MMA(1, 0, At, B0); PG8_MMA(1, 1, At, B1); PG8_BAR; PG8_SCHED;
            } else {
            PG8_LDB(B0, 0, 0); PG8_SCHED; PG8_LDA(At, 0, 0); PG8_STAGE(PG8_SA(1, 1), a1 + hstep, voffA);
            PG8_WAIT_L(8); PG8_BAR; PG8_WAIT_L(0); PG8_MMA(0, 0, At, B0); PG8_BAR; PG8_SCHED;
            PG8_LDB(B1, 0, 1); PG8_STAGE(PG8_SB(0, 0), b2, voffB);
            PG8_BAR; PG8_WAIT_L(0); PG8_MMA(0, 1, At, B1); PG8_BAR;
            PG8_LDA(At, 0, 1); PG8_STAGE(PG8_SA(0, 0), a2, voffA);
            PG8_BAR; PG8_WAIT_L(0); PG8_MMA(1, 0, At, B0); PG8_BAR; PG8_SCHED;
            PG8_STAGE(PG8_SB(0, 1), b2 + hstep, voffB);
            PG8_WAIT_V(6); PG8_BAR; PG8_MMA(1, 1, At, B1); PG8_BAR;
            PG8_LDB(B0, 1, 0); PG8_SCHED; PG8_LDA(At, 1, 0); PG8_STAGE(PG8_SA(0, 1), a2 + hstep, voffA);
            PG8_WAIT_L(8); PG8_BAR; PG8_WAIT_L(0); PG8_MMA(0, 0, At, B0); PG8_BAR; PG8_SCHED;
            PG8_LDB(B1, 1, 1); PG8_STAGE(PG8_SB(1, 0), b3, voffB);
            PG8_BAR; PG8_WAIT_L(0); PG8_MMA(0, 1, At, B1); PG8_BAR;
            PG8_LDA(At, 1, 1); PG8_STAGE(PG8_SA(1, 0), a3, voffA);
            PG8_BAR; PG8_WAIT_L(0); PG8_MMA(1, 0, At, B0); PG8_BAR; PG8_SCHED;
            PG8_STAGE(PG8_SB(1, 1), b3 + hstep, voffB);
            PG8_WAIT_V(6); PG8_BAR; PG8_MMA(1, 1, At, B1); PG8_BAR;
            }
        }
        if constexpr (ALIGN_EPI) { if (wr == 0) PG8_BAR; }
        if constexpr (!Epi::AFTER_DRAIN) { E(acc, cur, wr, wc, fr, fq); S.done(cur); }
        if (!has_next) break;
#pragma unroll
        for (int a = 0; a < 2; ++a)
#pragma unroll
            for (int b = 0; b < 2; ++b)
#pragma unroll
                for (int m = 0; m < 4; ++m)
#pragma unroll
                    for (int n = 0; n < 2; ++n) acc[a][b][m][n] = (f32x4){0.f, 0.f, 0.f, 0.f};
        cur = nxt; cA = nA; cB = nB; ++ui;
        if constexpr (ALIGN_EPI) { if (wr == 1) PG8_BAR; }
    }
    PG8_WAIT_V(0);
    if constexpr (!ALIGN_EPI) { if (wr == 0) PG8_BAR; }
    PG8_BAR;
    if constexpr (Epi::AFTER_DRAIN) { E.fused(acc, cur, wr, wc, fr, fq, lds, wid, lane); S.done(cur); }
#undef PG8_SA
#undef PG8_SB
#undef PG8_STAGE
#undef PG8_LDA
#undef PG8_LDB
#undef PG8_MMA
#undef PG8_WAIT_V
#undef PG8_WAIT_L
#undef PG8_BAR
#undef PG8_SCHED
}
}
#define GAS __attribute__((address_space(1)))
#define LAS __attribute__((address_space(3)))
typedef unsigned short bf16;
typedef unsigned v4u __attribute__((ext_vector_type(4)));
typedef float f32x4 __attribute__((ext_vector_type(4)));
typedef short bf16x8 __attribute__((ext_vector_type(8)));
typedef GAS unsigned gu32;
typedef GAS unsigned long long gu64;
#define RLX_AGENT __ATOMIC_RELAXED, __HIP_MEMORY_SCOPE_AGENT
#define LDS_WAIT() asm volatile("s_waitcnt lgkmcnt(0)" ::: "memory")
#define VM_WAIT() asm volatile("s_waitcnt vmcnt(0)" ::: "memory")
__device__ __forceinline__ unsigned long long rt() { return __builtin_amdgcn_s_memrealtime(); }
__device__ __forceinline__ unsigned f2bf(float f) { unsigned u = __builtin_bit_cast(unsigned, f); return (u + 0x7fffu + ((u >> 16) & 1u)) >> 16; }
__device__ __forceinline__ unsigned pk2(float lo, float hi) { return f2bf(lo) | (f2bf(hi) << 16); }

#define XB_TMO      128
#define XB_XCNT(j)  (256  + 64 * (j))
#define XB_XSUB(j)  (1280 + 64 * (j))
#define XB_XGEN(j)  (2304 + 64 * (j))
#define XB_TOP      3328
#define XB_TOPGEN   3392
#define XCD_BAR_WORDS 3456
#define XB_SPIN_CAP (1u << 18)

__device__ __forceinline__ unsigned xb_ld(unsigned* p)              { return __hip_atomic_load(p, __ATOMIC_RELAXED, __HIP_MEMORY_SCOPE_AGENT); }
__device__ __forceinline__ unsigned xb_add(unsigned* p, unsigned v) { return __hip_atomic_fetch_add(p, v, __ATOMIC_RELAXED, __HIP_MEMORY_SCOPE_AGENT); }
__device__ __forceinline__ unsigned xb_xcc_id() { return (unsigned)__builtin_amdgcn_s_getreg((3 << 11) | 20) & 0xFu; }
#define XB_SPIN(cond, bar) do { unsigned _sp = 0; while (cond) { __builtin_amdgcn_s_sleep(1); \
    if ((++_sp & 255u) == 0u) { if (xb_ld(&(bar)[XB_TMO])) break; if (_sp > XB_SPIN_CAP) { atomicAdd(&(bar)[XB_TMO], 1u); break; } } } } while (0)

struct XcdBarrier {
    unsigned* bar; unsigned x;
    volatile LAS unsigned* st;
};

__device__ __forceinline__ XcdBarrier xcd_barrier_post(unsigned* bar, volatile LAS unsigned* st) {
    XcdBarrier b; b.bar = bar; b.x = xb_xcc_id(); b.st = st;
    if (threadIdx.x == 0) (void)xb_add(&bar[XB_XCNT(b.x)], 1u);
    return b;
}
__device__ __forceinline__ void xcd_barrier_complete(unsigned* bar, unsigned x, unsigned& nloc, unsigned& nx) {
    const unsigned G = gridDim.x * gridDim.y * gridDim.z;
    unsigned sum, cnt, mine, sp = 0u;
    for (;;) {
        sum = 0u; cnt = 0u; mine = 0u;
#pragma unroll
        for (unsigned j = 0; j < 16; ++j) { const unsigned c = xb_ld(&bar[XB_XCNT(j)]); sum += c; cnt += (c > 0u) ? 1u : 0u; mine = (j == x) ? c : mine; }
        if (sum == G) break;
        __builtin_amdgcn_s_sleep(1);
        if ((++sp & 255u) == 0u) { if (xb_ld(&bar[XB_TMO])) break; if (sp > XB_SPIN_CAP) { atomicAdd(&bar[XB_TMO], 1u); break; } }
    }
    nloc = mine > 0u ? mine : 1u; nx = cnt > 0u ? cnt : 1u;
}

__device__ __forceinline__ void xcd_barrier(const XcdBarrier& b) {
    asm volatile("s_waitcnt vmcnt(0)" ::: "memory");
    __syncthreads();
    if (threadIdx.x == 0) {
        unsigned* bar = b.bar;
        __builtin_amdgcn_s_waitcnt(0);
        unsigned nloc = b.st[0], nx = b.st[1];
        if (nloc == 0u) { xcd_barrier_complete(bar, b.x, nloc, nx); b.st[0] = nloc; b.st[1] = nx; }
        const unsigned old = xb_add(&bar[XB_XSUB(b.x)], 1u);
        const unsigned gen = old / nloc;
        if (old + 1u == (gen + 1u) * nloc) {
            __builtin_amdgcn_fence(__ATOMIC_RELEASE, "agent");
            asm volatile("s_waitcnt vmcnt(0)" ::: "memory");
            const unsigned og = xb_add(&bar[XB_TOP], 1u);
            const unsigned tg = og / nx;
            if (og + 1u == (tg + 1u) * nx) xb_add(&bar[XB_TOPGEN], 1u);
            else XB_SPIN(xb_ld(&bar[XB_TOPGEN]) == tg, bar);
            __builtin_amdgcn_fence(__ATOMIC_ACQUIRE, "agent");
            xb_add(&bar[XB_XGEN(b.x)], 1u);
            asm volatile("s_waitcnt vmcnt(0)" ::: "memory");
        } else {
            XB_SPIN(xb_ld(&bar[XB_XGEN(b.x)]) == gen, bar);
            __builtin_amdgcn_fence(__ATOMIC_ACQUIRE, "agent");
            asm volatile("s_waitcnt vmcnt(0)" ::: "memory");
        }
    }
    __syncthreads();
}
namespace epi {
using pg8::f32x4; using pg8::Unit; using pg8::bf16_t; using pg8::u32x4; using pg8::cvt_pk_bf16;
__device__ __forceinline__ float sigm(float x) { return __builtin_amdgcn_rcpf(1.f + __builtin_amdgcn_exp2f(-1.4426950408889634f * x)); }
__device__ __forceinline__ f32x4 sigm4(f32x4 v) { return (f32x4){sigm(v[0]), sigm(v[1]), sigm(v[2]), sigm(v[3])}; }
__device__ __forceinline__ u32x4 pack8(f32x4 a, f32x4 b) { u32x4 w; w.x = cvt_pk_bf16(a[0], a[1]); w.y = cvt_pk_bf16(a[2], a[3]); w.z = cvt_pk_bf16(b[0], b[1]); w.w = cvt_pk_bf16(b[2], b[3]); return w; }
__device__ __forceinline__ void unpack8(u32x4 w, f32x4& a, f32x4& b) {
    a[0] = __uint_as_float(w.x << 16); a[1] = __uint_as_float(w.x & 0xffff0000u); a[2] = __uint_as_float(w.y << 16); a[3] = __uint_as_float(w.y & 0xffff0000u);
    b[0] = __uint_as_float(w.z << 16); b[1] = __uint_as_float(w.z & 0xffff0000u); b[2] = __uint_as_float(w.w << 16); b[3] = __uint_as_float(w.w & 0xffff0000u); }

struct EpiInProj { static constexpr bool PERM = true, AFTER_DRAIN = false;
    bf16_t* Qb; bf16_t* KVb; float* U; bf16_t* MG; float* GT; const float* rstd; float* out;
    __device__ __forceinline__ void operator()(const f32x4 (&acc)[2][2][4][2], const Unit& u, int wr, int wc, int fr, int fq) const {
        const int pn = u.pn, row0 = u.pm * 256 + wr * 64 + fr, c0 = wc * 32 + 8 * fq;
#pragma unroll
        for (int ai = 0; ai < 2; ++ai)
#pragma unroll
            for (int m = 0; m < 4; ++m) { const int r = row0 + ai * 128 + m * 16; const bool ok = r < MROWS; const float rs = rstd[r];
#pragma unroll
                for (int bj = 0; bj < 2; ++bj) { f32x4 v0 = acc[ai][bj][m][0] * rs, v1 = acc[ai][bj][m][1] * rs; const int c = c0 + bj * 128;
                    if (!ok) continue;
                    if (pn < 4) { *(u32x4*)(Qb + (size_t)r * 1024 + pn * 256 + c) = pack8(v0, v1); }
                    else if (pn < 10) { const int slot = pn - 4; *(u32x4*)(KVb + (size_t)r * 1536 + slot * 256 + c) = pack8(v0, v1);
                        float* dst = nullptr;
                        if (slot < 4) dst = (r < MP) ? out + O_KVP + (size_t)r * 1024 + slot * 256 + c : out + O_KVS + (size_t)(r - MP) * 1024 + slot * 256 + c;
                        else if (r < MP) { const int t = r & (SEQ - 1); if (t >= SEQ - 512) dst = out + O_WINP + ((size_t)((r >> 11) * 512 + (t - (SEQ - 512))) * 2 + (slot - 4)) * 256 + c; }
                        else { const int q = r - MP; dst = out + O_WINS + ((size_t)((q >> 3) * 512 + 504 + (q & 7)) * 2 + (slot - 4)) * 256 + c; }
                        if (dst) { *(f32x4*)dst = v0; *(f32x4*)(dst + 4) = v1; } }
                    else if (pn < 14) { float* dst = U + (size_t)r * 1024 + (pn - 10) * 256 + c; *(f32x4*)dst = v0; *(f32x4*)(dst + 4) = v1; }
                    else if (pn < 30) { *(u32x4*)(MG + (size_t)r * 4096 + (pn - 14) * 256 + c) = pack8(sigm4(v0), sigm4(v1)); }
                    else if (c < 48) { float* dst = GT + (size_t)r * 64 + c; *(f32x4*)dst = sigm4(v0); *(f32x4*)(dst + 4) = sigm4(v1); } } }
    }
};
struct EpiGlu { static constexpr bool PERM = true, AFTER_DRAIN = false;
    const bf16_t* MG; bf16_t* MB;
    __device__ __forceinline__ void operator()(const f32x4 (&acc)[2][2][4][2], const Unit& u, int wr, int wc, int fr, int fq) const {
        const int row0 = u.pm * 256 + wr * 64 + fr, col = u.pn * 128 + wc * 32 + 8 * fq;
#pragma unroll
        for (int ai = 0; ai < 2; ++ai)
#pragma unroll
            for (int m = 0; m < 4; ++m) { const int r = row0 + ai * 128 + m * 16; if (r >= MROWS) continue;
                f32x4 s0, s1; unpack8(*(const u32x4*)(MG + (size_t)r * 4096 + 2048 + col), s0, s1);
                const f32x4 y0 = acc[ai][0][m][0] * sigm4(acc[ai][1][m][0]) * s0, y1 = acc[ai][0][m][1] * sigm4(acc[ai][1][m][1]) * s1;
                *(u32x4*)(MB + (size_t)r * 2048 + col) = pack8(y0, y1); }
    }
};
struct EpiAttnOut { static constexpr bool PERM = true, AFTER_DRAIN = false;
    const bf16_t* MG; bf16_t* MB;
    __device__ __forceinline__ void operator()(const f32x4 (&acc)[2][2][4][2], const Unit& u, int wr, int wc, int fr, int fq) const {
        const int row0 = u.pm * 256 + wr * 64 + fr, col0 = u.pn * 256 + wc * 32 + 8 * fq;
#pragma unroll
        for (int ai = 0; ai < 2; ++ai)
#pragma unroll
            for (int m = 0; m < 4; ++m) { const int r = row0 + ai * 128 + m * 16; if (r >= MROWS) continue;
#pragma unroll
                for (int bj = 0; bj < 2; ++bj) { const int col = col0 + bj * 128;
                    f32x4 s0, s1, b0, b1; unpack8(*(const u32x4*)(MG + (size_t)r * 4096 + col), s0, s1); unpack8(*(const u32x4*)(MB + (size_t)r * 2048 + col), b0, b1);
                    *(u32x4*)(MB + (size_t)r * 2048 + col) = pack8(b0 + s0 * acc[ai][bj][m][0], b1 + s1 * acc[ai][bj][m][1]); } }
    }
};
struct EpiWout { static constexpr bool PERM = true, AFTER_DRAIN = false;
    const float* xp; const float* xs; float* X2; bf16_t* XN; float* ss;
    __device__ __forceinline__ void operator()(const f32x4 (&acc)[2][2][4][2], const Unit& u, int wr, int wc, int fr, int fq) const {
        const int row0 = u.pm * 256 + wr * 64 + fr, col0 = u.pn * 256 + wc * 32 + 8 * fq;
#pragma unroll
        for (int ai = 0; ai < 2; ++ai)
#pragma unroll
            for (int m = 0; m < 4; ++m) { const int r = row0 + ai * 128 + m * 16; const bool ok = r < MROWS; float s = 0.f;
                const float* xr = (r < MP) ? xp + (size_t)r * 2048 : xs + (size_t)(ok ? r - MP : 0) * 2048;
#pragma unroll
                for (int bj = 0; bj < 2; ++bj) { const int col = col0 + bj * 128;
                    f32x4 v0 = acc[ai][bj][m][0], v1 = acc[ai][bj][m][1];
                    if (ok) { v0 += *(const f32x4*)(xr + col); v1 += *(const f32x4*)(xr + col + 4);
                        float* d = X2 + (size_t)r * 2048 + col; *(f32x4*)d = v0; *(f32x4*)(d + 4) = v1; *(u32x4*)(XN + (size_t)r * 2048 + col) = pack8(v0, v1); }
                    s += (v0[0] * v0[0] + v0[1] * v0[1]) + (v0[2] * v0[2] + v0[3] * v0[3]) + (v1[0] * v1[0] + v1[1] * v1[1]) + (v1[2] * v1[2] + v1[3] * v1[3]); }
                s += __shfl_xor(s, 16); s += __shfl_xor(s, 32);
                if (ok && fq == 0) atomicAdd(ss + r, s); }
    }
};
struct EpiGateUp { static constexpr bool PERM = true, AFTER_DRAIN = false;
    const float* ss; bf16_t* HH;
    __device__ __forceinline__ void operator()(const f32x4 (&acc)[2][2][4][2], const Unit& u, int wr, int wc, int fr, int fq) const {
        const int row0 = u.pm * 256 + wr * 64 + fr, col = u.pn * 128 + wc * 32 + 8 * fq;
#pragma unroll
        for (int ai = 0; ai < 2; ++ai)
#pragma unroll
            for (int m = 0; m < 4; ++m) { const int r = row0 + ai * 128 + m * 16; if (r >= MROWS) continue;
                const float rs = 1.0f / sqrtf(ss[r] * (1.0f / 2048.0f) + EPS);
                const f32x4 g0 = acc[ai][0][m][0] * rs, g1 = acc[ai][0][m][1] * rs, u0 = acc[ai][1][m][0] * rs, u1 = acc[ai][1][m][1] * rs;
                *(u32x4*)(HH + (size_t)r * DFF + col) = pack8(g0 * sigm4(g0) * u0, g1 * sigm4(g1) * u1); }
    }
};
struct EpiDown { static constexpr bool PERM = true, AFTER_DRAIN = false;
    const float* X2; float* Y; float* ss;
    __device__ __forceinline__ void operator()(const f32x4 (&acc)[2][2][4][2], const Unit& u, int wr, int wc, int fr, int fq) const {
        const int row0 = u.pm * 256 + wr * 64 + fr, col0 = u.pn * 256 + wc * 32 + 8 * fq;
#pragma unroll
        for (int ai = 0; ai < 2; ++ai)
#pragma unroll
            for (int m = 0; m < 4; ++m) { const int r = row0 + ai * 128 + m * 16; const bool ok = r < MROWS; float s = 0.f;
#pragma unroll
                for (int bj = 0; bj < 2; ++bj) { const int col = col0 + bj * 128;
                    f32x4 v0 = acc[ai][bj][m][0], v1 = acc[ai][bj][m][1];
                    if (ok) { const float* xr = X2 + (size_t)r * 2048 + col; v0 += *(const f32x4*)xr; v1 += *(const f32x4*)(xr + 4);
                        float* d = Y + (size_t)r * 2048 + col; *(f32x4*)d = v0; *(f32x4*)(d + 4) = v1; }
                    s += (v0[0] * v0[0] + v0[1] * v0[1]) + (v0[2] * v0[2] + v0[3] * v0[3]) + (v1[0] * v1[0] + v1[1] * v1[1]) + (v1[2] * v1[2] + v1[3] * v1[3]); }
                s += __shfl_xor(s, 16); s += __shfl_xor(s, 32);
                if (ok && fq == 0) atomicAdd(ss + r, s); }
    }
};
}
constexpr int RING_OFF = 0, RING_BYTES = 131072;
constexpr int LDSCTL_OFF = RING_BYTES, MISC_OFF = LDSCTL_OFF + 320;
constexpr int LDS_BYTES = 147456;
constexpr int NWAVES = 8;
typedef float f32x2v __attribute__((ext_vector_type(2)));

#define WSYNC() do { asm volatile("s_waitcnt lgkmcnt(0)" ::: "memory"); __builtin_amdgcn_wave_barrier(); asm volatile("" ::: "memory"); } while (0)
__device__ __forceinline__ int vgpr_i(int x) { asm volatile("" : "+v"(x)); return x; }
__device__ __forceinline__ float bf2f(unsigned short h) { return __uint_as_float((unsigned)h << 16); }
__device__ __forceinline__ float wave_sum(float v) {
#pragma unroll
    for (int o = 1; o < 64; o <<= 1) v += __shfl_xor(v, o);
    return v; }
__device__ __forceinline__ float wave_max(float v) {
#pragma unroll
    for (int o = 1; o < 64; o <<= 1) v = fmaxf(v, __shfl_xor(v, o));
    return v; }
__device__ __forceinline__ float fsigm(float x) { return __builtin_amdgcn_rcpf(1.f + __builtin_amdgcn_exp2f(-1.4426950408889634f * x)); }
__device__ __forceinline__ float gelu_tanh(float x) { return x * fsigm(1.5957691216057308f * (x + 0.044715f * x * x * x)); }
__device__ __forceinline__ float fexp(float x) { return __builtin_amdgcn_exp2f(1.4426950408889634f * x); }

struct TrJob { const float* W0; const float* W1; const float* g; bf16* WT; int K, Nsrc, Ndst, kind; };
__device__ __forceinline__ const float* tr_src(const TrJob& j, int n) {
    switch (j.kind) {
    default: return n < j.Nsrc ? j.W0 + n : nullptr;
    case 1: { if (n < 2560) return j.W0 + n; if (n < 3584) return j.W0 + 2608 + (n - 2560); if (n < 7680) return j.W0 + 3632 + (n - 3584); if (n < 7728) return j.W0 + 2560 + (n - 7680); return nullptr; }
    case 2: { const int pn = n >> 8, w = n & 255; return j.W0 + (w < 128 ? 128 * pn + w : 2048 + 128 * pn + (w - 128)); }
    case 3: { const int pn = n >> 8, w = n & 255; return w < 128 ? j.W0 + 128 * pn + w : j.W1 + 128 * pn + (w - 128); }
    }
}
__device__ __forceinline__ void tr_item(const TrJob& j, int item, LAS unsigned* scr, int lane) {
    const int nblk = j.Ndst / 64, kb = item / nblk, nb = item % nblk, k0 = 64 * kb, n0 = 64 * nb;
    const float* src = tr_src(j, n0 + lane); const float msk = src ? 1.f : 0.f; if (!src) src = j.W0;
    src += (size_t)k0 * j.Nsrc;
#pragma unroll 8
    for (int i = 0; i < 32; ++i) { float a = src[(size_t)(2 * i) * j.Nsrc] * msk, b = src[(size_t)(2 * i + 1) * j.Nsrc] * msk;
        if (j.g) { a *= j.g[k0 + 2 * i]; b *= j.g[k0 + 2 * i + 1]; }
        scr[i * 65 + lane] = pk2(a, b); }
    LDS_WAIT(); __builtin_amdgcn_wave_barrier(); asm volatile("" ::: "memory");
    const int c = lane & 7;
#pragma unroll
    for (int jj = 0; jj < 8; ++jj) { const int n = 8 * jj + (lane >> 3); const LAS unsigned* s = scr + (4 * c) * 65 + n;
        v4u o; o.x = s[0]; o.y = s[65]; o.z = s[130]; o.w = s[195];
        *(GAS v4u*)(j.WT + (size_t)(n0 + n) * j.K + k0 + 8 * c) = o; }
    LDS_WAIT(); __builtin_amdgcn_wave_barrier(); asm volatile("" ::: "memory");
}
__device__ __forceinline__ void xn_row(const float* xrow, bf16* orow, float* rstd_out, int lane) {
    GAS unsigned long long* o8 = (GAS unsigned long long*)orow + lane;
    if (!xrow) {
#pragma unroll
        for (int j = 0; j < 8; ++j) o8[64 * j] = 0ull;
        if (lane == 0) *rstd_out = 0.f; return; }
    const GAS f32x4* xr = (const GAS f32x4*)xrow + lane; f32x4 v[8]; float s = 0.f;
#pragma unroll
    for (int j = 0; j < 8; ++j) { v[j] = xr[64 * j]; s += (v[j].x * v[j].x + v[j].y * v[j].y) + (v[j].z * v[j].z + v[j].w * v[j].w); }
    s = wave_sum(s);
#pragma unroll
    for (int j = 0; j < 8; ++j) o8[64 * j] = (unsigned long long)pk2(v[j].x, v[j].y) | ((unsigned long long)pk2(v[j].z, v[j].w) << 32);
    if (lane == 0) *rstd_out = 1.0f / sqrtf(s * (1.0f / D_MODEL) + EPS);
}

constexpr int CMP_PHI = 0, CMP_POOL = 8192, CMP_CST = 8256, CMP_GS = 8384;
__device__ __forceinline__ void compress_setup(const float* pe, const float* pool, const float* phi, LAS float* L, int tid) {
    for (int i = tid; i < 8192; i += NWAVES * 64) L[CMP_PHI + i] = phi[i];
    if (tid < 64) L[CMP_POOL + tid] = pool[tid];
    if (tid < 128) { const int w = tid >> 6, d = tid & 63; float s = 0.f;
        for (int j = 0; j < 32; ++j) s += pool[w * 32 + j] * pe[(w * 32 + j) * 64 + d];
        L[CMP_CST + tid] = s; }
    __syncthreads();
}
template <bool SAMPLE> __device__ __forceinline__ void compress_item(const float* rows, const int* pt, int b, int i, int nc, bf16* KC, LAS float* L, int wave, int lane) {
    const int which = lane >> 5;
    f32x4 plo0 = {0.f, 0.f, 0.f, 0.f}, plo1 = plo0;
    const int m_end = (8 * i + 8 < nc) ? 8 * i + 8 : nc;
    for (int m = 8 * i; m <= m_end; ++m) {
        const float* base;
        if (SAMPLE) { const int pos = 16 * m; const int phys = pt[b * NPAGES + (pos >> 7)]; base = rows + ((size_t)phys * PAGE + (pos & (PAGE - 1))) * 1024 + 8 * lane; }
        else base = rows + ((size_t)b * SEQ + 16 * m) * 1024 + 8 * lane;
        f32x4 lo0 = {0.f, 0.f, 0.f, 0.f}, lo1 = lo0, hi0 = lo0, hi1 = lo0;
#pragma unroll
        for (int j = 0; j < 16; ++j) { const f32x4 v0 = *(const f32x4*)(base + (size_t)j * 1024), v1 = *(const f32x4*)(base + (size_t)j * 1024 + 4);
            const float pl = L[CMP_POOL + which * 32 + j], ph = L[CMP_POOL + which * 32 + 16 + j];
            lo0 += pl * v0; lo1 += pl * v1; hi0 += ph * v0; hi1 += ph * v1; }
        if (m > 8 * i) { const int c = m - 1;
            const f32x4 c0 = *(const LAS f32x4*)(L + CMP_CST + which * 64 + 8 * (lane & 7)), c1 = *(const LAS f32x4*)(L + CMP_CST + which * 64 + 8 * (lane & 7) + 4);
            f32x4 g0 = plo0 + hi0 + c0, g1 = plo1 + hi1 + c1;
#pragma unroll
            for (int e = 0; e < 4; ++e) { g0[e] = gelu_tanh(g0[e]); g1[e] = gelu_tanh(g1[e]); }
            LAS float* Gs = L + CMP_GS + wave * 512;
            *(LAS f32x4*)(Gs + 8 * lane) = g0; *(LAS f32x4*)(Gs + 8 * lane + 4) = g1;
            WSYNC();
            f32x4 a0 = {0.f, 0.f, 0.f, 0.f}, a1 = a0; const LAS float* gr = Gs + (lane >> 3) * 64; const LAS float* ph = L + CMP_PHI + which * 4096 + 8 * (lane & 7);
#pragma unroll 8
            for (int d = 0; d < 64; ++d) { const float gv = gr[d]; a0 += gv * *(const LAS f32x4*)(ph + d * 64); a1 += gv * *(const LAS f32x4*)(ph + d * 64 + 4); }
            { v4u w; w.x = pk2(a0[0], a0[1]); w.y = pk2(a0[2], a0[3]); w.z = pk2(a1[0], a1[1]); w.w = pk2(a1[2], a1[3]); *(GAS v4u*)(KC + (size_t)c * 512 + 8 * lane) = w; }
            WSYNC(); }
        plo0 = lo0; plo1 = lo1;
    }
}

struct SsmIn { const float *lam_re, *lam_im, *log_dt, *b_re, *b_im, *c_re, *c_im, *dsk; };
struct SsmC { float ar, ai, dsk; f32x2v bb[16]; float cm[32]; };
__device__ __forceinline__ void ssm_consts(const SsmIn& I, int g, int lane, SsmC& C) {
    const int p = lane; const float dt = expf(I.log_dt[g]), lr = I.lam_re[g * 64 + p], li = I.lam_im[g * 64 + p];
    const float mag = expf(lr * dt); float sn, cs; sincosf(li * dt, &sn, &cs);
    C.ar = mag * cs; C.ai = mag * sn;
    const float den = lr * lr + li * li, fr = ((C.ar - 1.f) * lr + C.ai * li) / den, fi = (C.ai * lr - (C.ar - 1.f) * li) / den;
#pragma unroll
    for (int c4 = 0; c4 < 4; ++c4) { const f32x4 br = *(const f32x4*)(I.b_re + (size_t)(g * 64 + p) * 16 + 4 * c4), bi = *(const f32x4*)(I.b_im + (size_t)(g * 64 + p) * 16 + 4 * c4);
#pragma unroll
        for (int e = 0; e < 4; ++e) C.bb[4 * c4 + e] = (f32x2v){fr * br[e] - fi * bi[e], fr * bi[e] + fi * br[e]}; }
    const int c = lane & 15, q = lane >> 4;
#pragma unroll
    for (int k4 = 0; k4 < 4; ++k4) { const f32x4 cr = *(const f32x4*)(I.c_re + (size_t)(g * 16 + c) * 64 + 16 * q + 4 * k4), ci = *(const f32x4*)(I.c_im + (size_t)(g * 16 + c) * 64 + 16 * q + 4 * k4);
#pragma unroll
        for (int e = 0; e < 4; ++e) { C.cm[8 * k4 + 2 * e] = cr[e]; C.cm[8 * k4 + 2 * e + 1] = -ci[e]; } }
    C.dsk = I.dsk[g * 16 + c];
}
__device__ __forceinline__ f32x4 ssm_y16(const LAS float* Hs, const SsmC& C, int lane) {
    const int trow = lane & 15, q = lane >> 4; f32x4 d = {0.f, 0.f, 0.f, 0.f};
#pragma unroll
    for (int k4 = 0; k4 < 8; ++k4) { const f32x4 a = *(const LAS f32x4*)(Hs + trow * 132 + 32 * q + 4 * k4);
#pragma unroll
        for (int e = 0; e < 4; ++e) d = __builtin_amdgcn_mfma_f32_16x16x4f32(a[e], C.cm[4 * k4 + e], d, 0, 0, 0); }
    return d;
}
constexpr int SSM_US = 0, SSM_HS = 16384, SSM_HEND = SSM_HS + 8 * 8448;
__device__ __forceinline__ void ssm_prompt_item(const SsmIn& I, int b, int g, const float* U, bf16* GY, float* out, LAS unsigned char* lds, int wave, int lane) {
    SsmC C; ssm_consts(I, g, lane, C);
    float a32r = C.ar, a32i = C.ai;
#pragma unroll
    for (int s = 0; s < 5; ++s) { const float nr = a32r * a32r - a32i * a32i, ni = 2.f * a32r * a32i; a32r = nr; a32i = ni; }
    LAS float* uS = (LAS float*)(lds + SSM_US) + wave * 512; LAS float* Hs = (LAS float*)(lds + SSM_HS) + wave * 2112; LAS float* hend = (LAS float*)(lds + SSM_HEND);
    float cr = 0.f, ci = 0.f;
#pragma unroll 1
    for (int sb = 0; sb < SEQ / 256; ++sb) {
        const int row0 = b * SEQ + sb * 256 + wave * 32;
#pragma unroll
        for (int h = 0; h < 2; ++h) { const int tt = (lane >> 2) + 16 * h; *(LAS f32x4*)(uS + tt * 16 + 4 * (lane & 3)) = *(const f32x4*)(U + (size_t)(row0 + tt) * 1024 + g * 16 + 4 * (lane & 3)); }
        WSYNC();
        f32x2v x[32];
#pragma unroll
        for (int i = 0; i < 32; ++i) { f32x2v sx = {0.f, 0.f}; asm volatile("" ::: "memory");
#pragma unroll
            for (int c4 = 0; c4 < 4; ++c4) { const f32x4 u4 = *(const LAS f32x4*)(uS + i * 16 + 4 * c4);
#pragma unroll
                for (int e = 0; e < 4; ++e) sx += u4[e] * C.bb[4 * c4 + e]; }
            x[i] = sx; }
        const f32x2v A1 = {C.ar, C.ar}, A2 = {-C.ai, C.ai};
        f32x2v h = {0.f, 0.f};
#pragma unroll
        for (int i = 0; i < 32; ++i) { const f32x2v hs = __builtin_shufflevector(h, h, 1, 0); h = A1 * h + (A2 * hs + x[i]); }
        const float hr = h.x, hi = h.y;
        *(LAS f32x2v*)(hend + (wave * 64 + lane) * 2) = (f32x2v){hr, hi};
        __syncthreads();
        float chr = cr, chi = ci, cinr = 0.f, cini = 0.f;
#pragma unroll
        for (int w = 0; w < 8; ++w) { if (w == wave) { cinr = chr; cini = chi; }
            const f32x2v e = *(const LAS f32x2v*)(hend + (w * 64 + lane) * 2);
            const float nr = a32r * chr - a32i * chi + e.x, ni = a32r * chi + a32i * chr + e.y; chr = nr; chi = ni; }
        cr = chr; ci = chi; h = (f32x2v){cinr, cini};
#pragma unroll
        for (int half = 0; half < 2; ++half) {
#pragma unroll
            for (int i = 0; i < 16; ++i) { const int ii = half * 16 + i; const f32x2v hs = __builtin_shufflevector(h, h, 1, 0); h = A1 * h + (A2 * hs + x[ii]);
                *(LAS f32x2v*)(Hs + i * 132 + 2 * lane) = h; }
            WSYNC();
            const f32x4 d = ssm_y16(Hs, C, lane); const int c = lane & 15, q = lane >> 4;
#pragma unroll
            for (int r = 0; r < 4; ++r) { const int tt = half * 16 + 4 * q + r; const float y = d[r] + C.dsk * uS[tt * 16 + c];
                GY[(size_t)(row0 + tt) * 1024 + g * 16 + c] = (bf16)f2bf(gelu_tanh(y)); }
            WSYNC();
        }
        __syncthreads();
    }
    if (wave == 0) { out[O_HRP + (size_t)(b * 64 + g) * 64 + lane] = cr; out[O_HIP + (size_t)(b * 64 + g) * 64 + lane] = ci; }
}
__device__ __forceinline__ void ssm_sample_item(const SsmIn& I, int b, int g, const float* U, const float* h0r, const float* h0i, bf16* GY, float* out, LAS unsigned char* lds, int wave, int lane) {
    SsmC C; ssm_consts(I, g, lane, C);
    LAS float* uS = (LAS float*)(lds + SSM_US) + wave * 512; LAS float* Hs = (LAS float*)(lds + SSM_HS) + wave * 2112;
    const int row0 = MP + b * DEC_T;
    if (lane < 32) { const int tt = lane >> 2; *(LAS f32x4*)(uS + tt * 16 + 4 * (lane & 3)) = *(const f32x4*)(U + (size_t)(row0 + tt) * 1024 + g * 16 + 4 * (lane & 3)); }
    WSYNC();
    float hr = h0r[(size_t)(b * 64 + g) * 64 + lane], hi = h0i[(size_t)(b * 64 + g) * 64 + lane];
#pragma unroll
    for (int i = 0; i < 16; ++i) {
        if (i < DEC_T) { f32x2v sx = {0.f, 0.f};
#pragma unroll
            for (int c4 = 0; c4 < 4; ++c4) { const f32x4 u4 = *(const LAS f32x4*)(uS + i * 16 + 4 * c4);
#pragma unroll
                for (int e = 0; e < 4; ++e) sx += u4[e] * C.bb[4 * c4 + e]; }
            const float nr = C.ar * hr - C.ai * hi + sx.x, ni = C.ar * hi + C.ai * hr + sx.y; hr = nr; hi = ni; }
        *(LAS f32x2v*)(Hs + i * 132 + 2 * lane) = (i < DEC_T) ? (f32x2v){hr, hi} : (f32x2v){0.f, 0.f}; }
    WSYNC();
    out[O_HRS + (size_t)(b * 64 + g) * 64 + lane] = hr; out[O_HIS + (size_t)(b * 64 + g) * 64 + lane] = hi;
    const f32x4 d = ssm_y16(Hs, C, lane); const int c = lane & 15, q = lane >> 4;
#pragma unroll
    for (int r = 0; r < 4; ++r) { const int tt = 4 * q + r; if (tt < DEC_T) { const float y = d[r] + C.dsk * uS[tt * 16 + c];
        GY[(size_t)(row0 + tt) * 1024 + g * 16 + c] = (bf16)f2bf(gelu_tanh(y)); } }
    WSYNC();
}

constexpr int AS_QS = 0, AS_PS = 256, AS_PSUM = 512, AS_IMP = 1536, AS_SEL = 1800, AS_WORDS = 2048;
__device__ __forceinline__ void ld8(bool bf, const void* base, size_t off, float (&k)[8]) {
    if (bf) { const v4u w = *(const v4u*)((const bf16*)base + off);
        k[0] = __uint_as_float(w.x << 16); k[1] = __uint_as_float(w.x & 0xffff0000u); k[2] = __uint_as_float(w.y << 16); k[3] = __uint_as_float(w.y & 0xffff0000u);
        k[4] = __uint_as_float(w.z << 16); k[5] = __uint_as_float(w.z & 0xffff0000u); k[6] = __uint_as_float(w.w << 16); k[7] = __uint_as_float(w.w & 0xffff0000u); }
    else { const f32x4 a = *(const f32x4*)((const float*)base + off), b = *(const f32x4*)((const float*)base + off + 4);
        k[0] = a[0]; k[1] = a[1]; k[2] = a[2]; k[3] = a[3]; k[4] = b[0]; k[5] = b[1]; k[6] = b[2]; k[7] = b[3]; }
}
__device__ __forceinline__ float ld1(bool bf, const void* base, size_t off) { return bf ? bf2f(((const bf16*)base)[off]) : ((const float*)base)[off]; }
template <int MODE> __device__ __forceinline__ void att_chunk(bool bf, const void* kb, int stride, int c_lo, int c_hi, int kp0, int kstep, int pc,
        const float (&sl)[4], LAS float* W, float (&m)[4], float (&l)[4], float (&acc)[4], LAS float* psum, int lane) {
    const bool valid = lane >= c_lo && lane < c_hi;
    float s[4] = {0.f, 0.f, 0.f, 0.f};
    if (valid) {
#pragma unroll 1
        for (int hh = 0; hh < 2; ++hh) {
            float kk[4][8];
#pragma unroll
            for (int i = 0; i < 4; ++i) ld8(bf, kb, (size_t)lane * stride + 32 * hh + 8 * i, kk[i]);
#pragma unroll
            for (int i = 0; i < 4; ++i) { const float (&k)[8] = kk[i];
#pragma unroll
                for (int n = 0; n < 4; ++n) { asm volatile("" ::: "memory");
                    const f32x4 qa = *(const LAS f32x4*)(W + AS_QS + n * 64 + 32 * hh + 8 * i), qb = *(const LAS f32x4*)(W + AS_QS + n * 64 + 32 * hh + 8 * i + 4);
                    s[n] += (k[0] * qa[0] + k[1] * qa[1]) + (k[2] * qa[2] + k[3] * qa[3]) + (k[4] * qb[0] + k[5] * qb[1]) + (k[6] * qb[2] + k[7] * qb[3]); } }
            asm volatile("" ::: "memory"); } }
    const float dist = (float)(pc - (kp0 + kstep * lane));
#pragma unroll
    for (int n = 0; n < 4; ++n) s[n] = valid ? s[n] * 0.125f - sl[n] * dist : -INFINITY;
    if (MODE == 1) {
#pragma unroll
        for (int n = 0; n < 4; ++n) { const float mn = fmaxf(m[n], wave_max(s[n])); const float sc = (m[n] == -INFINITY) ? 0.f : fexp(m[n] - mn);
            l[n] = l[n] * sc + wave_sum(valid ? fexp(s[n] - mn) : 0.f); m[n] = mn; }
        return; }
    f32x4 p;
    if (MODE == 0) {
#pragma unroll
        for (int n = 0; n < 4; ++n) { const float mn = fmaxf(m[n], wave_max(s[n])); const float sc = (m[n] == -INFINITY) ? 0.f : fexp(m[n] - mn);
            p[n] = valid ? fexp(s[n] - mn) : 0.f; l[n] = l[n] * sc + wave_sum(p[n]); acc[n] *= sc; m[n] = mn; }
    } else {
#pragma unroll
        for (int n = 0; n < 4; ++n) p[n] = valid ? fexp(s[n] - m[n]) * l[n] : 0.f;
        psum[lane] = (p[0] + p[1]) + (p[2] + p[3]);
    }
    *(LAS f32x4*)(W + AS_PS + 4 * lane) = p;
    WSYNC();
#pragma unroll 2
    for (int c = c_lo; c < c_hi; ++c) { const float v = ld1(bf, kb, (size_t)c * stride + 256 + lane); const f32x4 pp = *(const LAS f32x4*)(W + AS_PS + 4 * c);
#pragma unroll
        for (int n = 0; n < 4; ++n) acc[n] += pp[n] * v; }
    WSYNC();
}
struct AttnP { const bf16* Qb; const bf16* KVb; const bf16* KCP; const bf16* KCS; const float* GT; const float* cache; const float* swin; const int* pt; bf16* OB; };
__device__ __forceinline__ void attn_item_simple(const AttnP& P, int r, int g, LAS float* W, int lane) {
    const bool sample = r >= MP; const int q_ = r - MP;
    const int b = sample ? (q_ >> 3) : (r >> 11), t = sample ? (q_ & 7) : (r & (SEQ - 1)), pc = sample ? PAST + t : t;
    const int rowbase = sample ? MP + b * DEC_T : b * SEQ;
    float sl[4];
#pragma unroll
    for (int n = 0; n < 4; ++n) { W[AS_QS + n * 64 + lane] = bf2f(P.Qb[(size_t)r * 1024 + (4 * g + n) * 64 + lane]); sl[n] = exp2f(-0.5f * (float)(4 * g + n + 1)); }
    WSYNC();
    float ot[4] = {0.f, 0.f, 0.f, 0.f};
    const int gi = vgpr_i(r * 64 + 4 * g);
    const int ncmax = sample ? NC_S : NC_P; int ncv = pc >= 31 ? (pc - 31) / 16 + 1 : 0; if (ncv > ncmax) ncv = ncmax;
    const bf16* kc = sample ? P.KCS + (size_t)b * NCP_S * 512 : P.KCP + (size_t)b * NCP_P * 512;
    if (ncv > 0) { float m[4] = {-INFINITY, -INFINITY, -INFINITY, -INFINITY}, l[4] = {0.f, 0.f, 0.f, 0.f}, oc[4] = {0.f, 0.f, 0.f, 0.f};
#pragma unroll 1
        for (int c0 = 0; c0 < ncv; c0 += 64) att_chunk<1>(true, kc + (size_t)c0 * 512 + g * 64, 512, 0, (ncv - c0 < 64) ? ncv - c0 : 64, 16 * c0 + 31, 16, pc, sl, W, m, l, oc, nullptr, lane);
#pragma unroll
        for (int n = 0; n < 4; ++n) l[n] = 1.0f / l[n];
#pragma unroll 1
        for (int c0 = 0; c0 < ncv; c0 += 64) att_chunk<2>(true, kc + (size_t)c0 * 512 + g * 64, 512, 0, (ncv - c0 < 64) ? ncv - c0 : 64, 16 * c0 + 31, 16, pc, sl, W, m, l, oc, W + AS_PSUM + c0, lane);
#pragma unroll
        for (int n = 0; n < 4; ++n) ot[n] = P.GT[gi + n] * oc[n]; }
    const int ns = sample ? 257 : 32, cur = pc >> 6;
    for (int s = lane; s < ns; s += 64) { float v;
        if (s > cur) v = -1.f; else if (s == 0 || s == cur || s == cur - 1) v = 1e4f;
        else { v = 0.f; for (int c = 4 * s - 1; c <= 4 * s + 3; ++c) v += W[AS_PSUM + c]; }
        W[AS_IMP + s] = v; }
    WSYNC();
    int nsel = 0;
#pragma unroll 1
    for (int it = 0; it < 16; ++it) { float bv = -3.f; int bi = 1 << 30;
        for (int s = lane; s < ns; s += 64) { const float v = W[AS_IMP + s]; if (v > bv) { bv = v; bi = s; } }
#pragma unroll
        for (int o = 1; o < 64; o <<= 1) { const float ov = __shfl_xor(bv, o); const int oi = __shfl_xor(bi, o); if (ov > bv || (ov == bv && oi < bi)) { bv = ov; bi = oi; } }
        if (bv < 0.f) break;
        if (lane == 0) { ((LAS int*)W)[AS_SEL + nsel] = bi; W[AS_IMP + bi] = -2.f; }
        WSYNC(); ++nsel; }
    const int lo = pc - 511 > 0 ? pc - 511 : 0;
#pragma unroll 1
    for (int br = 0; br < 2; ++br) {
        float m[4] = {-INFINITY, -INFINITY, -INFINITY, -INFINITY}, l[4] = {0.f, 0.f, 0.f, 0.f}, o[4] = {0.f, 0.f, 0.f, 0.f};
        int nch;
        if (br == 0) nch = nsel; else if (!sample) nch = (pc >> 6) - (lo >> 6) + 1; else nch = (512 - ((t + 1) & ~63)) / 64 + 1;
#pragma unroll 1
        for (int i = 0; i < nch; ++i) {
            bool bf = true; const void* kb; int stride = 1536, c_lo = 0, c_hi = 64, kp0;
            const bf16* newrows = P.KVb + (size_t)rowbase * 1536 + (2 + 2 * br) * 256 + g * 64;
            if (br == 0) { const int blk = __builtin_amdgcn_readfirstlane(((LAS int*)W)[AS_SEL + i]); kp0 = blk * 64;
                if (!sample) { kb = newrows + (size_t)kp0 * 1536; c_hi = (pc - kp0 + 1 < 64) ? pc - kp0 + 1 : 64; }
                else if (blk == 256) { kb = newrows; c_hi = t + 1; }
                else { const int phys = P.pt[b * NPAGES + (kp0 >> 7)]; kb = P.cache + ((size_t)phys * PAGE + (kp0 & (PAGE - 1))) * 1024 + 2 * 256 + g * 64; bf = false; stride = 1024; } }
            else if (!sample) { kp0 = (lo & ~63) + 64 * i; kb = newrows + (size_t)kp0 * 1536; c_lo = lo - kp0 > 0 ? lo - kp0 : 0; c_hi = (pc - kp0 + 1 < 64) ? pc - kp0 + 1 : 64; }
            else if (i < nch - 1) { const int i0 = ((t + 1) & ~63) + 64 * i; kb = P.swin + ((size_t)(b * 512 + i0) * 2) * 256 + g * 64; bf = false; stride = 512; c_lo = t + 1 - i0 > 0 ? t + 1 - i0 : 0; kp0 = PAST - 512 + i0; }
            else { kb = newrows; c_hi = t + 1; kp0 = PAST; }
            att_chunk<0>(bf, kb, stride, c_lo, c_hi, kp0, 1, pc, sl, W, m, l, o, nullptr, lane);
        }
#pragma unroll
        for (int n = 0; n < 4; ++n) ot[n] += P.GT[gi + 16 * (br + 1) + n] * o[n] / l[n];
    }
#pragma unroll
    for (int n = 0; n < 4; ++n) P.OB[(size_t)r * 1024 + (4 * g + n) * 64 + lane] = (bf16)f2bf(ot[n]);
    WSYNC();
}
#ifndef MK_N_LAUNCHES
#define MK_N_LAUNCHES 1
#endif
constexpr int N_PHASES = 10;
#ifndef PHASE_MASK
#define PHASE_MASK 0x3ff
#endif
struct Args { const void* in[28]; float* out; unsigned char* ws; int ph_lo, ph_hi; };
__global__ void __launch_bounds__(NWAVES * 64, 2) mega_fwd(Args args) {
    extern __shared__ __attribute__((aligned(16))) unsigned char lds_raw[];
    LAS unsigned char* lds = (LAS unsigned char*)lds_raw;
    volatile LAS unsigned* MISC = (volatile LAS unsigned*)(lds + MISC_OFF);
    const int tid = threadIdx.x, lane = tid & 63, wave = __builtin_amdgcn_readfirstlane(tid >> 6);
    const int G = gridDim.x; const int bx = blockIdx.x; const int vcu = (G % 8 == 0) ? (bx % 8) * (G / 8) + bx / 8 : bx;
    const int gw = vcu * NWAVES + wave, NGW = G * NWAVES;
    unsigned char* ws = args.ws; float* out = args.out;
    gu32* ctl = (gu32*)(ws + WS_CTL);
    const float* x_prompt = (const float*)args.in[0]; const float* x_sample = (const float*)args.in[1]; const float* cache_kv = (const float*)args.in[2]; const float* state_win = (const float*)args.in[3];
    const float* st_re = (const float*)args.in[4]; const float* st_im = (const float*)args.in[5]; const int* page_table = (const int*)args.in[6];
    const float* g_mix = (const float*)args.in[7]; const float* w_in = (const float*)args.in[8]; const float* cmp_pe = (const float*)args.in[9]; const float* cmp_pool = (const float*)args.in[10]; const float* cmp_phi = (const float*)args.in[11];
    const float* w_attn_out = (const float*)args.in[12];
    const SsmIn SI{(const float*)args.in[13], (const float*)args.in[14], (const float*)args.in[15], (const float*)args.in[16], (const float*)args.in[17], (const float*)args.in[18], (const float*)args.in[19], (const float*)args.in[20]};
    const float* w_glu = (const float*)args.in[21]; const float* w_out = (const float*)args.in[22]; const float* g_ffn = (const float*)args.in[23];
    const float* w_gate = (const float*)args.in[24]; const float* w_up = (const float*)args.in[25]; const float* w_down = (const float*)args.in[26]; const float* g_final = (const float*)args.in[27];
    bf16* WIN = (bf16*)(ws + WS_WIN); bf16* WA = (bf16*)(ws + WS_WA); bf16* WGLU = (bf16*)(ws + WS_WGLU); bf16* WOUT = (bf16*)(ws + WS_WOUT); bf16* WGU = (bf16*)(ws + WS_WGU); bf16* WDN = (bf16*)(ws + WS_WDN);
    bf16* XN = (bf16*)(ws + WS_XN); float* RSTD1 = (float*)(ws + WS_RSTD1); bf16* QB = (bf16*)(ws + WS_QB); bf16* KVB = (bf16*)(ws + WS_KVB); float* U = (float*)(ws + WS_U);
    bf16* MG = (bf16*)(ws + WS_MG); float* GT = (float*)(ws + WS_GT); bf16* KCP = (bf16*)(ws + WS_KCP); bf16* KCS = (bf16*)(ws + WS_KCS); bf16* GY = (bf16*)(ws + WS_GY);
    bf16* OB = (bf16*)(ws + WS_OB); bf16* MB = (bf16*)(ws + WS_MB); float* X2 = (float*)(ws + WS_X2); bf16* HH = (bf16*)(ws + WS_HH); float* Y = (float*)(ws + WS_Y);
    float* SS2 = (float*)(ws + WS_CTL) + CW_SS2; float* SS3 = (float*)(ws + WS_CTL) + CW_SS3;

    for (int u = tid; u < (LDS_BYTES - LDSCTL_OFF) / 4; u += NWAVES * 64) ((LAS unsigned*)(lds + LDSCTL_OFF))[u] = 0u;
    __syncthreads();
    const int lo = args.ph_lo, hi = args.ph_hi;
    XcdBarrier bar; bar.bar = (unsigned*)(ctl + CW_BAR); bar.x = 0; bar.st = nullptr;
    if (hi - lo > 1) bar = xcd_barrier_post((unsigned*)(ctl + CW_BAR), MISC + 8);
#define IN(k) (lo <= (k) && (k) < hi)
#define SEAM(k) do { if (IN(k) && IN((k) + 1)) xcd_barrier(bar); } while (0)

    if (((PHASE_MASK >> 0) & 1) && IN(0)) {
        LAS unsigned* scr = (LAS unsigned*)(lds + RING_OFF) + wave * (32 * 65);
        constexpr int I0 = 32 * 124, I1 = 16 * 32, I2 = 16 * 64, I3 = 32 * 32, I4 = 32 * 176, I5 = 88 * 32, ITOT = I0 + I1 + I2 + I3 + I4 + I5;
        for (int it = gw; it < ITOT; it += NGW) { int r = it;
            if (r < I0) { const TrJob j{w_in, nullptr, g_mix, WIN, 2048, IN_COLS, NIN, 1}; tr_item(j, r, scr, lane); continue; } r -= I0;
            if (r < I1) { const TrJob j{w_attn_out, nullptr, nullptr, WA, 1024, 2048, 2048, 0}; tr_item(j, r, scr, lane); continue; } r -= I1;
            if (r < I2) { const TrJob j{w_glu, nullptr, nullptr, WGLU, 1024, 4096, 4096, 2}; tr_item(j, r, scr, lane); continue; } r -= I2;
            if (r < I3) { const TrJob j{w_out, nullptr, nullptr, WOUT, 2048, 2048, 2048, 0}; tr_item(j, r, scr, lane); continue; } r -= I3;
            if (r < I4) { const TrJob j{w_gate, w_up, g_ffn, WGU, 2048, DFF, 2 * DFF, 3}; tr_item(j, r, scr, lane); continue; } r -= I4;
            { const TrJob j{w_down, nullptr, nullptr, WDN, DFF, 2048, 2048, 0}; tr_item(j, r, scr, lane); } }
        for (int m = gw; m < MPAD; m += NGW) xn_row(m < MP ? x_prompt + (size_t)m * D_MODEL : (m < MROWS ? x_sample + (size_t)(m - MP) * D_MODEL : nullptr), XN + (size_t)m * D_MODEL, RSTD1 + m, lane);
        for (int i4 = (vcu * NWAVES * 64 + tid); i4 < DEC_B * 504 * 128; i4 += G * NWAVES * 64) { const int b = i4 / (504 * 128), rem = i4 - b * (504 * 128);
            *(GAS f32x4*)(out + O_WINS + (size_t)b * 512 * 512 + (size_t)rem * 4) = *(const GAS f32x4*)(state_win + (size_t)b * 512 * 512 + 8 * 512 + (size_t)rem * 4); }
        __syncthreads();
        compress_setup(cmp_pe, cmp_pool, cmp_phi, (LAS float*)(lds + RING_OFF), tid);
        for (int it = gw; it < DEC_B * 128; it += NGW) { const int b = it >> 7, i = it & 127; compress_item<true>(cache_kv, page_table, b, i, NC_S, KCS + (size_t)b * NCP_S * 512, (LAS float*)(lds + RING_OFF), wave, lane); }
        __syncthreads();
    }
    SEAM(0);
    if (((PHASE_MASK >> 1) & 1) && IN(1)) {
        pg8::Gemm g{XN, WIN, MPAD, NIN, D_MODEL}; pg8::StaticOrder S; S.init(MPAD, NIN, G, bx);
        epi::EpiInProj E{QB, KVB, U, MG, GT, RSTD1, out};
        pg8::gemm_phase<epi::EpiInProj, pg8::StaticOrder, true, true>(lds + RING_OFF, g, S, E);
    }
    SEAM(1);
    if (((PHASE_MASK >> 2) & 1) && IN(2)) {
#ifndef NO_P2_CMP
        if (vcu < 8) { compress_setup(cmp_pe, cmp_pool, cmp_phi, (LAS float*)(lds + RING_OFF), tid);
            for (int it = gw; it < BATCH * 16; it += NGW) { const int b = it >> 4, i = it & 15; compress_item<false>(out + O_KVP, nullptr, b, i, NC_P, KCP + (size_t)b * NCP_P * 512, (LAS float*)(lds + RING_OFF), wave, lane); } }
#endif
        __syncthreads();
#ifndef NO_P2_SSMP
        for (int it = vcu; it < BATCH * SSM_NG; it += G) ssm_prompt_item(SI, it >> 6, it & 63, U, GY, out, lds + RING_OFF, wave, lane);
#endif
#ifndef NO_P2_SSMS
        for (int it = gw; it < DEC_B * SSM_NG; it += NGW) ssm_sample_item(SI, it >> 6, it & 63, U, st_re, st_im, GY, out, lds + RING_OFF, wave, lane);
#endif
        __syncthreads();
    }
    SEAM(2);
    if (((PHASE_MASK >> 3) & 1) && IN(3)) {
        const AttnP P{QB, KVB, KCP, KCS, GT, cache_kv, state_win, page_table, OB};
        LAS float* W = (LAS float*)(lds + RING_OFF) + wave * AS_WORDS;
        for (int it = gw; it < MROWS * NKV; it += NGW) attn_item_simple(P, it >> 2, it & 3, W, lane);
        __syncthreads();
    }
    SEAM(3);
    if (((PHASE_MASK >> 4) & 1) && IN(4)) {
        pg8::Gemm g{GY, WGLU, MPAD, 4096, 1024}; pg8::StaticOrder S; S.init(MPAD, 4096, G, bx);
        epi::EpiGlu E{MG, MB};
        pg8::gemm_phase<epi::EpiGlu, pg8::StaticOrder, true, true>(lds + RING_OFF, g, S, E);
    }
    SEAM(4);
    if (((PHASE_MASK >> 5) & 1) && IN(5)) {
        pg8::Gemm g{OB, WA, MPAD, 2048, 1024}; pg8::StaticOrder S; S.init(MPAD, 2048, G, bx);
        epi::EpiAttnOut E{MG, MB};
        pg8::gemm_phase<epi::EpiAttnOut, pg8::StaticOrder, true, true>(lds + RING_OFF, g, S, E);
    }
    SEAM(5);
    if (((PHASE_MASK >> 6) & 1) && IN(6)) {
        pg8::Gemm g{MB, WOUT, MPAD, 2048, 2048}; pg8::StaticOrder S; S.init(MPAD, 2048, G, bx);
        epi::EpiWout E{x_prompt, x_sample, X2, XN, SS2};
        pg8::gemm_phase<epi::EpiWout, pg8::StaticOrder, true, true>(lds + RING_OFF, g, S, E);
    }
    SEAM(6);
    if (((PHASE_MASK >> 7) & 1) && IN(7)) {
        pg8::Gemm g{XN, WGU, MPAD, 2 * DFF, 2048}; pg8::StaticOrder S; S.init(MPAD, 2 * DFF, G, bx);
        epi::EpiGateUp E{SS2, HH};
        pg8::gemm_phase<epi::EpiGateUp, pg8::StaticOrder, true, true>(lds + RING_OFF, g, S, E);
    }
    SEAM(7);
    if (((PHASE_MASK >> 8) & 1) && IN(8)) {
        pg8::Gemm g{HH, WDN, MPAD, 2048, DFF}; pg8::StaticOrder S; S.init(MPAD, 2048, G, bx);
        epi::EpiDown E{X2, Y, SS3};
        pg8::gemm_phase<epi::EpiDown, pg8::StaticOrder, true, true>(lds + RING_OFF, g, S, E);
    }
    SEAM(8);
    if (((PHASE_MASK >> 9) & 1) && IN(9)) {
        for (int r = gw; r < MROWS; r += NGW) {
            const float rs = 1.0f / sqrtf(SS3[vgpr_i(r)] * (1.0f / D_MODEL) + EPS);
#ifdef EXP_Y_FROM_X2
            const GAS f32x4* yr = (const GAS f32x4*)(X2 + (size_t)r * D_MODEL) + lane;
#else
            const GAS f32x4* yr = (const GAS f32x4*)(Y + (size_t)r * D_MODEL) + lane;
#endif
            const GAS f32x4* gf = (const GAS f32x4*)g_final + lane;
            GAS f32x4* o = (GAS f32x4*)(r < MP ? out + O_YP + (size_t)r * D_MODEL : out + O_YS + (size_t)(r - MP) * D_MODEL) + lane;
#pragma unroll
#ifdef EXP_Y_FROM_BF
            for (int j = 0; j < 8; ++j) { const int col = (4 * (lane + 64 * j)) % EXP_BF_LD; const bf16* sp = EXP_Y_FROM_BF + (size_t)r * EXP_BF_LD + col;
                o[64 * j] = (f32x4){bf2f(sp[0]), bf2f(sp[1]), bf2f(sp[2]), bf2f(sp[3])}; }
#elif defined(EXP_ZERO_Y)
            for (int j = 0; j < 8; ++j) o[64 * j] = (f32x4){0.f, 0.f, 0.f, 0.f};
#else
            for (int j = 0; j < 8; ++j) o[64 * j] = yr[64 * j] * rs * gf[64 * j];
#endif
        }
    }
#undef IN
#undef SEAM
}

extern "C" void kernel_launch(void* const* d_in, const int* in_sizes, int n_in, void* d_out, int out_size, void* d_ws, size_t ws_size, hipStream_t stream) {
    static int grid = 0;
    if (grid == 0) {
        if (n_in != 28 || ws_size < WS_END) { fprintf(stderr, "kernel_launch: unexpected inputs (n_in %d, ws %zu < %zu)\n", n_in, ws_size, (size_t)WS_END); grid = -1; return; }
        int dev = 0, cus = 0;
        if (hipGetDevice(&dev) != hipSuccess || hipDeviceGetAttribute(&cus, hipDeviceAttributeMultiprocessorCount, dev) != hipSuccess) { grid = -1; return; }
        if (hipFuncSetAttribute((const void*)mega_fwd, hipFuncAttributeMaxDynamicSharedMemorySize, LDS_BYTES) != hipSuccess) { fprintf(stderr, "kernel_launch: hipFuncSetAttribute failed\n"); grid = -1; return; }
        (void)hipGetLastError();
        grid = cus;
    }
    if (grid < 0) return;
    (void)hipMemsetAsync((char*)d_ws + WS_CTL, 0, CTL_ZERO_BYTES, stream);
    Args a{};
    for (int i = 0; i < 28; ++i) a.in[i] = d_in[i];
    a.out = (float*)d_out; a.ws = (unsigned char*)d_ws;
#if MK_N_LAUNCHES == 1
    a.ph_lo = 0; a.ph_hi = N_PHASES;
    hipLaunchKernelGGL(mega_fwd, dim3(grid), dim3(NWAVES * 64), LDS_BYTES, stream, a);
#else
#ifndef EXP_SKIP_LO
#define EXP_SKIP_LO 100
#define EXP_SKIP_HI 100
#endif
    for (int ph = 0; ph < N_PHASES; ++ph) { if (ph >= EXP_SKIP_LO && ph <= EXP_SKIP_HI) continue; a.ph_lo = ph; a.ph_hi = ph + 1; hipLaunchKernelGGL(mega_fwd, dim3(grid), dim3(NWAVES * 64), LDS_BYTES, stream, a); }
#endif
}
```

```cpp
#include <hip/hip_runtime.h>
#include <hip/hip_bf16.h>
#include <cstdio>
#include <cstdint>
constexpr int D_MODEL = 2048, BATCH = 4, SEQ = 2048, DEC_B = 8, DEC_T = 8, PAST = 16384, PAGE = 128, NPAGES = PAST / PAGE;
constexpr int NH = 16, HD = 64, NKV = 4, GRP = 4;
constexpr int SSM_W = 1024, SSM_NG = 64, SSM_P = 64, SSM_C = 16;
constexpr int DFF = 5632;
constexpr int MP = BATCH * SEQ, MS = DEC_B * DEC_T, MROWS = MP + MS, MPAD = 8448;
constexpr int IN_COLS = 7728, NIN = 7936;
constexpr int NC_P = 127, NCP_P = 128, NC_S = 1023, NCP_S = 1024;
constexpr float EPS = 1e-6f;
constexpr size_t O_YP = 0, O_YS = 16777216, O_KVP = 16908288, O_WINP = 25296896, O_HRP = 26345472, O_HIP = 26361856, O_KVS = 26378240, O_WINS = 26443776, O_HRS = 28540928, O_HIS = 28573696;
constexpr size_t al256(size_t x) { return (x + 255) & ~(size_t)255; }
constexpr size_t WS_CTL = 0, CTL_ZERO_BYTES = 1u << 20;
constexpr int CW_TMO = 0, CW_Q = 512, CW_BAR = 4096, CW_SS2 = 65536, CW_SS3 = 81920;
constexpr size_t WS_WIN = CTL_ZERO_BYTES;
constexpr size_t WS_WA = WS_WIN + al256((size_t)NIN * 2048 * 2);
constexpr size_t WS_WGLU = WS_WA + al256((size_t)2048 * 1024 * 2);
constexpr size_t WS_WOUT = WS_WGLU + al256((size_t)4096 * 1024 * 2);
constexpr size_t WS_WGU = WS_WOUT + al256((size_t)2048 * 2048 * 2);
constexpr size_t WS_WDN = WS_WGU + al256((size_t)2 * DFF * 2048 * 2);
constexpr size_t WS_XN = WS_WDN + al256((size_t)2048 * DFF * 2);
constexpr size_t WS_RSTD1 = WS_XN + al256((size_t)MPAD * 2048 * 2);
constexpr size_t WS_QB = WS_RSTD1 + al256((size_t)MPAD * 4);
constexpr size_t WS_KVB = WS_QB + al256((size_t)MPAD * 1024 * 2);
constexpr size_t WS_U = WS_KVB + al256((size_t)MPAD * 1536 * 2);
constexpr size_t WS_MG = WS_U + al256((size_t)MPAD * 1024 * 4);
constexpr size_t WS_GT = WS_MG + al256((size_t)MPAD * 4096 * 2);
constexpr size_t WS_KCP = WS_GT + al256((size_t)MPAD * 64 * 4);
constexpr size_t WS_KCS = WS_KCP + al256((size_t)BATCH * NCP_P * 512 * 4);
constexpr size_t WS_GY = WS_KCS + al256((size_t)DEC_B * NCP_S * 512 * 4);
constexpr size_t WS_OB = WS_GY + al256((size_t)MPAD * 1024 * 2);
constexpr size_t WS_MB = WS_OB + al256((size_t)MPAD * 1024 * 2);
constexpr size_t WS_X2 = WS_MB + al256((size_t)MPAD * 2048 * 2);
constexpr size_t WS_HH = WS_X2 + al256((size_t)MPAD * 2048 * 4);
constexpr size_t WS_Y = WS_HH + al256((size_t)MPAD * DFF * 2);
constexpr size_t WS_END = WS_Y + al256((size_t)MPAD * 2048 * 4);
namespace pg8 {
#define PG8_LAS __attribute__((address_space(3)))
typedef unsigned short bf16_t;
typedef short bf16x8 __attribute__((ext_vector_type(8)));
typedef float f32x4 __attribute__((ext_vector_type(4)));
typedef unsigned u32x4 __attribute__((ext_vector_type(4)));
constexpr int BM = 256, BK = 64, HALF = 128, HTB = HALF * BK * 2  , STAGE_BYTES = 8 * HTB, NXCD = 8, WGM = 8;

__host__ __device__ __forceinline__ int lds_byte(int r, int c) { const int st = (r >> 4) * 2 + (c >> 5), rr = r & 15, cc = c & 31, ob = rr * 64 + cc * 2; return st * 1024 + (ob ^ (((ob >> 9) & 1) << 5)); }
__host__ __device__ __forceinline__ void stage_rc(int b, int& R, int& C) { const int st = b / 1024, sb = b % 1024, swz = sb ^ (((sb >> 9) & 1) << 5); R = (st >> 1) * 16 + swz / 64; C = (st & 1) * 32 + (swz % 64) / 2; }
__host__ __device__ __forceinline__ int perm32(int rho) { const int n = rho >> 4, i = rho & 15; return 8 * (i >> 2) + 4 * n + (i & 3); }

struct Unit { int pm, pn; };
struct Gemm { const bf16_t* A; const bf16_t* Bt; int M, N, K; };

struct StaticOrder {
    int nM, nN, nwg, G, c;
    __host__ __device__ void init(int M, int N, int G_, int c_) { nM = M / BM; nN = N / BM; nwg = nM * nN; G = G_; c = c_; }
    __host__ __device__ bool next(int i, Unit& u) const {
        const long L = (long)i * G + c; if (L >= nwg) return false;
        int wgid = (int)L; { const int q = nwg / NXCD, r = nwg % NXCD, xcd = wgid % NXCD, off = wgid / NXCD; wgid = (xcd < r ? xcd * (q + 1) : r * (q + 1) + (xcd - r) * q) + off; }
        const int nig = WGM * nN, gid = wgid / nig, fm = gid * WGM, gsz = (nM - fm) < WGM ? (nM - fm) : WGM;
        u.pm = fm + ((wgid % nig) % gsz); u.pn = (wgid % nig) / gsz; return true;
    }
    __device__ __forceinline__ void a_ready(const Unit&) const {}
    __device__ __forceinline__ void done(const Unit&) const {}
};

typedef float f32x2_cv __attribute__((ext_vector_type(2))); typedef __bf16 bf16x2_cv __attribute__((ext_vector_type(2)));
__device__ __forceinline__ unsigned cvt_pk_bf16(float lo, float hi) { f32x2_cv v = {lo, hi}; bf16x2_cv b = __builtin_convertvector(v, bf16x2_cv); return __builtin_bit_cast(unsigned, b); }
template <class Epi, class Sched, bool ALIGN_EPI = false, bool SP2 = false>
__device__ __forceinline__ void gemm_phase(PG8_LAS unsigned char* lds, const Gemm g, const Sched& S, const Epi& E) {
    const int tid = threadIdx.x, wid = __builtin_amdgcn_readfirstlane(tid >> 6), lane = tid & 63, wr = wid >> 2, wc = wid & 3, fr = lane & 15, fq = lane >> 4;
    const int K = g.K, nt = K / BK;
    unsigned voffA[2], voffB[2];
#pragma unroll
    for (int i = 0; i < 2; ++i) { int R, C; stage_rc(tid * 16 + i * 8192, R, C); const int Rb = Epi::PERM ? ((R & ~31) + perm32(R & 31)) : R;
        voffA[i] = (unsigned)(R * K + C) * 2u; voffB[i] = (unsigned)(Rb * K + C) * 2u; }
    const size_t kstep = (size_t)(BK * 2);
    const size_t hstep = (size_t)HALF * K * 2;
    const size_t tstep = 2 * hstep;
    const unsigned ldsw = (unsigned)wid * 1024u;
    const int aoff = lds_byte(wr * 64 + fr, fq * 8), boff = lds_byte(wc * 32 + fr, fq * 8);
#define PG8_SA(b, h) (((b) * 2 + (h)) * HTB)
#define PG8_SB(b, h) ((4 + (b) * 2 + (h)) * HTB)
#define PG8_STAGE(bufoff, gbase, voff) do { _Pragma("unroll") for (int _i = 0; _i < 2; ++_i) \
        __builtin_amdgcn_global_load_lds((const unsigned*)((const char*)(gbase) + (voff)[_i]), (PG8_LAS unsigned*)(lds + (bufoff) + ldsw + _i * 8192), 16, 0, 0); } while (0)
#define PG8_LDA(dst, b, h) do { _Pragma("unroll") for (int m = 0; m < 4; ++m) _Pragma("unroll") for (int k = 0; k < 2; ++k) dst[m][k] = *(const PG8_LAS bf16x8*)(lds + PG8_SA(b, h) + aoff + m * 2048 + k * 1024); } while (0)
#define PG8_LDB(dst, b, h) do { _Pragma("unroll") for (int n = 0; n < 2; ++n) _Pragma("unroll") for (int k = 0; k < 2; ++k) dst[n][k] = *(const PG8_LAS bf16x8*)(lds + PG8_SB(b, h) + boff + n * 2048 + k * 1024); } while (0)
#define PG8_MMA(ai, bj, At, Bt) do { __builtin_amdgcn_s_setprio(1); _Pragma("unroll") for (int m = 0; m < 4; ++m) _Pragma("unroll") for (int n = 0; n < 2; ++n) _Pragma("unroll") for (int k = 0; k < 2; ++k) \
        acc[ai][bj][m][n] = __builtin_amdgcn_mfma_f32_16x16x32_bf16(Bt[n][k], At[m][k], acc[ai][bj][m][n], 0, 0, 0); __builtin_amdgcn_s_setprio(0); } while (0)
#define PG8_WAIT_V(n) asm volatile("s_waitcnt vmcnt(" #n ")" ::: "memory")
#define PG8_WAIT_L(n) asm volatile("s_waitcnt lgkmcnt(" #n ")" ::: "memory")
#define PG8_BAR __builtin_amdgcn_s_barrier()
#define PG8_SCHED __builtin_amdgcn_sched_barrier(0)
    Unit cur, nxt; int ui = 0;
    if (!S.next(0, cur)) return;
    f32x4 acc[2][2][4][2];
#pragma unroll
    for (int a = 0; a < 2; ++a)
#pragma unroll
        for (int b = 0; b < 2; ++b)
#pragma unroll
            for (int m = 0; m < 4; ++m)
#pragma unroll
                for (int n = 0; n < 2; ++n) acc[a][b][m][n] = (f32x4){0.f, 0.f, 0.f, 0.f};
    bf16x8 At[4][2], B0[2][2], B1[2][2];
    const char* cA = (const char*)g.A + (size_t)cur.pm * tstep; const char* cB = (const char*)g.Bt + (size_t)cur.pn * tstep;
    S.a_ready(cur);
    if constexpr (SP2) {
        PG8_STAGE(PG8_SB(0, 0), cB, voffB); PG8_STAGE(PG8_SB(0, 1), cB + hstep, voffB); PG8_STAGE(PG8_SA(0, 0), cA, voffA); PG8_STAGE(PG8_SA(0, 1), cA + hstep, voffA);
        if (wr == 1) PG8_BAR;
        PG8_WAIT_V(2); PG8_BAR;
        PG8_STAGE(PG8_SB(1, 0), cB + kstep, voffB); PG8_STAGE(PG8_SA(1, 0), cA + kstep, voffA); PG8_STAGE(PG8_SB(1, 1), cB + hstep + kstep, voffB);
        PG8_WAIT_V(6); PG8_BAR;
    } else {
        PG8_STAGE(PG8_SB(0, 0), cB, voffB); PG8_STAGE(PG8_SA(0, 0), cA, voffA); PG8_STAGE(PG8_SB(0, 1), cB + hstep, voffB); PG8_STAGE(PG8_SA(0, 1), cA + hstep, voffA);
        if (wr == 1) PG8_BAR;
        PG8_WAIT_V(4); PG8_BAR;
        PG8_STAGE(PG8_SB(1, 0), cB + kstep, voffB); PG8_STAGE(PG8_SA(1, 0), cA + kstep, voffA); PG8_STAGE(PG8_SB(1, 1), cB + hstep + kstep, voffB);
        PG8_WAIT_V(6); PG8_BAR;
    }
    for (;;) {
        const bool has_next = S.next(ui + 1, nxt);
        const char* nA = has_next ? (const char*)g.A + (size_t)nxt.pm * tstep : cA; const char* nB = has_next ? (const char*)g.Bt + (size_t)nxt.pn * tstep : cB;
        for (int t = 0; t < nt; t += 2) {
            const bool last = (t == nt - 2);
            const char* a1 = cA + (size_t)(t + 1) * kstep;
            const char* a2 = last ? nA : cA + (size_t)(t + 2) * kstep; const char* b2 = last ? nB : cB + (size_t)(t + 2) * kstep;
            const char* a3 = a2 + kstep; const char* b3 = b2 + kstep;
            if (last && has_next) S.a_ready(nxt);
            if constexpr (SP2) {
            PG8_LDB(B0, 0, 0); PG8_LDB(B1, 0, 1); PG8_SCHED; PG8_LDA(At, 0, 0); PG8_STAGE(PG8_SA(1, 1), a1 + hstep, voffA);
            PG8_WAIT_V(8); PG8_WAIT_L(0); PG8_BAR; PG8_MMA(0, 0, At, B0); PG8_MMA(0, 1, At, B1); PG8_BAR; PG8_SCHED;
            PG8_LDA(At, 0, 1); PG8_STAGE(PG8_SB(0, 0), b2, voffB); PG8_STAGE(PG8_SB(0, 1), b2 + hstep, voffB); PG8_STAGE(PG8_SA(0, 0), a2, voffA);
            PG8_WAIT_V(8); PG8_WAIT_L(0); PG8_BAR; PG8_MMA(1, 0, At, B0); PG8_MMA(1, 1, At, B1); PG8_BAR; PG8_SCHED;
            PG8_LDB(B0, 1, 0); PG8_LDB(B1, 1, 1); PG8_SCHED; PG8_LDA(At, 1, 0); PG8_STAGE(PG8_SA(0, 1), a2 + hstep, voffA);
            PG8_WAIT_V(8); PG8_WAIT_L(0); PG8_BAR; PG8_MMA(0, 0, At, B0); PG8_MMA(0, 1, At, B1); PG8_BAR; PG8_SCHED;
            PG8_LDA(At, 1, 1); PG8_STAGE(PG8_SB(1, 0), b3, voffB); PG8_STAGE(PG8_SB(1, 1), b3 + hstep, voffB); PG8_STAGE(PG8_SA(1, 0), a3, voffA);
            PG8_WAIT_V(8); PG8_WAIT_L(0); PG8_BAR; PG8_MMA(1, 0, At, B0); PG8_MMA(1, 1, At, B1); PG8_BAR; PG8_SCHED;
            } else {
            PG8_LDB(B0, 0, 0); PG8_SCHED; PG8_LDA(At, 0, 0); PG8_STAGE(PG8_SA(1, 1), a1 + hstep, voffA);
            PG8_WAIT_L(8); PG8_BAR; PG8_WAIT_L(0); PG8_MMA(0, 0, At, B0); PG8_BAR; PG8_SCHED;
            PG8_LDB(B1, 0, 1); PG8_STAGE(PG8_SB(0, 0), b2, voffB);
            PG8_BAR; PG8_WAIT_L(0); PG8_MMA(0, 1, At, B1); PG8_BAR;
            PG8_LDA(At, 0, 1); PG8_STAGE(PG8_SA(0, 0), a2, voffA);
            PG8_BAR; PG8_WAIT_L(0); PG8_MMA(1, 0, At, B0); PG8_BAR; PG8_SCHED;
            PG8_STAGE(PG8_SB(0, 1), b2 + hstep, voffB);
            PG8_WAIT_V(6); PG8_BAR; PG8_MMA(1, 1, At, B1); PG8_BAR;
            PG8_LDB(B0, 1, 0); PG8_SCHED; PG8_LDA(At, 1, 0); PG8_STAGE(PG8_SA(0, 1), a2 + hstep, voffA);
            PG8_WAIT_L(8); PG8_BAR; PG8_WAIT_L(0); PG8_MMA(0, 0, At, B0); PG8_BAR; PG8_SCHED;
            PG8_LDB(B1, 1, 1); PG8_STAGE(PG8_SB(1, 0), b3, voffB);
            PG8_BAR; PG8_WAIT_L(0); PG8_MMA(0, 1, At, B1); PG8_BAR;
            PG8_LDA(At, 1, 1); PG8_STAGE(PG8_SA(1, 0), a3, voffA);
            PG8_BAR; PG8_WAIT_L(0); PG8_MMA(1, 0, At, B0); PG8_BAR; PG8_SCHED;
            PG8_STAGE(PG8_SB(1, 1), b3 + hstep, voffB);
            PG8_WAIT_V(6); PG8_BAR; PG8_MMA(1, 1, At, B1); PG8_BAR;
            }
        }
        if constexpr (ALIGN_EPI) { if (wr == 0) PG8_BAR; }
        if constexpr (!Epi::AFTER_DRAIN) { E(acc, cur, wr, wc, fr, fq); S.done(cur); }
        if (!has_next) break;
#pragma unroll
        for (int a = 0; a < 2; ++a)
#pragma unroll
            for (int b = 0; b < 2; ++b)
#pragma unroll
                for (int m = 0; m < 4; ++m)
#pragma unroll
                    for (int n = 0; n < 2; ++n) acc[a][b][m][n] = (f32x4){0.f, 0.f, 0.f, 0.f};
        cur = nxt; cA = nA; cB = nB; ++ui;
        if constexpr (ALIGN_EPI) { if (wr == 1) PG8_BAR; }
    }
    PG8_WAIT_V(0);
    if constexpr (!ALIGN_EPI) { if (wr == 0) PG8_BAR; }
    PG8_BAR;
    if constexpr (Epi::AFTER_DRAIN) { E.fused(acc, cur, wr, wc, fr, fq, lds, wid, lane); S.done(cur); }
#undef PG8_SA
#undef PG8_SB
#undef PG8_STAGE
#undef PG8_LDA
#undef PG8_LDB
#undef PG8_MMA
#undef PG8_WAIT_V
#undef PG8_WAIT_L
#undef PG8_BAR
#undef PG8_SCHED
}
}
#define GAS __attribute__((address_space(1)))
#define LAS __attribute__((address_space(3)))
typedef unsigned short bf16;
typedef unsigned v4u __attribute__((ext_vector_type(4)));
typedef float f32x4 __attribute__((ext_vector_type(4)));
typedef short bf16x8 __attribute__((ext_vector_type(8)));
typedef GAS unsigned gu32;
typedef GAS unsigned long long gu64;
#define RLX_AGENT __ATOMIC_RELAXED, __HIP_MEMORY_SCOPE_AGENT
#define LDS_WAIT() asm volatile("s_waitcnt lgkmcnt(0)" ::: "memory")
#define VM_WAIT() asm volatile("s_waitcnt vmcnt(0)" ::: "memory")
__device__ __forceinline__ unsigned long long rt() { return __builtin_amdgcn_s_memrealtime(); }
__device__ __forceinline__ unsigned f2bf(float f) { unsigned u = __builtin_bit_cast(unsigned, f); return (u + 0x7fffu + ((u >> 16) & 1u)) >> 16; }
__device__ __forceinline__ unsigned pk2(float lo, float hi) { return f2bf(lo) | (f2bf(hi) << 16); }

#define XB_TMO      128
#define XB_XCNT(j)  (256  + 64 * (j))
#define XB_XSUB(j)  (1280 + 64 * (j))
#define XB_XGEN(j)  (2304 + 64 * (j))
#define XB_TOP      3328
#define XB_TOPGEN   3392
#define XCD_BAR_WORDS 3456
#define XB_SPIN_CAP (1u << 18)

__device__ __forceinline__ unsigned xb_ld(unsigned* p)              { return __hip_atomic_load(p, __ATOMIC_RELAXED, __HIP_MEMORY_SCOPE_AGENT); }
__device__ __forceinline__ unsigned xb_add(unsigned* p, unsigned v) { return __hip_atomic_fetch_add(p, v, __ATOMIC_RELAXED, __HIP_MEMORY_SCOPE_AGENT); }
__device__ __forceinline__ unsigned xb_xcc_id() { return (unsigned)__builtin_amdgcn_s_getreg((3 << 11) | 20) & 0xFu; }
#define XB_SPIN(cond, bar) do { unsigned _sp = 0; while (cond) { __builtin_amdgcn_s_sleep(1); \
    if ((++_sp & 255u) == 0u) { if (xb_ld(&(bar)[XB_TMO])) break; if (_sp > XB_SPIN_CAP) { atomicAdd(&(bar)[XB_TMO], 1u); break; } } } } while (0)

struct XcdBarrier {
    unsigned* bar; unsigned x;
    volatile LAS unsigned* st;
};

__device__ __forceinline__ XcdBarrier xcd_barrier_post(unsigned* bar, volatile LAS unsigned* st) {
    XcdBarrier b; b.bar = bar; b.x = xb_xcc_id(); b.st = st;
    if (threadIdx.x == 0) (void)xb_add(&bar[XB_XCNT(b.x)], 1u);
    return b;
}
__device__ __forceinline__ void xcd_barrier_complete(unsigned* bar, unsigned x, unsigned& nloc, unsigned& nx) {
    const unsigned G = gridDim.x * gridDim.y * gridDim.z;
    unsigned sum, cnt, mine, sp = 0u;
    for (;;) {
        sum = 0u; cnt = 0u; mine = 0u;
#pragma unroll
        for (unsigned j = 0; j < 16; ++j) { const unsigned c = xb_ld(&bar[XB_XCNT(j)]); sum += c; cnt += (c > 0u) ? 1u : 0u; mine = (j == x) ? c : mine; }
        if (sum == G) break;
        __builtin_amdgcn_s_sleep(1);
        if ((++sp & 255u) == 0u) { if (xb_ld(&bar[XB_TMO])) break; if (sp > XB_SPIN_CAP) { atomicAdd(&bar[XB_TMO], 1u); break; } }
    }
    nloc = mine > 0u ? mine : 1u; nx = cnt > 0u ? cnt : 1u;
}

__device__ __forceinline__ void xcd_barrier(const XcdBarrier& b) {
    asm volatile("s_waitcnt vmcnt(0)" ::: "memory");
    __syncthreads();
    if (threadIdx.x == 0) {
        unsigned* bar = b.bar;
        __builtin_amdgcn_s_waitcnt(0);
        unsigned nloc = b.st[0], nx = b.st[1];
        if (nloc == 0u) { xcd_barrier_complete(bar, b.x, nloc, nx); b.st[0] = nloc; b.st[1] = nx; }
        const unsigned old = xb_add(&bar[XB_XSUB(b.x)], 1u);
        const unsigned gen = old / nloc;
        if (old + 1u == (gen + 1u) * nloc) {
            __builtin_amdgcn_fence(__ATOMIC_RELEASE, "agent");
            asm volatile("s_waitcnt vmcnt(0)" ::: "memory");
            const unsigned og = xb_add(&bar[XB_TOP], 1u);
            const unsigned tg = og / nx;
            if (og + 1u == (tg + 1u) * nx) xb_add(&bar[XB_TOPGEN], 1u);
            else XB_SPIN(xb_ld(&bar[XB_TOPGEN]) == tg, bar);
            __builtin_amdgcn_fence(__ATOMIC_ACQUIRE, "agent");
            xb_add(&bar[XB_XGEN(b.x)], 1u);
            asm volatile("s_waitcnt vmcnt(0)" ::: "memory");
        } else {
            XB_SPIN(xb_ld(&bar[XB_XGEN(b.x)]) == gen, bar);
            __builtin_amdgcn_fence(__ATOMIC_ACQUIRE, "agent");
            asm volatile("s_waitcnt vmcnt(0)" ::: "memory");
        }
    }
    __syncthreads();
}
namespace epi {
using pg8::f32x4; using pg8::Unit; using pg8::bf16_t; using pg8::u32x4; using pg8::cvt_pk_bf16;
__device__ __forceinline__ float sigm(float x) { return __builtin_amdgcn_rcpf(1.f + __builtin_amdgcn_exp2f(-1.4426950408889634f * x)); }
__device__ __forceinline__ f32x4 sigm4(f32x4 v) { return (f32x4){sigm(v[0]), sigm(v[1]), sigm(v[2]), sigm(v[3])}; }
__device__ __forceinline__ u32x4 pack8(f32x4 a, f32x4 b) { u32x4 w; w.x = cvt_pk_bf16(a[0], a[1]); w.y = cvt_pk_bf16(a[2], a[3]); w.z = cvt_pk_bf16(b[0], b[1]); w.w = cvt_pk_bf16(b[2], b[3]); return w; }
__device__ __forceinline__ void unpack8(u32x4 w, f32x4& a, f32x4& b) {
    a[0] = __uint_as_float(w.x << 16); a[1] = __uint_as_float(w.x & 0xffff0000u); a[2] = __uint_as_float(w.y << 16); a[3] = __uint_as_float(w.y & 0xffff0000u);
    b[0] = __uint_as_float(w.z << 16); b[1] = __uint_as_float(w.z & 0xffff0000u); b[2] = __uint_as_float(w.w << 16); b[3] = __uint_as_float(w.w & 0xffff0000u); }

struct EpiInProj { static constexpr bool PERM = true, AFTER_DRAIN = false;
    bf16_t* Qb; bf16_t* KVb; float* U; bf16_t* MG; float* GT; const float* rstd; float* out;
    __device__ __forceinline__ void operator()(const f32x4 (&acc)[2][2][4][2], const Unit& u, int wr, int wc, int fr, int fq) const {
        const int pn = u.pn, row0 = u.pm * 256 + wr * 64 + fr, c0 = wc * 32 + 8 * fq;
#pragma unroll
        for (int ai = 0; ai < 2; ++ai)
#pragma unroll
            for (int m = 0; m < 4; ++m) { const int r = row0 + ai * 128 + m * 16; const bool ok = r < MROWS; const float rs = rstd[r];
#pragma unroll
                for (int bj = 0; bj < 2; ++bj) { f32x4 v0 = acc[ai][bj][m][0] * rs, v1 = acc[ai][bj][m][1] * rs; const int c = c0 + bj * 128;
                    if (!ok) continue;
                    if (pn < 4) { *(u32x4*)(Qb + (size_t)r * 1024 + pn * 256 + c) = pack8(v0, v1); }
                    else if (pn < 10) { const int slot = pn - 4; *(u32x4*)(KVb + (size_t)r * 1536 + slot * 256 + c) = pack8(v0, v1);
                        float* dst = nullptr;
                        if (slot < 4) dst = (r < MP) ? out + O_KVP + (size_t)r * 1024 + slot * 256 + c : out + O_KVS + (size_t)(r - MP) * 1024 + slot * 256 + c;
                        else if (r < MP) { const int t = r & (SEQ - 1); if (t >= SEQ - 512) dst = out + O_WINP + ((size_t)((r >> 11) * 512 + (t - (SEQ - 512))) * 2 + (slot - 4)) * 256 + c; }
                        else { const int q = r - MP; dst = out + O_WINS + ((size_t)((q >> 3) * 512 + 504 + (q & 7)) * 2 + (slot - 4)) * 256 + c; }
                        if (dst) { *(f32x4*)dst = v0; *(f32x4*)(dst + 4) = v1; } }
                    else if (pn < 14) { float* dst = U + (size_t)r * 1024 + (pn - 10) * 256 + c; *(f32x4*)dst = v0; *(f32x4*)(dst + 4) = v1; }
                    else if (pn < 30) { *(u32x4*)(MG + (size_t)r * 4096 + (pn - 14) * 256 + c) = pack8(sigm4(v0), sigm4(v1)); }
                    else if (c < 48) { float* dst = GT + (size_t)r * 64 + c; *(f32x4*)dst = sigm4(v0); *(f32x4*)(dst + 4) = sigm4(v1); } } }
    }
};
struct EpiGlu { static constexpr bool PERM = true, AFTER_DRAIN = false;
    const bf16_t* MG; bf16_t* MB;
    __device__ __forceinline__ void operator()(const f32x4 (&acc)[2][2][4][2], const Unit& u, int wr, int wc, int fr, int fq) const {
        const int row0 = u.pm * 256 + wr * 64 + fr, col = u.pn * 128 + wc * 32 + 8 * fq;
#pragma unroll
        for (int ai = 0; ai < 2; ++ai)
#pragma unroll
            for (int m = 0; m < 4; ++m) { const int r = row0 + ai * 128 + m * 16; if (r >= MROWS) continue;
                f32x4 s0, s1; unpack8(*(const u32x4*)(MG + (size_t)r * 4096 + 2048 + col), s0, s1);
                const f32x4 y0 = acc[ai][0][m][0] * sigm4(acc[ai][1][m][0]) * s0, y1 = acc[ai][0][m][1] * sigm4(acc[ai][1][m][1]) * s1;
                *(u32x4*)(MB + (size_t)r * 2048 + col) = pack8(y0, y1); }
    }
};
struct EpiAttnOut { static constexpr bool PERM = true, AFTER_DRAIN = false;
    const bf16_t* MG; bf16_t* MB;
    __device__ __forceinline__ void operator()(const f32x4 (&acc)[2][2][4][2], const Unit& u, int wr, int wc, int fr, int fq) const {
        const int row0 = u.pm * 256 + wr * 64 + fr, col0 = u.pn * 256 + wc * 32 + 8 * fq;
#pragma unroll
        for (int ai = 0; ai < 2; ++ai)
#pragma unroll
            for (int m = 0; m < 4; ++m) { const int r = row0 + ai * 128 + m * 16; if (r >= MROWS) continue;
#pragma unroll
                for (int bj = 0; bj < 2; ++bj) { const int col = col0 + bj * 128;
                    f32x4 s0, s1, b0, b1; unpack8(*(const u32x4*)(MG + (size_t)r * 4096 + col), s0, s1); unpack8(*(const u32x4*)(MB + (size_t)r * 2048 + col), b0, b1);
                    *(u32x4*)(MB + (size_t)r * 2048 + col) = pack8(b0 + s0 * acc[ai][bj][m][0], b1 + s1 * acc[ai][bj][m][1]); } }
    }
};
struct EpiWout { static constexpr bool PERM = true, AFTER_DRAIN = false;
    const float* xp; const float* xs; float* X2; bf16_t* XN; float* ss;
    __device__ __forceinline__ void operator()(const f32x4 (&acc)[2][2][4][2], const Unit& u, int wr, int wc, int fr, int fq) const {
        const int row0 = u.pm * 256 + wr * 64 + fr, col0 = u.pn * 256 + wc * 32 + 8 * fq;
#pragma unroll
        for (int ai = 0; ai < 2; ++ai)
#pragma unroll
            for (int m = 0; m < 4; ++m) { const int r = row0 + ai * 128 + m * 16; const bool ok = r < MROWS; float s = 0.f;
                const float* xr = (r < MP) ? xp + (size_t)r * 2048 : xs + (size_t)(ok ? r - MP : 0) * 2048;
#pragma unroll
                for (int bj = 0; bj < 2; ++bj) { const int col = col0 + bj * 128;
                    f32x4 v0 = acc[ai][bj][m][0], v1 = acc[ai][bj][m][1];
                    if (ok) { v0 += *(const f32x4*)(xr + col); v1 += *(const f32x4*)(xr + col + 4);
                        float* d = X2 + (size_t)r * 2048 + col; *(f32x4*)d = v0; *(f32x4*)(d + 4) = v1; *(u32x4*)(XN + (size_t)r * 2048 + col) = pack8(v0, v1); }
                    s += (v0[0] * v0[0] + v0[1] * v0[1]) + (v0[2] * v0[2] + v0[3] * v0[3]) + (v1[0] * v1[0] + v1[1] * v1[1]) + (v1[2] * v1[2] + v1[3] * v1[3]); }
                s += __shfl_xor(s, 16); s += __shfl_xor(s, 32);
                if (ok && fq == 0) atomicAdd(ss + r, s); }
    }
};
struct EpiGateUp { static constexpr bool PERM = true, AFTER_DRAIN = false;
    const float* ss; bf16_t* HH;
    __device__ __forceinline__ void operator()(const f32x4 (&acc)[2][2][4][2], const Unit& u, int wr, int wc, int fr, int fq) const {
        const int row0 = u.pm * 256 + wr * 64 + fr, col = u.pn * 128 + wc * 32 + 8 * fq;
#pragma unroll
        for (int ai = 0; ai < 2; ++ai)
#pragma unroll
            for (int m = 0; m < 4; ++m) { const int r = row0 + ai * 128 + m * 16; if (r >= MROWS) continue;
                const float rs = 1.0f / sqrtf(ss[r] * (1.0f / 2048.0f) + EPS);
                const f32x4 g0 = acc[ai][0][m][0] * rs, g1 = acc[ai][0][m][1] * rs, u0 = acc[ai][1][m][0] * rs, u1 = acc[ai][1][m][1] * rs;
                *(u32x4*)(HH + (size_t)r * DFF + col) = pack8(g0 * sigm4(g0) * u0, g1 * sigm4(g1) * u1); }
    }
};
struct EpiDown { static constexpr bool PERM = true, AFTER_DRAIN = false;
    const float* X2; float* Y; float* ss;
    __device__ __forceinline__ void operator()(const f32x4 (&acc)[2][2][4][2], const Unit& u, int wr, int wc, int fr, int fq) const {
        const int row0 = u.pm * 256 + wr * 64 + fr, col0 = u.pn * 256 + wc * 32 + 8 * fq;
#pragma unroll
        for (int ai = 0; ai < 2; ++ai)
#pragma unroll
            for (int m = 0; m < 4; ++m) { const int r = row0 + ai * 128 + m * 16; const bool ok = r < MROWS; float s = 0.f;
#pragma unroll
                for (int bj = 0; bj < 2; ++bj) { const int col = col0 + bj * 128;
                    f32x4 v0 = acc[ai][bj][m][0], v1 = acc[ai][bj][m][1];
                    if (ok) { const float* xr = X2 + (size_t)r * 2048 + col; v0 += *(const f32x4*)xr; v1 += *(const f32x4*)(xr + 4);
                        float* d = Y + (size_t)r * 2048 + col; *(f32x4*)d = v0; *(f32x4*)(d + 4) = v1; }
                    s += (v0[0] * v0[0] + v0[1] * v0[1]) + (v0[2] * v0[2] + v0[3] * v0[3]) + (v1[0] * v1[0] + v1[1] * v1[1]) + (v1[2] * v1[2] + v1[3] * v1[3]); }
                s += __shfl_xor(s, 16); s += __shfl_xor(s, 32);
                if (ok && fq == 0) atomicAdd(ss + r, s); }
    }
};
}
constexpr int RING_OFF = 0, RING_BYTES = 131072;
constexpr int LDSCTL_OFF = RING_BYTES, MISC_OFF = LDSCTL_OFF + 320;
constexpr int LDS_BYTES = 147456;
constexpr int NWAVES = 8;
typedef float f32x2v __attribute__((ext_vector_type(2)));

#define WSYNC() do { asm volatile("s_waitcnt lgkmcnt(0)" ::: "memory"); __builtin_amdgcn_wave_barrier(); asm volatile("" ::: "memory"); } while (0)
__device__ __forceinline__ int vgpr_i(int x) { asm volatile("" : "+v"(x)); return x; }
__device__ __forceinline__ float bf2f(unsigned short h) { return __uint_as_float((unsigned)h << 16); }
__device__ __forceinline__ float wave_sum(float v) {
#pragma unroll
    for (int o = 1; o < 64; o <<= 1) v += __shfl_xor(v, o);
    return v; }
__device__ __forceinline__ float wave_max(float v) {
#pragma unroll
    for (int o = 1; o < 64; o <<= 1) v = fmaxf(v, __shfl_xor(v, o));
    return v; }
__device__ __forceinline__ float fsigm(float x) { return __builtin_amdgcn_rcpf(1.f + __builtin_amdgcn_exp2f(-1.4426950408889634f * x)); }
__device__ __forceinline__ float gelu_tanh(float x) { return x * fsigm(1.5957691216057308f * (x + 0.044715f * x * x * x)); }
__device__ __forceinline__ float fexp(float x) { return __builtin_amdgcn_exp2f(1.4426950408889634f * x); }

struct TrJob { const float* W0; const float* W1; const float* g; bf16* WT; int K, Nsrc, Ndst, kind; };
__device__ __forceinline__ const float* tr_src(const TrJob& j, int n) {
    switch (j.kind) {
    default: return n < j.Nsrc ? j.W0 + n : nullptr;
    case 1: { if (n < 2560) return j.W0 + n; if (n < 3584) return j.W0 + 2608 + (n - 2560); if (n < 7680) return j.W0 + 3632 + (n - 3584); if (n < 7728) return j.W0 + 2560 + (n - 7680); return nullptr; }
    case 2: { const int pn = n >> 8, w = n & 255; return j.W0 + (w < 128 ? 128 * pn + w : 2048 + 128 * pn + (w - 128)); }
    case 3: { const int pn = n >> 8, w = n & 255; return w < 128 ? j.W0 + 128 * pn + w : j.W1 + 128 * pn + (w - 128); }
    }
}
__device__ __forceinline__ void tr_item(const TrJob& j, int item, LAS unsigned* scr, int lane) {
    const int nblk = j.Ndst / 64, kb = item / nblk, nb = item % nblk, k0 = 64 * kb, n0 = 64 * nb;
    const float* src = tr_src(j, n0 + lane); const float msk = src ? 1.f : 0.f; if (!src) src = j.W0;
    src += (size_t)k0 * j.Nsrc;
#pragma unroll 8
    for (int i = 0; i < 32; ++i) { float a = src[(size_t)(2 * i) * j.Nsrc] * msk, b = src[(size_t)(2 * i + 1) * j.Nsrc] * msk;
        if (j.g) { a *= j.g[k0 + 2 * i]; b *= j.g[k0 + 2 * i + 1]; }
        scr[i * 65 + lane] = pk2(a, b); }
    LDS_WAIT(); __builtin_amdgcn_wave_barrier(); asm volatile("" ::: "memory");
    const int c = lane & 7;
#pragma unroll
    for (int jj = 0; jj < 8; ++jj) { const int n = 8 * jj + (lane >> 3); const LAS unsigned* s = scr + (4 * c) * 65 + n;
        v4u o; o.x = s[0]; o.y = s[65]; o.z = s[130]; o.w = s[195];
        *(GAS v4u*)(j.WT + (size_t)(n0 + n) * j.K + k0 + 8 * c) = o; }
    LDS_WAIT(); __builtin_amdgcn_wave_barrier(); asm volatile("" ::: "memory");
}
__device__ __forceinline__ void xn_row(const float* xrow, bf16* orow, float* rstd_out, int lane) {
    GAS unsigned long long* o8 = (GAS unsigned long long*)orow + lane;
    if (!xrow) {
#pragma unroll
        for (int j = 0; j < 8; ++j) o8[64 * j] = 0ull;
        if (lane == 0) *rstd_out = 0.f; return; }
    const GAS f32x4* xr = (const GAS f32x4*)xrow + lane; f32x4 v[8]; float s = 0.f;
#pragma unroll
    for (int j = 0; j < 8; ++j) { v[j] = xr[64 * j]; s += (v[j].x * v[j].x + v[j].y * v[j].y) + (v[j].z * v[j].z + v[j].w * v[j].w); }
    s = wave_sum(s);
#pragma unroll
    for (int j = 0; j < 8; ++j) o8[64 * j] = (unsigned long long)pk2(v[j].x, v[j].y) | ((unsigned long long)pk2(v[j].z, v[j].w) << 32);
    if (lane == 0) *rstd_out = 1.0f / sqrtf(s * (1.0f / D_MODEL) + EPS);
}

constexpr int CMP_PHI = 0, CMP_POOL = 8192, CMP_CST = 8256, CMP_GS = 8384;
__device__ __forceinline__ void compress_setup(const float* pe, const float* pool, const float* phi, LAS float* L, int tid) {
    for (int i = tid; i < 8192; i += NWAVES * 64) L[CMP_PHI + i] = phi[i];
    if (tid < 64) L[CMP_POOL + tid] = pool[tid];
    if (tid < 128) { const int w = tid >> 6, d = tid & 63; float s = 0.f;
        for (int j = 0; j < 32; ++j) s += pool[w * 32 + j] * pe[(w * 32 + j) * 64 + d];
        L[CMP_CST + tid] = s; }
    __syncthreads();
}
template <bool SAMPLE> __device__ __forceinline__ void compress_item(const float* rows, const int* pt, int b, int i, int nc, bf16* KC, LAS float* L, int wave, int lane) {
    const int which = lane >> 5;
    f32x4 plo0 = {0.f, 0.f, 0.f, 0.f}, plo1 = plo0;
    const int m_end = (8 * i + 8 < nc) ? 8 * i + 8 : nc;
    for (int m = 8 * i; m <= m_end; ++m) {
        const float* base;
        if (SAMPLE) { const int pos = 16 * m; const int phys = pt[b * NPAGES + (pos >> 7)]; base = rows + ((size_t)phys * PAGE + (pos & (PAGE - 1))) * 1024 + 8 * lane; }
        else base = rows + ((size_t)b * SEQ + 16 * m) * 1024 + 8 * lane;
        f32x4 lo0 = {0.f, 0.f, 0.f, 0.f}, lo1 = lo0, hi0 = lo0, hi1 = lo0;
#pragma unroll
        for (int j = 0; j < 16; ++j) { const f32x4 v0 = *(const f32x4*)(base + (size_t)j * 1024), v1 = *(const f32x4*)(base + (size_t)j * 1024 + 4);
            const float pl = L[CMP_POOL + which * 32 + j], ph = L[CMP_POOL + which * 32 + 16 + j];
            lo0 += pl * v0; lo1 += pl * v1; hi0 += ph * v0; hi1 += ph * v1; }
        if (m > 8 * i) { const int c = m - 1;
            const f32x4 c0 = *(const LAS f32x4*)(L + CMP_CST + which * 64 + 8 * (lane & 7)), c1 = *(const LAS f32x4*)(L + CMP_CST + which * 64 + 8 * (lane & 7) + 4);
            f32x4 g0 = plo0 + hi0 + c0, g1 = plo1 + hi1 + c1;
#pragma unroll
            for (int e = 0; e < 4; ++e) { g0[e] = gelu_tanh(g0[e]); g1[e] = gelu_tanh(g1[e]); }
            LAS float* Gs = L + CMP_GS + wave * 512;
            *(LAS f32x4*)(Gs + 8 * lane) = g0; *(LAS f32x4*)(Gs + 8 * lane + 4) = g1;
            WSYNC();
            f32x4 a0 = {0.f, 0.f, 0.f, 0.f}, a1 = a0; const LAS float* gr = Gs + (lane >> 3) * 64; const LAS float* ph = L + CMP_PHI + which * 4096 + 8 * (lane & 7);
#pragma unroll 8
            for (int d = 0; d < 64; ++d) { const float gv = gr[d]; a0 += gv * *(const LAS f32x4*)(ph + d * 64); a1 += gv * *(const LAS f32x4*)(ph + d * 64 + 4); }
            { v4u w; w.x = pk2(a0[0], a0[1]); w.y = pk2(a0[2], a0[3]); w.z = pk2(a1[0], a1[1]); w.w = pk2(a1[2], a1[3]); *(GAS v4u*)(KC + (size_t)c * 512 + 8 * lane) = w; }
            WSYNC(); }
        plo0 = lo0; plo1 = lo1;
    }
}

struct SsmIn { const float *lam_re, *lam_im, *log_dt, *b_re, *b_im, *c_re, *c_im, *dsk; };
struct SsmC { float ar, ai, dsk; f32x2v bb[16]; float cm[32]; };
__device__ __forceinline__ void ssm_consts(const SsmIn& I, int g, int lane, SsmC& C) {
    const int p = lane; const float dt = expf(I.log_dt[g]), lr = I.lam_re[g * 64 + p], li = I.lam_im[g * 64 + p];
    const float mag = expf(lr * dt); float sn, cs; sincosf(li * dt, &sn, &cs);
    C.ar = mag * cs; C.ai = mag * sn;
    const float den = lr * lr + li * li, fr = ((C.ar - 1.f) * lr + C.ai * li) / den, fi = (C.ai * lr - (C.ar - 1.f) * li) / den;
#pragma unroll
    for (int c4 = 0; c4 < 4; ++c4) { const f32x4 br = *(const f32x4*)(I.b_re + (size_t)(g * 64 + p) * 16 + 4 * c4), bi = *(const f32x4*)(I.b_im + (size_t)(g * 64 + p) * 16 + 4 * c4);
#pragma unroll
        for (int e = 0; e < 4; ++e) C.bb[4 * c4 + e] = (f32x2v){fr * br[e] - fi * bi[e], fr * bi[e] + fi * br[e]}; }
    const int c = lane & 15, q = lane >> 4;
#pragma unroll
    for (int k4 = 0; k4 < 4; ++k4) { const f32x4 cr = *(const f32x4*)(I.c_re + (size_t)(g * 16 + c) * 64 + 16 * q + 4 * k4), ci = *(const f32x4*)(I.c_im + (size_t)(g * 16 + c) * 64 + 16 * q + 4 * k4);
#pragma unroll
        for (int e = 0; e < 4; ++e) { C.cm[8 * k4 + 2 * e] = cr[e]; C.cm[8 * k4 + 2 * e + 1] = -ci[e]; } }
    C.dsk = I.dsk[g * 16 + c];
}
__device__ __forceinline__ f32x4 ssm_y16(const LAS float* Hs, const SsmC& C, int lane) {
    const int trow = lane & 15, q = lane >> 4; f32x4 d = {0.f, 0.f, 0.f, 0.f};
#pragma unroll
    for (int k4 = 0; k4 < 8; ++k4) { const f32x4 a = *(const LAS f32x4*)(Hs + trow * 132 + 32 * q + 4 * k4);
#pragma unroll
        for (int e = 0; e < 4; ++e) d = __builtin_amdgcn_mfma_f32_16x16x4f32(a[e], C.cm[4 * k4 + e], d, 0, 0, 0); }
    return d;
}
constexpr int SSM_US = 0, SSM_HS = 16384, SSM_HEND = SSM_HS + 8 * 8448;
__device__ __forceinline__ void ssm_prompt_item(const SsmIn& I, int b, int g, const float* U, bf16* GY, float* out, LAS unsigned char* lds, int wave, int lane) {
    SsmC C; ssm_consts(I, g, lane, C);
    float a32r = C.ar, a32i = C.ai;
#pragma unroll
    for (int s = 0; s < 5; ++s) { const float nr = a32r * a32r - a32i * a32i, ni = 2.f * a32r * a32i; a32r = nr; a32i = ni; }
    LAS float* uS = (LAS float*)(lds + SSM_US) + wave * 512; LAS float* Hs = (LAS float*)(lds + SSM_HS) + wave * 2112; LAS float* hend = (LAS float*)(lds + SSM_HEND);
    float cr = 0.f, ci = 0.f;
#pragma unroll 1
    for (int sb = 0; sb < SEQ / 256; ++sb) {
        const int row0 = b * SEQ + sb * 256 + wave * 32;
#pragma unroll
        for (int h = 0; h < 2; ++h) { const int tt = (lane >> 2) + 16 * h; *(LAS f32x4*)(uS + tt * 16 + 4 * (lane & 3)) = *(const f32x4*)(U + (size_t)(row0 + tt) * 1024 + g * 16 + 4 * (lane & 3)); }
        WSYNC();
        f32x2v x[32];
#pragma unroll
        for (int i = 0; i < 32; ++i) { f32x2v sx = {0.f, 0.f}; asm volatile("" ::: "memory");
#pragma unroll
            for (int c4 = 0; c4 < 4; ++c4) { const f32x4 u4 = *(const LAS f32x4*)(uS + i * 16 + 4 * c4);
#pragma unroll
                for (int e = 0; e < 4; ++e) sx += u4[e] * C.bb[4 * c4 + e]; }
            x[i] = sx; }
        const f32x2v A1 = {C.ar, C.ar}, A2 = {-C.ai, C.ai};
        f32x2v h = {0.f, 0.f};
#pragma unroll
        for (int i = 0; i < 32; ++i) { const f32x2v hs = __builtin_shufflevector(h, h, 1, 0); h = A1 * h + (A2 * hs + x[i]); }
        const float hr = h.x, hi = h.y;
        *(LAS f32x2v*)(hend + (wave * 64 + lane) * 2) = (f32x2v){hr, hi};
        __syncthreads();
        float chr = cr, chi = ci, cinr = 0.f, cini = 0.f;
#pragma unroll
        for (int w = 0; w < 8; ++w) { if (w == wave) { cinr = chr; cini = chi; }
            const f32x2v e = *(const LAS f32x2v*)(hend + (w * 64 + lane) * 2);
            const float nr = a32r * chr - a32i * chi + e.x, ni = a32r * chi + a32i * chr + e.y; chr = nr; chi = ni; }
        cr = chr; ci = chi; h = (f32x2v){cinr, cini};
#pragma unroll
        for (int half = 0; half < 2; ++half) {
#pragma unroll
            for (int i = 0; i < 16; ++i) { const int ii = half * 16 + i; const f32x2v hs = __builtin_shufflevector(h, h, 1, 0); h = A1 * h + (A2 * hs + x[ii]);
                *(LAS f32x2v*)(Hs + i * 132 + 2 * lane) = h; }
            WSYNC();
            const f32x4 d = ssm_y16(Hs, C, lane); const int c = lane & 15, q = lane >> 4;
#pragma unroll
            for (int r = 0; r < 4; ++r) { const int tt = half * 16 + 4 * q + r; const float y = d[r] + C.dsk * uS[tt * 16 + c];
                GY[(size_t)(row0 + tt) * 1024 + g * 16 + c] = (bf16)f2bf(gelu_tanh(y)); }
            WSYNC();
        }
        __syncthreads();
    }
    if (wave == 0) { out[O_HRP + (size_t)(b * 64 + g) * 64 + lane] = cr; out[O_HIP + (size_t)(b * 64 + g) * 64 + lane] = ci; }
}
__device__ __forceinline__ void ssm_sample_item(const SsmIn& I, int b, int g, const float* U, const float* h0r, const float* h0i, bf16* GY, float* out, LAS unsigned char* lds, int wave, int lane) {
    SsmC C; ssm_consts(I, g, lane, C);
    LAS float* uS = (LAS float*)(lds + SSM_US) + wave * 512; LAS float* Hs = (LAS float*)(lds + SSM_HS) + wave * 2112;
    const int row0 = MP + b * DEC_T;
    if (lane < 32) { const int tt = lane >> 2; *(LAS f32x4*)(uS + tt * 16 + 4 * (lane & 3)) = *(const f32x4*)(U + (size_t)(row0 + tt) * 1024 + g * 16 + 4 * (lane & 3)); }
    WSYNC();
    float hr = h0r[(size_t)(b * 64 + g) * 64 + lane], hi = h0i[(size_t)(b * 64 + g) * 64 + lane];
#pragma unroll
    for (int i = 0; i < 16; ++i) {
        if (i < DEC_T) { f32x2v sx = {0.f, 0.f};
#pragma unroll
            for (int c4 = 0; c4 < 4; ++c4) { const f32x4 u4 = *(const LAS f32x4*)(uS + i * 16 + 4 * c4);
#pragma unroll
                for (int e = 0; e < 4; ++e) sx += u4[e] * C.bb[4 * c4 + e]; }
            const float nr = C.ar * hr - C.ai * hi + sx.x, ni = C.ar * hi + C.ai * hr + sx.y; hr = nr; hi = ni; }
        *(LAS f32x2v*)(Hs + i * 132 + 2 * lane) = (i < DEC_T) ? (f32x2v){hr, hi} : (f32x2v){0.f, 0.f}; }
    WSYNC();
    out[O_HRS + (size_t)(b * 64 + g) * 64 + lane] = hr; out[O_HIS + (size_t)(b * 64 + g) * 64 + lane] = hi;
    const f32x4 d = ssm_y16(Hs, C, lane); const int c = lane & 15, q = lane >> 4;
#pragma unroll
    for (int r = 0; r < 4; ++r) { const int tt = 4 * q + r; if (tt < DEC_T) { const float y = d[r] + C.dsk * uS[tt * 16 + c];
        GY[(size_t)(row0 + tt) * 1024 + g * 16 + c] = (bf16)f2bf(gelu_tanh(y)); } }
    WSYNC();
}

constexpr int AS_QS = 0, AS_PS = 256, AS_PSUM = 512, AS_IMP = 1536, AS_SEL = 1800, AS_WORDS = 2048;
__device__ __forceinline__ void ld8(bool bf, const void* base, size_t off, float (&k)[8]) {
    if (bf) { const v4u w = *(const v4u*)((const bf16*)base + off);
        k[0] = __uint_as_float(w.x << 16); k[1] = __uint_as_float(w.x & 0xffff0000u); k[2] = __uint_as_float(w.y << 16); k[3] = __uint_as_float(w.y & 0xffff0000u);
        k[4] = __uint_as_float(w.z << 16); k[5] = __uint_as_float(w.z & 0xffff0000u); k[6] = __uint_as_float(w.w << 16); k[7] = __uint_as_float(w.w & 0xffff0000u); }
    else { const f32x4 a = *(const f32x4*)((const float*)base + off), b = *(const f32x4*)((const float*)base + off + 4);
        k[0] = a[0]; k[1] = a[1]; k[2] = a[2]; k[3] = a[3]; k[4] = b[0]; k[5] = b[1]; k[6] = b[2]; k[7] = b[3]; }
}
__device__ __forceinline__ float ld1(bool bf, const void* base, size_t off) { return bf ? bf2f(((const bf16*)base)[off]) : ((const float*)base)[off]; }
template <int MODE> __device__ __forceinline__ void att_chunk(bool bf, const void* kb, int stride, int c_lo, int c_hi, int kp0, int kstep, int pc,
        const float (&sl)[4], LAS float* W, float (&m)[4], float (&l)[4], float (&acc)[4], LAS float* psum, int lane) {
    const bool valid = lane >= c_lo && lane < c_hi;
    float s[4] = {0.f, 0.f, 0.f, 0.f};
    if (valid) {
#pragma unroll 1
        for (int hh = 0; hh < 2; ++hh) {
            float kk[4][8];
#pragma unroll
            for (int i = 0; i < 4; ++i) ld8(bf, kb, (size_t)lane * stride + 32 * hh + 8 * i, kk[i]);
#pragma unroll
            for (int i = 0; i < 4; ++i) { const float (&k)[8] = kk[i];
#pragma unroll
                for (int n = 0; n < 4; ++n) { asm volatile("" ::: "memory");
                    const f32x4 qa = *(const LAS f32x4*)(W + AS_QS + n * 64 + 32 * hh + 8 * i), qb = *(const LAS f32x4*)(W + AS_QS + n * 64 + 32 * hh + 8 * i + 4);
                    s[n] += (k[0] * qa[0] + k[1] * qa[1]) + (k[2] * qa[2] + k[3] * qa[3]) + (k[4] * qb[0] + k[5] * qb[1]) + (k[6] * qb[2] + k[7] * qb[3]); } }
            asm volatile("" ::: "memory"); } }
    const float dist = (float)(pc - (kp0 + kstep * lane));
#pragma unroll
    for (int n = 0; n < 4; ++n) s[n] = valid ? s[n] * 0.125f - sl[n] * dist : -INFINITY;
    if (MODE == 1) {
#pragma unroll
        for (int n = 0; n < 4; ++n) { const float mn = fmaxf(m[n], wave_max(s[n])); const float sc = (m[n] == -INFINITY) ? 0.f : fexp(m[n] - mn);
            l[n] = l[n] * sc + wave_sum(valid ? fexp(s[n] - mn) : 0.f); m[n] = mn; }
        return; }
    f32x4 p;
    if (MODE == 0) {
#pragma unroll
        for (int n = 0; n < 4; ++n) { const float mn = fmaxf(m[n], wave_max(s[n])); const float sc = (m[n] == -INFINITY) ? 0.f : fexp(m[n] - mn);
            p[n] = valid ? fexp(s[n] - mn) : 0.f; l[n] = l[n] * sc + wave_sum(p[n]); acc[n] *= sc; m[n] = mn; }
    } else {
#pragma unroll
        for (int n = 0; n < 4; ++n) p[n] = valid ? fexp(s[n] - m[n]) * l[n] : 0.f;
        psum[lane] = (p[0] + p[1]) + (p[2] + p[3]);
    }
    *(LAS f32x4*)(W + AS_PS + 4 * lane) = p;
    WSYNC();
#pragma unroll 2
    for (int c = c_lo; c < c_hi; ++c) { const float v = ld1(bf, kb, (size_t)c * stride + 256 + lane); const f32x4 pp = *(const LAS f32x4*)(W + AS_PS + 4 * c);
#pragma unroll
        for (int n = 0; n < 4; ++n) acc[n] += pp[n] * v; }
    WSYNC();
}
struct AttnP { const bf16* Qb; const bf16* KVb; const bf16* KCP; const bf16* KCS; const float* GT; const float* cache; const float* swin; const int* pt; bf16* OB; };
__device__ __forceinline__ void attn_item_simple(const AttnP& P, int r, int g, LAS float* W, int lane) {
    const bool sample = r >= MP; const int q_ = r - MP;
    const int b = sample ? (q_ >> 3) : (r >> 11), t = sample ? (q_ & 7) : (r & (SEQ - 1)), pc = sample ? PAST + t : t;
    const int rowbase = sample ? MP + b * DEC_T : b * SEQ;
    float sl[4];
#pragma unroll
    for (int n = 0; n < 4; ++n) { W[AS_QS + n * 64 + lane] = bf2f(P.Qb[(size_t)r * 1024 + (4 * g + n) * 64 + lane]); sl[n] = exp2f(-0.5f * (float)(4 * g + n + 1)); }
    WSYNC();
    float ot[4] = {0.f, 0.f, 0.f, 0.f};
    const int gi = vgpr_i(r * 64 + 4 * g);
    const int ncmax = sample ? NC_S : NC_P; int ncv = pc >= 31 ? (pc - 31) / 16 + 1 : 0; if (ncv > ncmax) ncv = ncmax;
    const bf16* kc = sample ? P.KCS + (size_t)b * NCP_S * 512 : P.KCP + (size_t)b * NCP_P * 512;
    if (ncv > 0) { float m[4] = {-INFINITY, -INFINITY, -INFINITY, -INFINITY}, l[4] = {0.f, 0.f, 0.f, 0.f}, oc[4] = {0.f, 0.f, 0.f, 0.f};
#pragma unroll 1
        for (int c0 = 0; c0 < ncv; c0 += 64) att_chunk<1>(true, kc + (size_t)c0 * 512 + g * 64, 512, 0, (ncv - c0 < 64) ? ncv - c0 : 64, 16 * c0 + 31, 16, pc, sl, W, m, l, oc, nullptr, lane);
#pragma unroll
        for (int n = 0; n < 4; ++n) l[n] = 1.0f / l[n];
#pragma unroll 1
        for (int c0 = 0; c0 < ncv; c0 += 64) att_chunk<2>(true, kc + (size_t)c0 * 512 + g * 64, 512, 0, (ncv - c0 < 64) ? ncv - c0 : 64, 16 * c0 + 31, 16, pc, sl, W, m, l, oc, W + AS_PSUM + c0, lane);
#pragma unroll
        for (int n = 0; n < 4; ++n) ot[n] = P.GT[gi + n] * oc[n]; }
    const int ns = sample ? 257 : 32, cur = pc >> 6;
    for (int s = lane; s < ns; s += 64) { float v;
        if (s > cur) v = -1.f; else if (s == 0 || s == cur || s == cur - 1) v = 1e4f;
        else { v = 0.f; for (int c = 4 * s - 1; c <= 4 * s + 3; ++c) v += W[AS_PSUM + c]; }
        W[AS_IMP + s] = v; }
    WSYNC();
    int nsel = 0;
#pragma unroll 1
    for (int it = 0; it < 16; ++it) { float bv = -3.f; int bi = 1 << 30;
        for (int s = lane; s < ns; s += 64) { const float v = W[AS_IMP + s]; if (v > bv) { bv = v; bi = s; } }
#pragma unroll
        for (int o = 1; o < 64; o <<= 1) { const float ov = __shfl_xor(bv, o); const int oi = __shfl_xor(bi, o); if (ov > bv || (ov == bv && oi < bi)) { bv = ov; bi = oi; } }
        if (bv < 0.f) break;
        if (lane == 0) { ((LAS int*)W)[AS_SEL + nsel] = bi; W[AS_IMP + bi] = -2.f; }
        WSYNC(); ++nsel; }
    const int lo = pc - 511 > 0 ? pc - 511 : 0;
#pragma unroll 1
    for (int br = 0; br < 2; ++br) {
        float m[4] = {-INFINITY, -INFINITY, -INFINITY, -INFINITY}, l[4] = {0.f, 0.f, 0.f, 0.f}, o[4] = {0.f, 0.f, 0.f, 0.f};
        int nch;
        if (br == 0) nch = nsel; else if (!sample) nch = (pc >> 6) - (lo >> 6) + 1; else nch = (512 - ((t + 1) & ~63)) / 64 + 1;
#pragma unroll 1
        for (int i = 0; i < nch; ++i) {
            bool bf = true; const void* kb; int stride = 1536, c_lo = 0, c_hi = 64, kp0;
            const bf16* newrows = P.KVb + (size_t)rowbase * 1536 + (2 + 2 * br) * 256 + g * 64;
            if (br == 0) { const int blk = __builtin_amdgcn_readfirstlane(((LAS int*)W)[AS_SEL + i]); kp0 = blk * 64;
                if (!sample) { kb = newrows + (size_t)kp0 * 1536; c_hi = (pc - kp0 + 1 < 64) ? pc - kp0 + 1 : 64; }
                else if (blk == 256) { kb = newrows; c_hi = t + 1; }
                else { const int phys = P.pt[b * NPAGES + (kp0 >> 7)]; kb = P.cache + ((size_t)phys * PAGE + (kp0 & (PAGE - 1))) * 1024 + 2 * 256 + g * 64; bf = false; stride = 1024; } }
            else if (!sample) { kp0 = (lo & ~63) + 64 * i; kb = newrows + (size_t)kp0 * 1536; c_lo = lo - kp0 > 0 ? lo - kp0 : 0; c_hi = (pc - kp0 + 1 < 64) ? pc - kp0 + 1 : 64; }
            else if (i < nch - 1) { const int i0 = ((t + 1) & ~63) + 64 * i; kb = P.swin + ((size_t)(b * 512 + i0) * 2) * 256 + g * 64; bf = false; stride = 512; c_lo = t + 1 - i0 > 0 ? t + 1 - i0 : 0; kp0 = PAST - 512 + i0; }
            else { kb = newrows; c_hi = t + 1; kp0 = PAST; }
            att_chunk<0>(bf, kb, stride, c_lo, c_hi, kp0, 1, pc, sl, W, m, l, o, nullptr, lane);
        }
#pragma unroll
        for (int n = 0; n < 4; ++n) ot[n] += P.GT[gi + 16 * (br + 1) + n] * o[n] / l[n];
    }
#pragma unroll
    for (int n = 0; n < 4; ++n) P.OB[(size_t)r * 1024 + (4 * g + n) * 64 + lane] = (bf16)f2bf(ot[n]);
    WSYNC();
}
namespace nsa {
typedef float f32x16 __attribute__((ext_vector_type(16)));
typedef short s16x4 __attribute__((ext_vector_type(4)));
typedef short v4i16_t __attribute__((ext_vector_type(4)));
constexpr float LOG2E = 1.4426950408889634f, MFLOOR = -1e20f;
constexpr int A_KS = 0, A_VS = 16384, A_IMPA = 32768, A_IMPB = 65536, A_IMPV = 98304, A_MASK = 106752, A_UNI = 107008, A_TL = 107072, A_WSF = 108096, A_END = 110144, A_OST = A_IMPA;
__device__ __forceinline__ int crow(int r, int hi) { return (r & 3) + 8 * (r >> 2) + 4 * hi; }
#define OPAQUE_PTR(p) asm volatile("" : "+v"(p))
__device__ __forceinline__ unsigned cvtpk(float lo, float hi) { return pg8::cvt_pk_bf16(lo, hi); }
__device__ __forceinline__ float pl32_max(float m) { auto rr = __builtin_amdgcn_permlane32_swap(__float_as_uint(m), __float_as_uint(m), false, false); return fmaxf(__uint_as_float(rr[0]), __uint_as_float(rr[1])); }
__device__ __forceinline__ float pl32_sum(float m) { auto rr = __builtin_amdgcn_permlane32_swap(__float_as_uint(m), __float_as_uint(m), false, false); return __uint_as_float(rr[0]) + __uint_as_float(rr[1]); }
__device__ __forceinline__ s16x4 vtr(const LAS unsigned char* p) { return __builtin_bit_cast(s16x4, __builtin_amdgcn_ds_read_tr16_b64_v4i16((LAS v4i16_t*)p)); }
__device__ __forceinline__ void qkt(f32x16& p0, f32x16& p1, const LAS unsigned char* Ks, const bf16x8 (&qr)[4], int r32, int hi) {
    const LAS unsigned char* kb = Ks + hi * 1024 + r32 * 16;
#pragma unroll
    for (int d0 = 0; d0 < 4; ++d0) { const bf16x8 b0 = *(const LAS bf16x8*)(kb + d0 * 2048), b1 = *(const LAS bf16x8*)(kb + d0 * 2048 + 512);
        p0 = __builtin_amdgcn_mfma_f32_32x32x16_bf16(b0, qr[d0], p0, 0, 0, 0); p1 = __builtin_amdgcn_mfma_f32_32x32x16_bf16(b1, qr[d0], p1, 0, 0, 0); }
}
__device__ __forceinline__ void pv(f32x16& o0, f32x16& o1, const LAS unsigned char* vp, const bf16x8 (&pa)[4]) {
#pragma unroll
    for (int d0 = 0; d0 < 2; ++d0) {
#pragma unroll
        for (int ks = 0; ks < 4; ++ks) { const s16x4 lo = vtr(vp + d0 * 4096 + ks * 1024), hh = vtr(vp + d0 * 4096 + ks * 1024 + 512);
            const bf16x8 B = {lo[0], lo[1], lo[2], lo[3], hh[0], hh[1], hh[2], hh[3]};
            if (d0 == 0) o0 = __builtin_amdgcn_mfma_f32_32x32x16_bf16(pa[ks], B, o0, 0, 0, 0); else o1 = __builtin_amdgcn_mfma_f32_32x32x16_bf16(pa[ks], B, o1, 0, 0, 0); } }
}
__device__ __forceinline__ float rowmax32(const f32x16& p0, const f32x16& p1) {
    float a = fmaxf(p0[0], p1[0]);
#pragma unroll
    for (int r = 1; r < 16; ++r) a = fmaxf(a, fmaxf(p0[r], p1[r]));
    return pl32_max(a);
}
struct Tile { int info, row0, col, kp0; };
struct UnitP { const bf16* QB; const bf16* KVB; const bf16* KC; const float* GT; bf16* OB; };
__device__ __forceinline__ void attn_prompt_unit(const UnitP& P, int b, int g, int i, LAS unsigned char* lds, int tid, int wave, int lane) {
    const int n = wave >> 1, qh = wave & 1, r32 = lane & 31, hi = lane >> 5, qloc = 32 * qh + r32, pos0 = 64 * i, qpos = pos0 + qloc, rowbase = b * SEQ;
    LAS float* wsf = (LAS float*)(lds + A_WSF) + wave * 64; LAS int* TL = (LAS int*)(lds + A_TL);
    LAS float* IA = (LAS float*)(lds + A_IMPA); LAS float* IB = (LAS float*)(lds + A_IMPB); LAS float* IV = (LAS float*)(lds + A_IMPV); LAS unsigned* MK = (LAS unsigned*)(lds + A_MASK); LAS unsigned* UNI = (LAS unsigned*)(lds + A_UNI);
    bf16x8 qr[4];
#pragma unroll
    for (int d0 = 0; d0 < 4; ++d0) { const v4u w = *(const v4u*)(P.QB + (size_t)(rowbase + qpos) * 1024 + (4 * g + n) * 64 + 16 * d0 + 8 * hi);
        v4u o; o.x = cvtpk(__uint_as_float(w.x << 16) * 0.125f, __uint_as_float(w.x & 0xffff0000u) * 0.125f); o.y = cvtpk(__uint_as_float(w.y << 16) * 0.125f, __uint_as_float(w.y & 0xffff0000u) * 0.125f);
        o.z = cvtpk(__uint_as_float(w.z << 16) * 0.125f, __uint_as_float(w.z & 0xffff0000u) * 0.125f); o.w = cvtpk(__uint_as_float(w.w << 16) * 0.125f, __uint_as_float(w.w & 0xffff0000u) * 0.125f);
        qr[d0] = __builtin_bit_cast(bf16x8, o); }
    const float slope = exp2f(-0.5f * (float)(4 * g + n + 1));
    const int gi = vgpr_i((rowbase + qpos) * 64 + 4 * g + n); const float gate0 = P.GT[gi], gate1 = P.GT[gi + 16], gate2 = P.GT[gi + 32];
    f32x16 ot0, ot1;
#pragma unroll
    for (int r = 0; r < 16; ++r) { ot0[r] = 0.f; ot1[r] = 0.f; }
    const LAS unsigned char* vp_l = lds + A_VS + ((lane >> 4) & 1) * 32 + (lane & 3) * 8 + (4 * hi + ((lane & 15) >> 2)) * 64;
    const int ncT = (i < 16) ? 1 : 2;
    if (tid < 2 * ncT) { const int pass = tid / ncT, j = tid % ncT; TL[4 * tid] = pass | (1 << 4) | (1 << 8); TL[4 * tid + 1] = b * NCP_P + 64 * j; TL[4 * tid + 2] = g * 64; TL[4 * tid + 3] = 64 * j; }
    __syncthreads();
    float m_run = MFLOOR, l_run = 0.f, invl = 0.f; f32x16 o0, o1; unsigned mymask = 0u;
#pragma unroll
    for (int r = 0; r < 16; ++r) { o0[r] = 0.f; o1[r] = 0.f; }
    int curbr = 0;
#pragma unroll 1
    for (int seq = 0; seq < 2; ++seq) {
        int NT;
        if (seq == 0) NT = 2 * ncT;
        else {
            { const int q = tid >> 3, part = tid & 7;
#pragma unroll
                for (int e = 0; e < 4; ++e) { const int s = 4 * part + e; float v;
                    if (s > i) v = -1.f; else if (s == 0 || s == i || s == i - 1) v = 1e4f;
                    else { v = 0.f;
#pragma unroll
                        for (int nn = 0; nn < 4; ++nn) v += IA[(nn * 32 + s) * 64 + q] + IB[(nn * 32 + s) * 64 + q]; }
                    IV[q * 33 + s] = v; }
                __syncthreads();
                float vv[32];
#pragma unroll
                for (int s = 0; s < 32; ++s) vv[s] = IV[q * 33 + s];
                unsigned bits = 0u;
#pragma unroll
                for (int e = 0; e < 4; ++e) { const int s = 4 * part + e; const float v = IV[q * 33 + s]; int rank = 0;
#pragma unroll
                    for (int s2 = 0; s2 < 32; ++s2) rank += (vv[s2] > v || (vv[s2] == v && s2 < s)) ? 1 : 0;
                    if (v >= 0.f && rank < 16) bits |= 1u << s; }
                bits |= __shfl_xor(bits, 1); bits |= __shfl_xor(bits, 2); bits |= __shfl_xor(bits, 4);
                if (part == 0) MK[q] = bits;
                bits |= __shfl_xor(bits, 8); bits |= __shfl_xor(bits, 16); bits |= __shfl_xor(bits, 32);
                if (lane == 0) UNI[wave] = bits;
                __syncthreads();
                unsigned uni = 0u;
#pragma unroll
                for (int w = 0; w < 8; ++w) uni |= UNI[w];
                const int nsel = __builtin_popcount(uni), nwin = (i < 8) ? i + 1 : 9;
                NT = nsel + nwin;
                if (tid < NT) { int info, blk;
                    if (tid < nsel) { unsigned u = uni; for (int k = 0; k < tid; ++k) u &= u - 1; blk = __builtin_ctz(u); info = 2 | ((blk == i ? 1 : 0) << 4); TL[4 * tid + 2] = 2 * 256 + g * 64; }
                    else { const int j = tid - nsel; blk = i - j; info = 3 | ((j == 0 ? 1 : (j == 8 ? 2 : 0)) << 4); TL[4 * tid + 2] = 4 * 256 + g * 64; }
                    TL[4 * tid] = info; TL[4 * tid + 1] = rowbase + 64 * blk; TL[4 * tid + 3] = 64 * blk; }
                __syncthreads();
                mymask = MK[qloc]; }
        }
        v4u kreg, vreg;
        { const int info = TL[0], row0 = TL[1], col = TL[2]; const bf16* src = (info & 256) ? P.KC : P.KVB; const int stride = (info & 256) ? 512 : 1536;
            kreg = *(const v4u*)(src + (size_t)(row0 + lane) * stride + col + 8 * wave);
            vreg = *(const v4u*)(src + (size_t)(row0 + 16 * (wave & 3) + (lane >> 2)) * stride + col + 256 + (wave >> 2) * 32 + (lane & 3) * 8);
            *(LAS v4u*)(lds + A_KS + wave * 1024 + lane * 16) = kreg; *(LAS v4u*)(lds + A_VS + wave * 1024 + lane * 16) = vreg; }
        __syncthreads();
#pragma unroll 1
        for (int t = 0; t < NT; ++t) {
            const int slot = (t & 1) * 8192;
            if (t + 1 < NT) { const int info = TL[4 * (t + 1)], row0 = TL[4 * (t + 1) + 1], col = TL[4 * (t + 1) + 2]; const bf16* src = (info & 256) ? P.KC : P.KVB; const int stride = (info & 256) ? 512 : 1536;
                kreg = *(const v4u*)(src + (size_t)(row0 + lane) * stride + col + 8 * wave);
                vreg = *(const v4u*)(src + (size_t)(row0 + 16 * (wave & 3) + (lane >> 2)) * stride + col + 256 + (wave >> 2) * 32 + (lane & 3) * 8); }
            const int info = __builtin_amdgcn_readfirstlane(TL[4 * t]), kp0 = __builtin_amdgcn_readfirstlane(TL[4 * t + 3]);
            const int br = info & 15, mkind = (info >> 4) & 15;
            if (br != curbr) {
                if (curbr == 0) { const float lt = pl32_sum(l_run); invl = (qpos >= 31 && lt > 0.f) ? 1.0f / lt : 0.f; }
                else { float f;
                    if (curbr == 1) f = gate0; else { const float lt = pl32_sum(l_run); f = (curbr == 2 ? gate1 : gate2) / lt; }
                    if (hi == 0) wsf[r32] = f;
                    WSYNC();
                    { const LAS float* wsb = wsf + 4 * hi; OPAQUE_PTR(wsb);
#pragma unroll
                    for (int r = 0; r < 16; ++r) { const float fr = wsb[(r & 3) + 8 * (r >> 2)]; ot0[r] += o0[r] * fr; ot1[r] += o1[r] * fr; o0[r] = 0.f; o1[r] = 0.f; } }
                    WSYNC();
                    m_run = MFLOOR; l_run = 0.f; }
                curbr = br; }
            const float sk = (br < 2) ? 16.f * slope : slope;
            float tb = slope * (float)((br < 2 ? 16 * kp0 + 31 : kp0) - pos0);
            if (br == 2 && !((mymask >> (kp0 >> 6)) & 1u)) tb = -INFINITY;
            const float tbh = tb + sk * (float)(4 * hi);
            f32x16 p0, p1;
#pragma unroll
            for (int r = 0; r < 16; ++r) { p0[r] = tbh + sk * (float)((r & 3) + 8 * (r >> 2)); p1[r] = p0[r] + 32.f * sk; }
            qkt(p0, p1, lds + A_KS + slot, qr, r32, hi);
            if (mkind) { int klo = -1, khi = 64;
                if (br < 2) khi = (qpos >= 31 ? (qpos - 31) >> 4 : -1) - kp0; else if (mkind == 1) khi = qpos - kp0; else klo = qpos - 512 - kp0;
                klo -= 4 * hi; khi -= 4 * hi;
#pragma unroll
                for (int r = 0; r < 16; ++r) { const int k = (r & 3) + 8 * (r >> 2);
                    if (k <= klo || k > khi) p0[r] = -INFINITY;
                    if (k + 32 <= klo || k + 32 > khi) p1[r] = -INFINITY; } }
            if (br != 1) {
                const float rm = rowmax32(p0, p1);
                if (__any(rm > m_run)) { const float mn = fmaxf(m_run, rm); const float alpha = __builtin_amdgcn_exp2f((m_run - mn) * LOG2E); l_run *= alpha; m_run = mn;
                    if (br != 0) { if (hi == 0) wsf[r32] = alpha;
                        WSYNC();
                        { const LAS float* wsb = wsf + 4 * hi; OPAQUE_PTR(wsb);
#pragma unroll
                        for (int r = 0; r < 16; ++r) { const float fr = wsb[(r & 3) + 8 * (r >> 2)]; o0[r] *= fr; o1[r] *= fr; } }
                        WSYNC(); } } }
            const float mL = m_run * LOG2E; float sacc = 0.f;
#pragma unroll
            for (int r = 0; r < 16; ++r) { p0[r] = __builtin_amdgcn_exp2f(p0[r] * LOG2E - mL); p1[r] = __builtin_amdgcn_exp2f(p1[r] * LOG2E - mL); sacc += p0[r] + p1[r]; }
            if (br == 0) l_run += sacc;
            else {
                if (br == 1) {
#pragma unroll
                    for (int r = 0; r < 16; ++r) { p0[r] *= invl; p1[r] *= invl; }
                    const int sb = (kp0 >> 2) + hi;
                    LAS float* ia = IA + (n * 32 + sb) * 64 + qloc; LAS float* ib = IB + (n * 32 + sb + 1) * 64 + qloc; OPAQUE_PTR(ia); OPAQUE_PTR(ib);
#pragma unroll
                    for (int k4 = 0; k4 < 4; ++k4) { const int s0 = sb + 2 * k4, s1 = s0 + 8;
                        const float a0 = (p0[4 * k4] + p0[4 * k4 + 1]) + (p0[4 * k4 + 2] + p0[4 * k4 + 3]), a1 = (p1[4 * k4] + p1[4 * k4 + 1]) + (p1[4 * k4 + 2] + p1[4 * k4 + 3]);
                        ia[2 * k4 * 64] = a0; ia[(2 * k4 + 8) * 64] = a1;
                        if (s0 + 1 < 32) ib[2 * k4 * 64] = p0[4 * k4 + 3];
                        if (s1 + 1 < 32) ib[(2 * k4 + 8) * 64] = p1[4 * k4 + 3]; } }
                else l_run += sacc;
                bf16x8 pa[4];
                { v4u w;
                    w.x = cvtpk(p0[0], p0[1]); w.y = cvtpk(p0[2], p0[3]); w.z = cvtpk(p0[4], p0[5]); w.w = cvtpk(p0[6], p0[7]); pa[0] = __builtin_bit_cast(bf16x8, w);
                    w.x = cvtpk(p0[8], p0[9]); w.y = cvtpk(p0[10], p0[11]); w.z = cvtpk(p0[12], p0[13]); w.w = cvtpk(p0[14], p0[15]); pa[1] = __builtin_bit_cast(bf16x8, w);
                    w.x = cvtpk(p1[0], p1[1]); w.y = cvtpk(p1[2], p1[3]); w.z = cvtpk(p1[4], p1[5]); w.w = cvtpk(p1[6], p1[7]); pa[2] = __builtin_bit_cast(bf16x8, w);
                    w.x = cvtpk(p1[8], p1[9]); w.y = cvtpk(p1[10], p1[11]); w.z = cvtpk(p1[12], p1[13]); w.w = cvtpk(p1[14], p1[15]); pa[3] = __builtin_bit_cast(bf16x8, w); }
                pv(o0, o1, vp_l + slot, pa); }
            if (t + 1 < NT) { const int ns = ((t + 1) & 1) * 8192; *(LAS v4u*)(lds + A_KS + ns + wave * 1024 + lane * 16) = kreg; *(LAS v4u*)(lds + A_VS + ns + wave * 1024 + lane * 16) = vreg; }
            __syncthreads();
        }
        if (seq == 0) {
            if (hi == 0) wsf[r32] = gate0;
            WSYNC();
            { const LAS float* wsb = wsf + 4 * hi; OPAQUE_PTR(wsb);
#pragma unroll
            for (int r = 0; r < 16; ++r) { const float fr = wsb[(r & 3) + 8 * (r >> 2)]; ot0[r] += o0[r] * fr; ot1[r] += o1[r] * fr; o0[r] = 0.f; o1[r] = 0.f; } }
            WSYNC();
            m_run = MFLOOR; l_run = 0.f; curbr = 2; }
    }
    { const float lt = pl32_sum(l_run); const float f = gate2 / lt;
        if (hi == 0) wsf[r32] = f;
        WSYNC();
        { const LAS float* wsb = wsf + 4 * hi; OPAQUE_PTR(wsb);
#pragma unroll
        for (int r = 0; r < 16; ++r) { const float fr = wsb[(r & 3) + 8 * (r >> 2)]; ot0[r] += o0[r] * fr; ot1[r] += o1[r] * fr; } }
        WSYNC(); }
    { LAS bf16* stg = (LAS bf16*)(lds + A_OST) + wave * 2048;
        { LAS bf16* sb2 = stg + 256 * hi + r32; OPAQUE_PTR(sb2);
#pragma unroll
        for (int r = 0; r < 16; ++r) { sb2[((r & 3) + 8 * (r >> 2)) * 64] = (bf16)f2bf(ot0[r]); sb2[((r & 3) + 8 * (r >> 2)) * 64 + 32] = (bf16)f2bf(ot1[r]); } }
        WSYNC();
        bf16* Ow = P.OB + (size_t)(rowbase + pos0 + 32 * qh) * 1024 + (4 * g + n) * 64;
#pragma unroll
        for (int k = 0; k < 4; ++k) { const int row = k * 8 + (lane >> 3), ch = lane & 7; const v4u v = *(const LAS v4u*)(stg + row * 64 + ch * 8); *(v4u*)(Ow + (size_t)row * 1024 + ch * 8) = v; } }
    __syncthreads();
}
}
#ifndef MK_N_LAUNCHES
#define MK_N_LAUNCHES 1
#endif
constexpr int N_PHASES = 10;
#ifndef PHASE_MASK
#define PHASE_MASK 0x3ff
#endif
struct Args { const void* in[28]; float* out; unsigned char* ws; int ph_lo, ph_hi; };
__global__ void __launch_bounds__(NWAVES * 64, 2) mega_fwd(Args args) {
    extern __shared__ __attribute__((aligned(16))) unsigned char lds_raw[];
    LAS unsigned char* lds = (LAS unsigned char*)lds_raw;
    volatile LAS unsigned* MISC = (volatile LAS unsigned*)(lds + MISC_OFF);
    const int tid = threadIdx.x, lane = tid & 63, wave = __builtin_amdgcn_readfirstlane(tid >> 6);
    const int G = gridDim.x; const int bx = blockIdx.x; const int vcu = (G % 8 == 0) ? (bx % 8) * (G / 8) + bx / 8 : bx;
    const int gw = vcu * NWAVES + wave, NGW = G * NWAVES;
    unsigned char* ws = args.ws; float* out = args.out;
    gu32* ctl = (gu32*)(ws + WS_CTL);
    const float* x_prompt = (const float*)args.in[0]; const float* x_sample = (const float*)args.in[1]; const float* cache_kv = (const float*)args.in[2]; const float* state_win = (const float*)args.in[3];
    const float* st_re = (const float*)args.in[4]; const float* st_im = (const float*)args.in[5]; const int* page_table = (const int*)args.in[6];
    const float* g_mix = (const float*)args.in[7]; const float* w_in = (const float*)args.in[8]; const float* cmp_pe = (const float*)args.in[9]; const float* cmp_pool = (const float*)args.in[10]; const float* cmp_phi = (const float*)args.in[11];
    const float* w_attn_out = (const float*)args.in[12];
    const SsmIn SI{(const float*)args.in[13], (const float*)args.in[14], (const float*)args.in[15], (const float*)args.in[16], (const float*)args.in[17], (const float*)args.in[18], (const float*)args.in[19], (const float*)args.in[20]};
    const float* w_glu = (const float*)args.in[21]; const float* w_out = (const float*)args.in[22]; const float* g_ffn = (const float*)args.in[23];
    const float* w_gate = (const float*)args.in[24]; const float* w_up = (const float*)args.in[25]; const float* w_down = (const float*)args.in[26]; const float* g_final = (const float*)args.in[27];
    bf16* WIN = (bf16*)(ws + WS_WIN); bf16* WA = (bf16*)(ws + WS_WA); bf16* WGLU = (bf16*)(ws + WS_WGLU); bf16* WOUT = (bf16*)(ws + WS_WOUT); bf16* WGU = (bf16*)(ws + WS_WGU); bf16* WDN = (bf16*)(ws + WS_WDN);
    bf16* XN = (bf16*)(ws + WS_XN); float* RSTD1 = (float*)(ws + WS_RSTD1); bf16* QB = (bf16*)(ws + WS_QB); bf16* KVB = (bf16*)(ws + WS_KVB); float* U = (float*)(ws + WS_U);
    bf16* MG = (bf16*)(ws + WS_MG); float* GT = (float*)(ws + WS_GT); bf16* KCP = (bf16*)(ws + WS_KCP); bf16* KCS = (bf16*)(ws + WS_KCS); bf16* GY = (bf16*)(ws + WS_GY);
    bf16* OB = (bf16*)(ws + WS_OB); bf16* MB = (bf16*)(ws + WS_MB); float* X2 = (float*)(ws + WS_X2); bf16* HH = (bf16*)(ws + WS_HH); float* Y = (float*)(ws + WS_Y);
    float* SS2 = (float*)(ws + WS_CTL) + CW_SS2; float* SS3 = (float*)(ws + WS_CTL) + CW_SS3;

    for (int u = tid; u < (LDS_BYTES - LDSCTL_OFF) / 4; u += NWAVES * 64) ((LAS unsigned*)(lds + LDSCTL_OFF))[u] = 0u;
    __syncthreads();
    const int lo = args.ph_lo, hi = args.ph_hi;
    XcdBarrier bar; bar.bar = (unsigned*)(ctl + CW_BAR); bar.x = 0; bar.st = nullptr;
    if (hi - lo > 1) bar = xcd_barrier_post((unsigned*)(ctl + CW_BAR), MISC + 8);
#define IN(k) (lo <= (k) && (k) < hi)
#define SEAM(k) do { if (IN(k) && IN((k) + 1)) xcd_barrier(bar); } while (0)

    if (((PHASE_MASK >> 0) & 1) && IN(0)) {
        LAS unsigned* scr = (LAS unsigned*)(lds + RING_OFF) + wave * (32 * 65);
        constexpr int I0 = 32 * 124, I1 = 16 * 32, I2 = 16 * 64, I3 = 32 * 32, I4 = 32 * 176, I5 = 88 * 32, ITOT = I0 + I1 + I2 + I3 + I4 + I5;
        for (int it = gw; it < ITOT; it += NGW) { int r = it;
            if (r < I0) { const TrJob j{w_in, nullptr, g_mix, WIN, 2048, IN_COLS, NIN, 1}; tr_item(j, r, scr, lane); continue; } r -= I0;
            if (r < I1) { const TrJob j{w_attn_out, nullptr, nullptr, WA, 1024, 2048, 2048, 0}; tr_item(j, r, scr, lane); continue; } r -= I1;
            if (r < I2) { const TrJob j{w_glu, nullptr, nullptr, WGLU, 1024, 4096, 4096, 2}; tr_item(j, r, scr, lane); continue; } r -= I2;
            if (r < I3) { const TrJob j{w_out, nullptr, nullptr, WOUT, 2048, 2048, 2048, 0}; tr_item(j, r, scr, lane); continue; } r -= I3;
            if (r < I4) { const TrJob j{w_gate, w_up, g_ffn, WGU, 2048, DFF, 2 * DFF, 3}; tr_item(j, r, scr, lane); continue; } r -= I4;
            { const TrJob j{w_down, nullptr, nullptr, WDN, DFF, 2048, 2048, 0}; tr_item(j, r, scr, lane); } }
        for (int m = gw; m < MPAD; m += NGW) xn_row(m < MP ? x_prompt + (size_t)m * D_MODEL : (m < MROWS ? x_sample + (size_t)(m - MP) * D_MODEL : nullptr), XN + (size_t)m * D_MODEL, RSTD1 + m, lane);
        for (int i4 = (vcu * NWAVES * 64 + tid); i4 < DEC_B * 504 * 128; i4 += G * NWAVES * 64) { const int b = i4 / (504 * 128), rem = i4 - b * (504 * 128);
            *(GAS f32x4*)(out + O_WINS + (size_t)b * 512 * 512 + (size_t)rem * 4) = *(const GAS f32x4*)(state_win + (size_t)b * 512 * 512 + 8 * 512 + (size_t)rem * 4); }
        __syncthreads();
        compress_setup(cmp_pe, cmp_pool, cmp_phi, (LAS float*)(lds + RING_OFF), tid);
        for (int it = gw; it < DEC_B * 128; it += NGW) { const int b = it >> 7, i = it & 127; compress_item<true>(cache_kv, page_table, b, i, NC_S, KCS + (size_t)b * NCP_S * 512, (LAS float*)(lds + RING_OFF), wave, lane); }
        __syncthreads();
    }
    SEAM(0);
    if (((PHASE_MASK >> 1) & 1) && IN(1)) {
        pg8::Gemm g{XN, WIN, MPAD, NIN, D_MODEL}; pg8::StaticOrder S; S.init(MPAD, NIN, G, bx);
        epi::EpiInProj E{QB, KVB, U, MG, GT, RSTD1, out};
        pg8::gemm_phase<epi::EpiInProj, pg8::StaticOrder, true, true>(lds + RING_OFF, g, S, E);
    }
    SEAM(1);
    if (((PHASE_MASK >> 2) & 1) && IN(2)) {
#ifndef NO_P2_CMP
        if (vcu < 8) { compress_setup(cmp_pe, cmp_pool, cmp_phi, (LAS float*)(lds + RING_OFF), tid);
            for (int it = gw; it < BATCH * 16; it += NGW) { const int b = it >> 4, i = it & 15; compress_item<false>(out + O_KVP, nullptr, b, i, NC_P, KCP + (size_t)b * NCP_P * 512, (LAS float*)(lds + RING_OFF), wave, lane); } }
#endif
        if (vcu == 8) { for (int j = tid; j < BATCH * 64; j += NWAVES * 64) *(GAS v4u*)(KCP + (size_t)((j >> 6) * NCP_P + 127) * 512 + 8 * (j & 63)) = (v4u){0u, 0u, 0u, 0u}; }
        __syncthreads();
#ifndef NO_P2_SSMP
        for (int it = vcu; it < BATCH * SSM_NG; it += G) ssm_prompt_item(SI, it >> 6, it & 63, U, GY, out, lds + RING_OFF, wave, lane);
#endif
#ifndef NO_P2_SSMS
        for (int it = gw; it < DEC_B * SSM_NG; it += NGW) ssm_sample_item(SI, it >> 6, it & 63, U, st_re, st_im, GY, out, lds + RING_OFF, wave, lane);
#endif
        __syncthreads();
    }
    SEAM(2);
    if (((PHASE_MASK >> 3) & 1) && IN(3)) {
        { const nsa::UnitP UP{QB, KVB, KCP, GT, OB}; LAS int* QS = (LAS int*)(lds + nsa::A_UNI + 32);
            for (;;) { if (tid == 0) QS[0] = (int)__hip_atomic_fetch_add(ctl + CW_Q, 1u, RLX_AGENT); __syncthreads(); const int u = QS[0]; __syncthreads(); if (u >= BATCH * NKV * 32) break;
                nsa::attn_prompt_unit(UP, (u & 15) >> 2, u & 3, 31 - (u >> 4), lds + RING_OFF, tid, wave, lane); } }
        const AttnP P{QB, KVB, KCP, KCS, GT, cache_kv, state_win, page_table, OB};
        LAS float* W = (LAS float*)(lds + RING_OFF) + wave * AS_WORDS;
#ifndef NO_P3_SIMPLE
        for (int it = gw; it < MS * NKV; it += NGW) attn_item_simple(P, MP + (it >> 2), it & 3, W, lane);
#endif
        __syncthreads();
    }
    SEAM(3);
    if (((PHASE_MASK >> 4) & 1) && IN(4)) {
        pg8::Gemm g{GY, WGLU, MPAD, 4096, 1024}; pg8::StaticOrder S; S.init(MPAD, 4096, G, bx);
        epi::EpiGlu E{MG, MB};
        pg8::gemm_phase<epi::EpiGlu, pg8::StaticOrder, true, true>(lds + RING_OFF, g, S, E);
    }
    SEAM(4);
    if (((PHASE_MASK >> 5) & 1) && IN(5)) {
        pg8::Gemm g{OB, WA, MPAD, 2048, 1024}; pg8::StaticOrder S; S.init(MPAD, 2048, G, bx);
        epi::EpiAttnOut E{MG, MB};
        pg8::gemm_phase<epi::EpiAttnOut, pg8::StaticOrder, true, true>(lds + RING_OFF, g, S, E);
    }
    SEAM(5);
    if (((PHASE_MASK >> 6) & 1) && IN(6)) {
        pg8::Gemm g{MB, WOUT, MPAD, 2048, 2048}; pg8::StaticOrder S; S.init(MPAD, 2048, G, bx);
        epi::EpiWout E{x_prompt, x_sample, X2, XN, SS2};
        pg8::gemm_phase<epi::EpiWout, pg8::StaticOrder, true, true>(lds + RING_OFF, g, S, E);
    }
    SEAM(6);
    if (((PHASE_MASK >> 7) & 1) && IN(7)) {
        pg8::Gemm g{XN, WGU, MPAD, 2 * DFF, 2048}; pg8::StaticOrder S; S.init(MPAD, 2 * DFF, G, bx);
        epi::EpiGateUp E{SS2, HH};
        pg8::gemm_phase<epi::EpiGateUp, pg8::StaticOrder, true, true>(lds + RING_OFF, g, S, E);
    }
    SEAM(7);
    if (((PHASE_MASK >> 8) & 1) && IN(8)) {
        pg8::Gemm g{HH, WDN, MPAD, 2048, DFF}; pg8::StaticOrder S; S.init(MPAD, 2048, G, bx);
        epi::EpiDown E{X2, Y, SS3};
        pg8::gemm_phase<epi::EpiDown, pg8::StaticOrder, true, true>(lds + RING_OFF, g, S, E);
    }
    SEAM(8);
    if (((PHASE_MASK >> 9) & 1) && IN(9)) {
        for (int r = gw; r < MROWS; r += NGW) {
            const float rs = 1.0f / sqrtf(SS3[vgpr_i(r)] * (1.0f / D_MODEL) + EPS);
#ifdef EXP_Y_FROM_X2
            const GAS f32x4* yr = (const GAS f32x4*)(X2 + (size_t)r * D_MODEL) + lane;
#else
            const GAS f32x4* yr = (const GAS f32x4*)(Y + (size_t)r * D_MODEL) + lane;
#endif
            const GAS f32x4* gf = (const GAS f32x4*)g_final + lane;
            GAS f32x4* o = (GAS f32x4*)(r < MP ? out + O_YP + (size_t)r * D_MODEL : out + O_YS + (size_t)(r - MP) * D_MODEL) + lane;
#pragma unroll
#ifdef EXP_Y_FROM_BF
            for (int j = 0; j < 8; ++j) { const int col = (4 * (lane + 64 * j)) % EXP_BF_LD; const bf16* sp = EXP_Y_FROM_BF + (size_t)r * EXP_BF_LD + col;
                f32x4 ov = (f32x4){bf2f(sp[0]), bf2f(sp[1]), bf2f(sp[2]), bf2f(sp[3])};
#ifdef EXP_SCRUB_NAN
                for (int e = 0; e < 4; ++e) if (!(ov[e] == ov[e]) || fabsf(ov[e]) > 1e30f) ov[e] = 12345.f;
#endif
                o[64 * j] = ov; }
#elif defined(EXP_ZERO_Y)
            for (int j = 0; j < 8; ++j) o[64 * j] = (f32x4){0.f, 0.f, 0.f, 0.f};
#else
            for (int j = 0; j < 8; ++j) o[64 * j] = yr[64 * j] * rs * gf[64 * j];
#endif
        }
    }
#undef IN
#undef SEAM
}

extern "C" void kernel_launch(void* const* d_in, const int* in_sizes, int n_in, void* d_out, int out_size, void* d_ws, size_t ws_size, hipStream_t stream) {
    static int grid = 0;
    if (grid == 0) {
        if (n_in != 28 || ws_size < WS_END) { fprintf(stderr, "kernel_launch: unexpected inputs (n_in %d, ws %zu < %zu)\n", n_in, ws_size, (size_t)WS_END); grid = -1; return; }
        int dev = 0, cus = 0;
        if (hipGetDevice(&dev) != hipSuccess || hipDeviceGetAttribute(&cus, hipDeviceAttributeMultiprocessorCount, dev) != hipSuccess) { grid = -1; return; }
        if (hipFuncSetAttribute((const void*)mega_fwd, hipFuncAttributeMaxDynamicSharedMemorySize, LDS_BYTES) != hipSuccess) { fprintf(stderr, "kernel_launch: hipFuncSetAttribute failed\n"); grid = -1; return; }
        (void)hipGetLastError();
        grid = cus;
    }
    if (grid < 0) return;
    (void)hipMemsetAsync((char*)d_ws + WS_CTL, 0, CTL_ZERO_BYTES, stream);
    Args a{};
    for (int i = 0; i < 28; ++i) a.in[i] = d_in[i];
    a.out = (float*)d_out; a.ws = (unsigned char*)d_ws;
#if MK_N_LAUNCHES == 1
    a.ph_lo = 0; a.ph_hi = N_PHASES;
    hipLaunchKernelGGL(mega_fwd, dim3(grid), dim3(NWAVES * 64), LDS_BYTES, stream, a);
#else
#ifndef EXP_SKIP_LO
#define EXP_SKIP_LO 100
#define EXP_SKIP_HI 100
#endif
    for (int ph = 0; ph < N_PHASES; ++ph) { if (ph >= EXP_SKIP_LO && ph <= EXP_SKIP_HI) continue; a.ph_lo = ph; a.ph_hi = ph + 1; hipLaunchKernelGGL(mega_fwd, dim3(grid), dim3(NWAVES * 64), LDS_BYTES, stream, a); }
#endif
}
```

```cpp
#include <hip/hip_runtime.h>
#include <hip/hip_bf16.h>
#include <cstdio>
#include <cstdint>
constexpr int D_MODEL = 2048, BATCH = 4, SEQ = 2048, DEC_B = 8, DEC_T = 8, PAST = 16384, PAGE = 128, NPAGES = PAST / PAGE;
constexpr int NH = 16, HD = 64, NKV = 4, GRP = 4;
constexpr int SSM_W = 1024, SSM_NG = 64, SSM_P = 64, SSM_C = 16;
constexpr int DFF = 5632;
constexpr int MP = BATCH * SEQ, MS = DEC_B * DEC_T, MROWS = MP + MS, MPAD = 8448;
constexpr int IN_COLS = 7728, NIN = 7936;
constexpr int NC_P = 127, NCP_P = 128, NC_S = 1023, NCP_S = 1024;
constexpr float EPS = 1e-6f;
constexpr size_t O_YP = 0, O_YS = 16777216, O_KVP = 16908288, O_WINP = 25296896, O_HRP = 26345472, O_HIP = 26361856, O_KVS = 26378240, O_WINS = 26443776, O_HRS = 28540928, O_HIS = 28573696;
constexpr size_t al256(size_t x) { return (x + 255) & ~(size_t)255; }
constexpr size_t WS_CTL = 0, CTL_ZERO_BYTES = 1u << 20;
constexpr int CW_TMO = 0, CW_Q = 512, CW_BAR = 4096, CW_SS2 = 65536, CW_SS3 = 81920;
constexpr size_t WS_WIN = CTL_ZERO_BYTES;
constexpr size_t WS_WA = WS_WIN + al256((size_t)NIN * 2048 * 2);
constexpr size_t WS_WGLU = WS_WA + al256((size_t)2048 * 1024 * 2);
constexpr size_t WS_WOUT = WS_WGLU + al256((size_t)4096 * 1024 * 2);
constexpr size_t WS_WGU = WS_WOUT + al256((size_t)2048 * 2048 * 2);
constexpr size_t WS_WDN = WS_WGU + al256((size_t)2 * DFF * 2048 * 2);
constexpr size_t WS_XN = WS_WDN + al256((size_t)2048 * DFF * 2);
constexpr size_t WS_RSTD1 = WS_XN + al256((size_t)MPAD * 2048 * 2);
constexpr size_t WS_QB = WS_RSTD1 + al256((size_t)MPAD * 4);
constexpr size_t WS_KVB = WS_QB + al256((size_t)MPAD * 1024 * 2);
constexpr size_t WS_U = WS_KVB + al256((size_t)MPAD * 1536 * 2);
constexpr size_t WS_MG = WS_U + al256((size_t)MPAD * 1024 * 4);
constexpr size_t WS_GT = WS_MG + al256((size_t)MPAD * 4096 * 2);
constexpr size_t WS_KCP = WS_GT + al256((size_t)MPAD * 64 * 4);
constexpr size_t WS_KCS = WS_KCP + al256((size_t)BATCH * NCP_P * 512 * 4);
constexpr size_t WS_GY = WS_KCS + al256((size_t)DEC_B * NCP_S * 512 * 4);
constexpr size_t WS_OB = WS_GY + al256((size_t)MPAD * 1024 * 2);
constexpr size_t WS_MB = WS_OB + al256((size_t)MPAD * 1024 * 2);
constexpr size_t WS_X2 = WS_MB + al256((size_t)MPAD * 2048 * 2);
constexpr size_t WS_HH = WS_X2 + al256((size_t)MPAD * 2048 * 4);
constexpr size_t WS_Y = WS_HH + al256((size_t)MPAD * DFF * 2);
constexpr size_t WS_END = WS_Y + al256((size_t)MPAD * 2048 * 4);
namespace pg8 {
#define PG8_LAS __attribute__((address_space(3)))
typedef unsigned short bf16_t;
typedef short bf16x8 __attribute__((ext_vector_type(8)));
typedef float f32x4 __attribute__((ext_vector_type(4)));
typedef unsigned u32x4 __attribute__((ext_vector_type(4)));
constexpr int BM = 256, BK = 64, HALF = 128, HTB = HALF * BK * 2  , STAGE_BYTES = 8 * HTB, NXCD = 8, WGM = 8;

__host__ __device__ __forceinline__ int lds_byte(int r, int c) { const int st = (r >> 4) * 2 + (c >> 5), rr = r & 15, cc = c & 31, ob = rr * 64 + cc * 2; return st * 1024 + (ob ^ (((ob >> 9) & 1) << 5)); }
__host__ __device__ __forceinline__ void stage_rc(int b, int& R, int& C) { const int st = b / 1024, sb = b % 1024, swz = sb ^ (((sb >> 9) & 1) << 5); R = (st >> 1) * 16 + swz / 64; C = (st & 1) * 32 + (swz % 64) / 2; }
__host__ __device__ __forceinline__ int perm32(int rho) { const int n = rho >> 4, i = rho & 15; return 8 * (i >> 2) + 4 * n + (i & 3); }

struct Unit { int pm, pn; };
struct Gemm { const bf16_t* A; const bf16_t* Bt; int M, N, K; };

struct StaticOrder {
    int nM, nN, nwg, G, c;
    __host__ __device__ void init(int M, int N, int G_, int c_) { nM = M / BM; nN = N / BM; nwg = nM * nN; G = G_; c = c_; }
    __host__ __device__ bool next(int i, Unit& u) const {
        const long L = (long)i * G + c; if (L >= nwg) return false;
        int wgid = (int)L; { const int q = nwg / NXCD, r = nwg % NXCD, xcd = wgid % NXCD, off = wgid / NXCD; wgid = (xcd < r ? xcd * (q + 1) : r * (q + 1) + (xcd - r) * q) + off; }
        const int nig = WGM * nN, gid = wgid / nig, fm = gid * WGM, gsz = (nM - fm) < WGM ? (nM - fm) : WGM;
        u.pm = fm + ((wgid % nig) % gsz); u.pn = (wgid % nig) / gsz; return true;
    }
    __device__ __forceinline__ void a_ready(const Unit&) const {}
    __device__ __forceinline__ void done(const Unit&) const {}
};

typedef float f32x2_cv __attribute__((ext_vector_type(2))); typedef __bf16 bf16x2_cv __attribute__((ext_vector_type(2)));
__device__ __forceinline__ unsigned cvt_pk_bf16(float lo, float hi) { f32x2_cv v = {lo, hi}; bf16x2_cv b = __builtin_convertvector(v, bf16x2_cv); return __builtin_bit_cast(unsigned, b); }
template <class Epi, class Sched, bool ALIGN_EPI = false, bool SP2 = false>
__device__ __forceinline__ void gemm_phase(PG8_LAS unsigned char* lds, const Gemm g, const Sched& S, const Epi& E) {
    const int tid = threadIdx.x, wid = __builtin_amdgcn_readfirstlane(tid >> 6), lane = tid & 63, wr = wid >> 2, wc = wid & 3, fr = lane & 15, fq = lane >> 4;
    const int K = g.K, nt = K / BK;
    unsigned voffA[2], voffB[2];
#pragma unroll
    for (int i = 0; i < 2; ++i) { int R, C; stage_rc(tid * 16 + i * 8192, R, C); const int Rb = Epi::PERM ? ((R & ~31) + perm32(R & 31)) : R;
        voffA[i] = (unsigned)(R * K + C) * 2u; voffB[i] = (unsigned)(Rb * K + C) * 2u; }
    const size_t kstep = (size_t)(BK * 2);
    const size_t hstep = (size_t)HALF * K * 2;
    const size_t tstep = 2 * hstep;
    const unsigned ldsw = (unsigned)wid * 1024u;
    const int aoff = lds_byte(wr * 64 + fr, fq * 8), boff = lds_byte(wc * 32 + fr, fq * 8);
#define PG8_SA(b, h) (((b) * 2 + (h)) * HTB)
#define PG8_SB(b, h) ((4 + (b) * 2 + (h)) * HTB)
#define PG8_STAGE(bufoff, gbase, voff) do { _Pragma("unroll") for (int _i = 0; _i < 2; ++_i) \
        __builtin_amdgcn_global_load_lds((const unsigned*)((const char*)(gbase) + (voff)[_i]), (PG8_LAS unsigned*)(lds + (bufoff) + ldsw + _i * 8192), 16, 0, 0); } while (0)
#define PG8_LDA(dst, b, h) do { _Pragma("unroll") for (int m = 0; m < 4; ++m) _Pragma("unroll") for (int k = 0; k < 2; ++k) dst[m][k] = *(const PG8_LAS bf16x8*)(lds + PG8_SA(b, h) + aoff + m * 2048 + k * 1024); } while (0)
#define PG8_LDB(dst, b, h) do { _Pragma("unroll") for (int n = 0; n < 2; ++n) _Pragma("unroll") for (int k = 0; k < 2; ++k) dst[n][k] = *(const PG8_LAS bf16x8*)(lds + PG8_SB(b, h) + boff + n * 2048 + k * 1024); } while (0)
#define PG8_MMA(ai, bj, At, Bt) do { __builtin_amdgcn_s_setprio(1); _Pragma("unroll") for (int m = 0; m < 4; ++m) _Pragma("unroll") for (int n = 0; n < 2; ++n) _Pragma("unroll") for (int k = 0; k < 2; ++k) \
        acc[ai][bj][m][n] = __builtin_amdgcn_mfma_f32_16x16x32_bf16(Bt[n][k], At[m][k], acc[ai][bj][m][n], 0, 0, 0); __builtin_amdgcn_s_setprio(0); } while (0)
#define PG8_WAIT_V(n) asm volatile("s_waitcnt vmcnt(" #n ")" ::: "memory")
#define PG8_WAIT_L(n) asm volatile("s_waitcnt lgkmcnt(" #n ")" ::: "memory")
#define PG8_BAR __builtin_amdgcn_s_barrier()
#define PG8_SCHED __builtin_amdgcn_sched_barrier(0)
    Unit cur, nxt; int ui = 0;
    if (!S.next(0, cur)) return;
    f32x4 acc[2][2][4][2];
#pragma unroll
    for (int a = 0; a < 2; ++a)
#pragma unroll
        for (int b = 0; b < 2; ++b)
#pragma unroll
            for (int m = 0; m < 4; ++m)
#pragma unroll
                for (int n = 0; n < 2; ++n) acc[a][b][m][n] = (f32x4){0.f, 0.f, 0.f, 0.f};
    bf16x8 At[4][2], B0[2][2], B1[2][2];
    const char* cA = (const char*)g.A + (size_t)cur.pm * tstep; const char* cB = (const char*)g.Bt + (size_t)cur.pn * tstep;
    S.a_ready(cur);
    if constexpr (SP2) {
        PG8_STAGE(PG8_SB(0, 0), cB, voffB); PG8_STAGE(PG8_SB(0, 1), cB + hstep, voffB); PG8_STAGE(PG8_SA(0, 0), cA, voffA); PG8_STAGE(PG8_SA(0, 1), cA + hstep, voffA);
        if (wr == 1) PG8_BAR;
        PG8_WAIT_V(2); PG8_BAR;
        PG8_STAGE(PG8_SB(1, 0), cB + kstep, voffB); PG8_STAGE(PG8_SA(1, 0), cA + kstep, voffA); PG8_STAGE(PG8_SB(1, 1), cB + hstep + kstep, voffB);
        PG8_WAIT_V(6); PG8_BAR;
    } else {
        PG8_STAGE(PG8_SB(0, 0), cB, voffB); PG8_STAGE(PG8_SA(0, 0), cA, voffA); PG8_STAGE(PG8_SB(0, 1), cB + hstep, voffB); PG8_STAGE(PG8_SA(0, 1), cA + hstep, voffA);
        if (wr == 1) PG8_BAR;
        PG8_WAIT_V(4); PG8_BAR;
        PG8_STAGE(PG8_SB(1, 0), cB + kstep, voffB); PG8_STAGE(PG8_SA(1, 0), cA + kstep, voffA); PG8_STAGE(PG8_SB(1, 1), cB + hstep + kstep, voffB);
        PG8_WAIT_V(6); PG8_BAR;
    }
    for (;;) {
        const bool has_next = S.next(ui + 1, nxt);
        const char* nA = has_next ? (const char*)g.A + (size_t)nxt.pm * tstep : cA; const char* nB = has_next ? (const char*)g.Bt + (size_t)nxt.pn * tstep : cB;
        for (int t = 0; t < nt; t += 2) {
            const bool last = (t == nt - 2);
            const char* a1 = cA + (size_t)(t + 1) * kstep;
            const char* a2 = last ? nA : cA + (size_t)(t + 2) * kstep; const char* b2 = last ? nB : cB + (size_t)(t + 2) * kstep;
            const char* a3 = a2 + kstep; const char* b3 = b2 + kstep;
            if (last && has_next) S.a_ready(nxt);
            if constexpr (SP2) {
            PG8_LDB(B0, 0, 0); PG8_LDB(B1, 0, 1); PG8_SCHED; PG8_LDA(At, 0, 0); PG8_STAGE(PG8_SA(1, 1), a1 + hstep, voffA);
            PG8_WAIT_V(8); PG8_WAIT_L(0); PG8_BAR; PG8_MMA(0, 0, At, B0); PG8_MMA(0, 1, At, B1); PG8_BAR; PG8_SCHED;
            PG8_LDA(At, 0, 1); PG8_STAGE(PG8_SB(0, 0), b2, voffB); PG8_STAGE(PG8_SB(0, 1), b2 + hstep, voffB); PG8_STAGE(PG8_SA(0, 0), a2, voffA);
            PG8_WAIT_V(8); PG8_WAIT_L(0); PG8_BAR; PG8_MMA(1, 0, At, B0); PG8_MMA(1, 1, At, B1); PG8_BAR; PG8_SCHED;
            PG8_LDB(B0, 1, 0); PG8_LDB(B1, 1, 1); PG8_SCHED; PG8_LDA(At, 1, 0); PG8_STAGE(PG8_SA(0, 1), a2 + hstep, voffA);
            PG8_WAIT_V(8); PG8_WAIT_L(0); PG8_BAR; PG8_MMA(0, 0, At, B0); PG8_MMA(0, 1, At, B1); PG8_BAR; PG8_SCHED;
            PG8_LDA(At, 1, 1); PG8_STAGE(PG8_SB(1, 0), b3, voffB); PG8_STAGE(PG8_SB(1, 1), b3 + hstep, voffB); PG8_STAGE(PG8_SA(1, 0), a3, voffA);
            PG8_WAIT_V(8); PG8_WAIT_L(0); PG8_BAR; PG8_MMA(1, 0, At, B0); PG8_MMA(1, 1, At, B1); PG8_BAR; PG8_SCHED;
            } else {
            PG8_LDB(B0, 0, 0); PG8_SCHED; PG8_LDA(At, 0, 0); PG8_STAGE(PG8_SA(1, 1), a1 + hstep, voffA);
            PG8_WAIT_L(8); PG8_BAR; PG8_WAIT_L(0); PG8_MMA(0, 0, At, B0); PG8_BAR; PG8_SCHED;
            PG8_LDB(B1, 0, 1); PG8_STAGE(PG8_SB(0, 0), b2, voffB);
            PG8_BAR; PG8_WAIT_L(0); PG8_MMA(0, 1, At, B1); PG8_BAR;
            PG8_LDA(At, 0, 1); PG8_STAGE(PG8_SA(0, 0), a2, voffA);
            PG8_BAR; PG8_WAIT_L(0); PG8_MMA(1, 0, At, B0); PG8_BAR; PG8_SCHED;
            PG8_STAGE(PG8_SB(0, 1), b2 + hstep, voffB);
            PG8_WAIT_V(6); PG8_BAR; PG8_MMA(1, 1, At, B1); PG8_BAR;
            PG8_LDB(B0, 1, 0); PG8_SCHED; PG8_LDA(At, 1, 0); PG8_STAGE(PG8_SA(0, 1), a2 + hstep, voffA);
            PG8_WAIT_L(8); PG8_BAR; PG8_WAIT_L(0); PG8_MMA(0, 0, At, B0); PG8_BAR; PG8_SCHED;
            PG8_LDB(B1, 1, 1); PG8_STAGE(PG8_SB(1, 0), b3, voffB);
            PG8_BAR; PG8_WAIT_L(0); PG8_MMA(0, 1, At, B1); PG8_BAR;
            PG8_LDA(At, 1, 1); PG8_STAGE(PG8_SA(1, 0), a3, voffA);
            PG8_BAR; PG8_WAIT_L(0); PG8_MMA(1, 0, At, B0); PG8_BAR; PG8_SCHED;
            PG8_STAGE(PG8_SB(1, 1), b3 + hstep, voffB);
            PG8_WAIT_V(6); PG8_BAR; PG8_MMA(1, 1, At, B1); PG8_BAR;
            }
        }
        if constexpr (ALIGN_EPI) { if (wr == 0) PG8_BAR; }
        if constexpr (!Epi::AFTER_DRAIN) { E(acc, cur, wr, wc, fr, fq); S.done(cur); }
        if (!has_next) break;
#pragma unroll
        for (int a = 0; a < 2; ++a)
#pragma unroll
            for (int b = 0; b < 2; ++b)
#pragma unroll
                for (int m = 0; m < 4; ++m)
#pragma unroll
                    for (int n = 0; n < 2; ++n) acc[a][b][m][n] = (f32x4){0.f, 0.f, 0.f, 0.f};
        cur = nxt; cA = nA; cB = nB; ++ui;
        if constexpr (ALIGN_EPI) { if (wr == 1) PG8_BAR; }
    }
    PG8_WAIT_V(0);
    if constexpr (!ALIGN_EPI) { if (wr == 0) PG8_BAR; }
    PG8_BAR;
    if constexpr (Epi::AFTER_DRAIN) { E.fused(acc, cur, wr, wc, fr, fq, lds, wid, lane); S.done(cur); }
#undef PG8_SA
#undef PG8_SB
#undef PG8_STAGE
#undef PG8_LDA
#undef PG8_LDB
#undef PG8_MMA
#undef PG8_WAIT_V
#undef PG8_WAIT_L
#undef PG8_BAR
#undef PG8_SCHED
}
}
#define GAS __attribute__((address_space(1)))
#define LAS __attribute__((address_space(3)))
typedef unsigned short bf16;
typedef unsigned v4u __attribute__((ext_vector_type(4)));
typedef float f32x4 __attribute__((ext_vector_type(4)));
typedef short bf16x8 __attribute__((ext_vector_type(8)));
typedef GAS unsigned gu32;
typedef GAS unsigned long long gu64;
#define RLX_AGENT __ATOMIC_RELAXED, __HIP_MEMORY_SCOPE_AGENT
#define LDS_WAIT() asm volatile("s_waitcnt lgkmcnt(0)" ::: "memory")
#define VM_WAIT() asm volatile("s_waitcnt vmcnt(0)" ::: "memory")
__device__ __forceinline__ unsigned long long rt() { return __builtin_amdgcn_s_memrealtime(); }
__device__ __forceinline__ unsigned f2bf(float f) { unsigned u = __builtin_bit_cast(unsigned, f); return (u + 0x7fffu + ((u >> 16) & 1u)) >> 16; }
__device__ __forceinline__ unsigned pk2(float lo, float hi) { return f2bf(lo) | (f2bf(hi) << 16); }

#define XB_TMO      128
#define XB_XCNT(j)  (256  + 64 * (j))
#define XB_XSUB(j)  (1280 + 64 * (j))
#define XB_XGEN(j)  (2304 + 64 * (j))
#define XB_TOP      3328
#define XB_TOPGEN   3392
#define XCD_BAR_WORDS 3456
#define XB_SPIN_CAP (1u << 18)

__device__ __forceinline__ unsigned xb_ld(unsigned* p)              { return __hip_atomic_load(p, __ATOMIC_RELAXED, __HIP_MEMORY_SCOPE_AGENT); }
__device__ __forceinline__ unsigned xb_add(unsigned* p, unsigned v) { return __hip_atomic_fetch_add(p, v, __ATOMIC_RELAXED, __HIP_MEMORY_SCOPE_AGENT); }
__device__ __forceinline__ unsigned xb_xcc_id() { return (unsigned)__builtin_amdgcn_s_getreg((3 << 11) | 20) & 0xFu; }
#define XB_SPIN(cond, bar) do { unsigned _sp = 0; while (cond) { __builtin_amdgcn_s_sleep(1); \
    if ((++_sp & 255u) == 0u) { if (xb_ld(&(bar)[XB_TMO])) break; if (_sp > XB_SPIN_CAP) { atomicAdd(&(bar)[XB_TMO], 1u); break; } } } } while (0)

struct XcdBarrier {
    unsigned* bar; unsigned x;
    volatile LAS unsigned* st;
};

__device__ __forceinline__ XcdBarrier xcd_barrier_post(unsigned* bar, volatile LAS unsigned* st) {
    XcdBarrier b; b.bar = bar; b.x = xb_xcc_id(); b.st = st;
    if (threadIdx.x == 0) (void)xb_add(&bar[XB_XCNT(b.x)], 1u);
    return b;
}
__device__ __forceinline__ void xcd_barrier_complete(unsigned* bar, unsigned x, unsigned& nloc, unsigned& nx) {
    const unsigned G = gridDim.x * gridDim.y * gridDim.z;
    unsigned sum, cnt, mine, sp = 0u;
    for (;;) {
        sum = 0u; cnt = 0u; mine = 0u;
#pragma unroll
        for (unsigned j = 0; j < 16; ++j) { const unsigned c = xb_ld(&bar[XB_XCNT(j)]); sum += c; cnt += (c > 0u) ? 1u : 0u; mine = (j == x) ? c : mine; }
        if (sum == G) break;
        __builtin_amdgcn_s_sleep(1);
        if ((++sp & 255u) == 0u) { if (xb_ld(&bar[XB_TMO])) break; if (sp > XB_SPIN_CAP) { atomicAdd(&bar[XB_TMO], 1u); break; } }
    }
    nloc = mine > 0u ? mine : 1u; nx = cnt > 0u ? cnt : 1u;
}

__device__ __forceinline__ void xcd_barrier(const XcdBarrier& b) {
    asm volatile("s_waitcnt vmcnt(0)" ::: "memory");
    __syncthreads();
    if (threadIdx.x == 0) {
        unsigned* bar = b.bar;
        __builtin_amdgcn_s_waitcnt(0);
        unsigned nloc = b.st[0], nx = b.st[1];
        if (nloc == 0u) { xcd_barrier_complete(bar, b.x, nloc, nx); b.st[0] = nloc; b.st[1] = nx; }
        const unsigned old = xb_add(&bar[XB_XSUB(b.x)], 1u);
        const unsigned gen = old / nloc;
        if (old + 1u == (gen + 1u) * nloc) {
            __builtin_amdgcn_fence(__ATOMIC_RELEASE, "agent");
            asm volatile("s_waitcnt vmcnt(0)" ::: "memory");
            const unsigned og = xb_add(&bar[XB_TOP], 1u);
            const unsigned tg = og / nx;
            if (og + 1u == (tg + 1u) * nx) xb_add(&bar[XB_TOPGEN], 1u);
            else XB_SPIN(xb_ld(&bar[XB_TOPGEN]) == tg, bar);
            __builtin_amdgcn_fence(__ATOMIC_ACQUIRE, "agent");
            xb_add(&bar[XB_XGEN(b.x)], 1u);
            asm volatile("s_waitcnt vmcnt(0)" ::: "memory");
        } else {
            XB_SPIN(xb_ld(&bar[XB_XGEN(b.x)]) == gen, bar);
            __builtin_amdgcn_fence(__ATOMIC_ACQUIRE, "agent");
            asm volatile("s_waitcnt vmcnt(0)" ::: "memory");
        }
    }
    __syncthreads();
}
namespace epi {
using pg8::f32x4; using pg8::Unit; using pg8::bf16_t; using pg8::u32x4; using pg8::cvt_pk_bf16;
__device__ __forceinline__ float sigm(float x) { return __builtin_amdgcn_rcpf(1.f + __builtin_amdgcn_exp2f(-1.4426950408889634f * x)); }
__device__ __forceinline__ f32x4 sigm4(f32x4 v) { return (f32x4){sigm(v[0]), sigm(v[1]), sigm(v[2]), sigm(v[3])}; }
__device__ __forceinline__ u32x4 pack8(f32x4 a, f32x4 b) { u32x4 w; w.x = cvt_pk_bf16(a[0], a[1]); w.y = cvt_pk_bf16(a[2], a[3]); w.z = cvt_pk_bf16(b[0], b[1]); w.w = cvt_pk_bf16(b[2], b[3]); return w; }
__device__ __forceinline__ void unpack8(u32x4 w, f32x4& a, f32x4& b) {
    a[0] = __uint_as_float(w.x << 16); a[1] = __uint_as_float(w.x & 0xffff0000u); a[2] = __uint_as_float(w.y << 16); a[3] = __uint_as_float(w.y & 0xffff0000u);
    b[0] = __uint_as_float(w.z << 16); b[1] = __uint_as_float(w.z & 0xffff0000u); b[2] = __uint_as_float(w.w << 16); b[3] = __uint_as_float(w.w & 0xffff0000u); }

struct EpiInProj { static constexpr bool PERM = true, AFTER_DRAIN = false;
    bf16_t* Qb; bf16_t* KVb; float* U; bf16_t* MG; float* GT; const float* rstd; float* out;
    __device__ __forceinline__ void operator()(const f32x4 (&acc)[2][2][4][2], const Unit& u, int wr, int wc, int fr, int fq) const {
        const int pn = u.pn, row0 = u.pm * 256 + wr * 64 + fr, c0 = wc * 32 + 8 * fq;
#pragma unroll
        for (int ai = 0; ai < 2; ++ai)
#pragma unroll
            for (int m = 0; m < 4; ++m) { const int r = row0 + ai * 128 + m * 16; const bool ok = r < MROWS; const float rs = rstd[r];
#pragma unroll
                for (int bj = 0; bj < 2; ++bj) { f32x4 v0 = acc[ai][bj][m][0] * rs, v1 = acc[ai][bj][m][1] * rs; const int c = c0 + bj * 128;
                    if (!ok) continue;
                    if (pn < 4) { *(u32x4*)(Qb + (size_t)r * 1024 + pn * 256 + c) = pack8(v0, v1); }
                    else if (pn < 10) { const int slot = pn - 4; *(u32x4*)(KVb + (size_t)r * 1536 + slot * 256 + c) = pack8(v0, v1);
                        float* dst = nullptr;
                        if (slot < 4) dst = (r < MP) ? out + O_KVP + (size_t)r * 1024 + slot * 256 + c : out + O_KVS + (size_t)(r - MP) * 1024 + slot * 256 + c;
                        else if (r < MP) { const int t = r & (SEQ - 1); if (t >= SEQ - 512) dst = out + O_WINP + ((size_t)((r >> 11) * 512 + (t - (SEQ - 512))) * 2 + (slot - 4)) * 256 + c; }
                        else { const int q = r - MP; dst = out + O_WINS + ((size_t)((q >> 3) * 512 + 504 + (q & 7)) * 2 + (slot - 4)) * 256 + c; }
                        if (dst) { *(f32x4*)dst = v0; *(f32x4*)(dst + 4) = v1; } }
                    else if (pn < 14) { float* dst = U + (size_t)r * 1024 + (pn - 10) * 256 + c; *(f32x4*)dst = v0; *(f32x4*)(dst + 4) = v1; }
                    else if (pn < 30) { *(u32x4*)(MG + (size_t)r * 4096 + (pn - 14) * 256 + c) = pack8(sigm4(v0), sigm4(v1)); }
                    else if (c < 48) { float* dst = GT + (size_t)r * 64 + c; *(f32x4*)dst = sigm4(v0); *(f32x4*)(dst + 4) = sigm4(v1); } } }
    }
};
struct EpiGlu { static constexpr bool PERM = true, AFTER_DRAIN = false;
    const bf16_t* MG; bf16_t* MB;
    __device__ __forceinline__ void operator()(const f32x4 (&acc)[2][2][4][2], const Unit& u, int wr, int wc, int fr, int fq) const {
        const int row0 = u.pm * 256 + wr * 64 + fr, col = u.pn * 128 + wc * 32 + 8 * fq;
#pragma unroll
        for (int ai = 0; ai < 2; ++ai)
#pragma unroll
            for (int m = 0; m < 4; ++m) { const int r = row0 + ai * 128 + m * 16; if (r >= MROWS) continue;
                f32x4 s0, s1; unpack8(*(const u32x4*)(MG + (size_t)r * 4096 + 2048 + col), s0, s1);
                const f32x4 y0 = acc[ai][0][m][0] * sigm4(acc[ai][1][m][0]) * s0, y1 = acc[ai][0][m][1] * sigm4(acc[ai][1][m][1]) * s1;
                *(u32x4*)(MB + (size_t)r * 2048 + col) = pack8(y0, y1); }
    }
};
struct EpiAttnOut { static constexpr bool PERM = true, AFTER_DRAIN = false;
    const bf16_t* MG; bf16_t* MB;
    __device__ __forceinline__ void operator()(const f32x4 (&acc)[2][2][4][2], const Unit& u, int wr, int wc, int fr, int fq) const {
        const int row0 = u.pm * 256 + wr * 64 + fr, col0 = u.pn * 256 + wc * 32 + 8 * fq;
#pragma unroll
        for (int ai = 0; ai < 2; ++ai)
#pragma unroll
            for (int m = 0; m < 4; ++m) { const int r = row0 + ai * 128 + m * 16; if (r >= MROWS) continue;
#pragma unroll
                for (int bj = 0; bj < 2; ++bj) { const int col = col0 + bj * 128;
                    f32x4 s0, s1, b0, b1; unpack8(*(const u32x4*)(MG + (size_t)r * 4096 + col), s0, s1); unpack8(*(const u32x4*)(MB + (size_t)r * 2048 + col), b0, b1);
                    *(u32x4*)(MB + (size_t)r * 2048 + col) = pack8(b0 + s0 * acc[ai][bj][m][0], b1 + s1 * acc[ai][bj][m][1]); } }
    }
};
struct EpiWout { static constexpr bool PERM = true, AFTER_DRAIN = false;
    const float* xp; const float* xs; float* X2; bf16_t* XN; float* ss;
    __device__ __forceinline__ void operator()(const f32x4 (&acc)[2][2][4][2], const Unit& u, int wr, int wc, int fr, int fq) const {
        const int row0 = u.pm * 256 + wr * 64 + fr, col0 = u.pn * 256 + wc * 32 + 8 * fq;
#pragma unroll
        for (int ai = 0; ai < 2; ++ai)
#pragma unroll
            for (int m = 0; m < 4; ++m) { const int r = row0 + ai * 128 + m * 16; const bool ok = r < MROWS; float s = 0.f;
                const float* xr = (r < MP) ? xp + (size_t)r * 2048 : xs + (size_t)(ok ? r - MP : 0) * 2048;
#pragma unroll
                for (int bj = 0; bj < 2; ++bj) { const int col = col0 + bj * 128;
                    f32x4 v0 = acc[ai][bj][m][0], v1 = acc[ai][bj][m][1];
                    if (ok) { v0 += *(const f32x4*)(xr + col); v1 += *(const f32x4*)(xr + col + 4);
                        float* d = X2 + (size_t)r * 2048 + col; *(f32x4*)d = v0; *(f32x4*)(d + 4) = v1; *(u32x4*)(XN + (size_t)r * 2048 + col) = pack8(v0, v1); }
                    s += (v0[0] * v0[0] + v0[1] * v0[1]) + (v0[2] * v0[2] + v0[3] * v0[3]) + (v1[0] * v1[0] + v1[1] * v1[1]) + (v1[2] * v1[2] + v1[3] * v1[3]); }
                s += __shfl_xor(s, 16); s += __shfl_xor(s, 32);
                if (ok && fq == 0) atomicAdd(ss + r, s); }
    }
};
struct EpiGateUp { static constexpr bool PERM = true, AFTER_DRAIN = false;
    const float* ss; bf16_t* HH;
    __device__ __forceinline__ void operator()(const f32x4 (&acc)[2][2][4][2], const Unit& u, int wr, int wc, int fr, int fq) const {
        const int row0 = u.pm * 256 + wr * 64 + fr, col = u.pn * 128 + wc * 32 + 8 * fq;
#pragma unroll
        for (int ai = 0; ai < 2; ++ai)
#pragma unroll
            for (int m = 0; m < 4; ++m) { const int r = row0 + ai * 128 + m * 16; if (r >= MROWS) continue;
                const float rs = 1.0f / sqrtf(ss[r] * (1.0f / 2048.0f) + EPS);
                const f32x4 g0 = acc[ai][0][m][0] * rs, g1 = acc[ai][0][m][1] * rs, u0 = acc[ai][1][m][0] * rs, u1 = acc[ai][1][m][1] * rs;
                *(u32x4*)(HH + (size_t)r * DFF + col) = pack8(g0 * sigm4(g0) * u0, g1 * sigm4(g1) * u1); }
    }
};
struct EpiDown { static constexpr bool PERM = true, AFTER_DRAIN = false;
    const float* X2; float* Y; float* ss;
    __device__ __forceinline__ void operator()(const f32x4 (&acc)[2][2][4][2], const Unit& u, int wr, int wc, int fr, int fq) const {
        const int row0 = u.pm * 256 + wr * 64 + fr, col0 = u.pn * 256 + wc * 32 + 8 * fq;
#pragma unroll
        for (int ai = 0; ai < 2; ++ai)
#pragma unroll
            for (int m = 0; m < 4; ++m) { const int r = row0 + ai * 128 + m * 16; const bool ok = r < MROWS; float s = 0.f;
#pragma unroll
                for (int bj = 0; bj < 2; ++bj) { const int col = col0 + bj * 128;
                    f32x4 v0 = acc[ai][bj][m][0], v1 = acc[ai][bj][m][1];
                    if (ok) { const float* xr = X2 + (size_t)r * 2048 + col; v0 += *(const f32x4*)xr; v1 += *(const f32x4*)(xr + 4);
                        float* d = Y + (size_t)r * 2048 + col; *(f32x4*)d = v0; *(f32x4*)(d + 4) = v1; }
                    s += (v0[0] * v0[0] + v0[1] * v0[1]) + (v0[2] * v0[2] + v0[3] * v0[3]) + (v1[0] * v1[0] + v1[1] * v1[1]) + (v1[2] * v1[2] + v1[3] * v1[3]); }
                s += __shfl_xor(s, 16); s += __shfl_xor(s, 32);
                if (ok && fq == 0) atomicAdd(ss + r, s); }
    }
};
}
constexpr int RING_OFF = 0, RING_BYTES = 131072;
constexpr int LDSCTL_OFF = RING_BYTES, MISC_OFF = LDSCTL_OFF + 320;
constexpr int LDS_BYTES = 147456;
constexpr int NWAVES = 8;
typedef float f32x2v __attribute__((ext_vector_type(2)));

#define WSYNC() do { asm volatile("s_waitcnt lgkmcnt(0)" ::: "memory"); __builtin_amdgcn_wave_barrier(); asm volatile("" ::: "memory"); } while (0)
__device__ __forceinline__ int vgpr_i(int x) { asm volatile("" : "+v"(x)); return x; }
__device__ __forceinline__ float bf2f(unsigned short h) { return __uint_as_float((unsigned)h << 16); }
__device__ __forceinline__ float wave_sum(float v) {
#pragma unroll
    for (int o = 1; o < 64; o <<= 1) v += __shfl_xor(v, o);
    return v; }
__device__ __forceinline__ float wave_max(float v) {
#pragma unroll
    for (int o = 1; o < 64; o <<= 1) v = fmaxf(v, __shfl_xor(v, o));
    return v; }
__device__ __forceinline__ float fsigm(float x) { return __builtin_amdgcn_rcpf(1.f + __builtin_amdgcn_exp2f(-1.4426950408889634f * x)); }
__device__ __forceinline__ float gelu_tanh(float x) { return x * fsigm(1.5957691216057308f * (x + 0.044715f * x * x * x)); }
__device__ __forceinline__ float fexp(float x) { return __builtin_amdgcn_exp2f(1.4426950408889634f * x); }

struct TrJob { const float* W0; const float* W1; const float* g; bf16* WT; int K, Nsrc, Ndst, kind; };
__device__ __forceinline__ const float* tr_src(const TrJob& j, int n) {
    switch (j.kind) {
    default: return n < j.Nsrc ? j.W0 + n : nullptr;
    case 1: { if (n < 2560) return j.W0 + n; if (n < 3584) return j.W0 + 2608 + (n - 2560); if (n < 7680) return j.W0 + 3632 + (n - 3584); if (n < 7728) return j.W0 + 2560 + (n - 7680); return nullptr; }
    case 2: { const int pn = n >> 8, w = n & 255; return j.W0 + (w < 128 ? 128 * pn + w : 2048 + 128 * pn + (w - 128)); }
    case 3: { const int pn = n >> 8, w = n & 255; return w < 128 ? j.W0 + 128 * pn + w : j.W1 + 128 * pn + (w - 128); }
    }
}
__device__ __forceinline__ void tr_item(const TrJob& j, int item, LAS unsigned* scr, int lane) {
    const int nblk = j.Ndst / 64, kb = item / nblk, nb = item % nblk, k0 = 64 * kb, n0 = 64 * nb;
    const float* src = tr_src(j, n0 + lane); const float msk = src ? 1.f : 0.f; if (!src) src = j.W0;
    src += (size_t)k0 * j.Nsrc;
#pragma unroll 8
    for (int i = 0; i < 32; ++i) { float a = src[(size_t)(2 * i) * j.Nsrc] * msk, b = src[(size_t)(2 * i + 1) * j.Nsrc] * msk;
        if (j.g) { a *= j.g[k0 + 2 * i]; b *= j.g[k0 + 2 * i + 1]; }
        scr[i * 65 + lane] = pk2(a, b); }
    LDS_WAIT(); __builtin_amdgcn_wave_barrier(); asm volatile("" ::: "memory");
    const int c = lane & 7;
#pragma unroll
    for (int jj = 0; jj < 8; ++jj) { const int n = 8 * jj + (lane >> 3); const LAS unsigned* s = scr + (4 * c) * 65 + n;
        v4u o; o.x = s[0]; o.y = s[65]; o.z = s[130]; o.w = s[195];
        *(GAS v4u*)(j.WT + (size_t)(n0 + n) * j.K + k0 + 8 * c) = o; }
    LDS_WAIT(); __builtin_amdgcn_wave_barrier(); asm volatile("" ::: "memory");
}
__device__ __forceinline__ void xn_row(const float* xrow, bf16* orow, float* rstd_out, int lane) {
    GAS unsigned long long* o8 = (GAS unsigned long long*)orow + lane;
    if (!xrow) {
#pragma unroll
        for (int j = 0; j < 8; ++j) o8[64 * j] = 0ull;
        if (lane == 0) *rstd_out = 0.f; return; }
    const GAS f32x4* xr = (const GAS f32x4*)xrow + lane; f32x4 v[8]; float s = 0.f;
#pragma unroll
    for (int j = 0; j < 8; ++j) { v[j] = xr[64 * j]; s += (v[j].x * v[j].x + v[j].y * v[j].y) + (v[j].z * v[j].z + v[j].w * v[j].w); }
    s = wave_sum(s);
#pragma unroll
    for (int j = 0; j < 8; ++j) o8[64 * j] = (unsigned long long)pk2(v[j].x, v[j].y) | ((unsigned long long)pk2(v[j].z, v[j].w) << 32);
    if (lane == 0) *rstd_out = 1.0f / sqrtf(s * (1.0f / D_MODEL) + EPS);
}

constexpr int CMP_PHI = 0, CMP_POOL = 8192, CMP_CST = 8256, CMP_GS = 8384;
__device__ __forceinline__ void compress_setup(const float* pe, const float* pool, const float* phi, LAS float* L, int tid) {
    for (int i = tid; i < 8192; i += NWAVES * 64) L[CMP_PHI + i] = phi[i];
    if (tid < 64) L[CMP_POOL + tid] = pool[tid];
    if (tid < 128) { const int w = tid >> 6, d = tid & 63; float s = 0.f;
        for (int j = 0; j < 32; ++j) s += pool[w * 32 + j] * pe[(w * 32 + j) * 64 + d];
        L[CMP_CST + tid] = s; }
    __syncthreads();
}
template <bool SAMPLE> __device__ __forceinline__ void compress_item(const float* rows, const int* pt, int b, int i, int nc, bf16* KC, LAS float* L, int wave, int lane) {
    const int which = lane >> 5;
    f32x4 plo0 = {0.f, 0.f, 0.f, 0.f}, plo1 = plo0;
    const int m_end = (8 * i + 8 < nc) ? 8 * i + 8 : nc;
    for (int m = 8 * i; m <= m_end; ++m) {
        const float* base;
        if (SAMPLE) { const int pos = 16 * m; const int phys = pt[b * NPAGES + (pos >> 7)]; base = rows + ((size_t)phys * PAGE + (pos & (PAGE - 1))) * 1024 + 8 * lane; }
        else base = rows + ((size_t)b * SEQ + 16 * m) * 1024 + 8 * lane;
        f32x4 lo0 = {0.f, 0.f, 0.f, 0.f}, lo1 = lo0, hi0 = lo0, hi1 = lo0;
#pragma unroll
        for (int j = 0; j < 16; ++j) { const f32x4 v0 = *(const f32x4*)(base + (size_t)j * 1024), v1 = *(const f32x4*)(base + (size_t)j * 1024 + 4);
            const float pl = L[CMP_POOL + which * 32 + j], ph = L[CMP_POOL + which * 32 + 16 + j];
            lo0 += pl * v0; lo1 += pl * v1; hi0 += ph * v0; hi1 += ph * v1; }
        if (m > 8 * i) { const int c = m - 1;
            const f32x4 c0 = *(const LAS f32x4*)(L + CMP_CST + which * 64 + 8 * (lane & 7)), c1 = *(const LAS f32x4*)(L + CMP_CST + which * 64 + 8 * (lane & 7) + 4);
            f32x4 g0 = plo0 + hi0 + c0, g1 = plo1 + hi1 + c1;
#pragma unroll
            for (int e = 0; e < 4; ++e) { g0[e] = gelu_tanh(g0[e]); g1[e] = gelu_tanh(g1[e]); }
            LAS float* Gs = L + CMP_GS + wave * 512;
            *(LAS f32x4*)(Gs + 8 * lane) = g0; *(LAS f32x4*)(Gs + 8 * lane + 4) = g1;
            WSYNC();
            f32x4 a0 = {0.f, 0.f, 0.f, 0.f}, a1 = a0; const LAS float* gr = Gs + (lane >> 3) * 64; const LAS float* ph = L + CMP_PHI + which * 4096 + 8 * (lane & 7);
#pragma unroll 8
            for (int d = 0; d < 64; ++d) { const float gv = gr[d]; a0 += gv * *(const LAS f32x4*)(ph + d * 64); a1 += gv * *(const LAS f32x4*)(ph + d * 64 + 4); }
            { v4u w; w.x = pk2(a0[0], a0[1]); w.y = pk2(a0[2], a0[3]); w.z = pk2(a1[0], a1[1]); w.w = pk2(a1[2], a1[3]); *(GAS v4u*)(KC + (size_t)c * 512 + 8 * lane) = w; }
            WSYNC(); }
        plo0 = lo0; plo1 = lo1;
    }
}

struct SsmIn { const float *lam_re, *lam_im, *log_dt, *b_re, *b_im, *c_re, *c_im, *dsk; };
struct SsmC { float ar, ai, dsk; f32x2v bb[16]; float cm[32]; };
__device__ __forceinline__ void ssm_consts(const SsmIn& I, int g, int lane, SsmC& C) {
    const int p = lane; const float dt = expf(I.log_dt[g]), lr = I.lam_re[g * 64 + p], li = I.lam_im[g * 64 + p];
    const float mag = expf(lr * dt); float sn, cs; sincosf(li * dt, &sn, &cs);
    C.ar = mag * cs; C.ai = mag * sn;
    const float den = lr * lr + li * li, fr = ((C.ar - 1.f) * lr + C.ai * li) / den, fi = (C.ai * lr - (C.ar - 1.f) * li) / den;
#pragma unroll
    for (int c4 = 0; c4 < 4; ++c4) { const f32x4 br = *(const f32x4*)(I.b_re + (size_t)(g * 64 + p) * 16 + 4 * c4), bi = *(const f32x4*)(I.b_im + (size_t)(g * 64 + p) * 16 + 4 * c4);
#pragma unroll
        for (int e = 0; e < 4; ++e) C.bb[4 * c4 + e] = (f32x2v){fr * br[e] - fi * bi[e], fr * bi[e] + fi * br[e]}; }
    const int c = lane & 15, q = lane >> 4;
#pragma unroll
    for (int k4 = 0; k4 < 4; ++k4) { const f32x4 cr = *(const f32x4*)(I.c_re + (size_t)(g * 16 + c) * 64 + 16 * q + 4 * k4), ci = *(const f32x4*)(I.c_im + (size_t)(g * 16 + c) * 64 + 16 * q + 4 * k4);
#pragma unroll
        for (int e = 0; e < 4; ++e) { C.cm[8 * k4 + 2 * e] = cr[e]; C.cm[8 * k4 + 2 * e + 1] = -ci[e]; } }
    C.dsk = I.dsk[g * 16 + c];
}
__device__ __forceinline__ f32x4 ssm_y16(const LAS float* Hs, const SsmC& C, int lane) {
    const int trow = lane & 15, q = lane >> 4; f32x4 d = {0.f, 0.f, 0.f, 0.f};
#pragma unroll
    for (int k4 = 0; k4 < 8; ++k4) { const f32x4 a = *(const LAS f32x4*)(Hs + trow * 132 + 32 * q + 4 * k4);
#pragma unroll
        for (int e = 0; e < 4; ++e) d = __builtin_amdgcn_mfma_f32_16x16x4f32(a[e], C.cm[4 * k4 + e], d, 0, 0, 0); }
    return d;
}
constexpr int SSM_US = 0, SSM_HS = 16384, SSM_HEND = SSM_HS + 8 * 8448;
__device__ __forceinline__ void ssm_prompt_item(const SsmIn& I, int b, int g, const float* U, bf16* GY, float* out, LAS unsigned char* lds, int wave, int lane) {
    SsmC C; ssm_consts(I, g, lane, C);
    float a32r = C.ar, a32i = C.ai;
#pragma unroll
    for (int s = 0; s < 5; ++s) { const float nr = a32r * a32r - a32i * a32i, ni = 2.f * a32r * a32i; a32r = nr; a32i = ni; }
    LAS float* uS = (LAS float*)(lds + SSM_US) + wave * 512; LAS float* Hs = (LAS float*)(lds + SSM_HS) + wave * 2112; LAS float* hend = (LAS float*)(lds + SSM_HEND);
    float cr = 0.f, ci = 0.f;
#pragma unroll 1
    for (int sb = 0; sb < SEQ / 256; ++sb) {
        const int row0 = b * SEQ + sb * 256 + wave * 32;
#pragma unroll
        for (int h = 0; h < 2; ++h) { const int tt = (lane >> 2) + 16 * h; *(LAS f32x4*)(uS + tt * 16 + 4 * (lane & 3)) = *(const f32x4*)(U + (size_t)(row0 + tt) * 1024 + g * 16 + 4 * (lane & 3)); }
        WSYNC();
        f32x2v x[32];
#pragma unroll
        for (int i = 0; i < 32; ++i) { f32x2v sx = {0.f, 0.f}; asm volatile("" ::: "memory");
#pragma unroll
            for (int c4 = 0; c4 < 4; ++c4) { const f32x4 u4 = *(const LAS f32x4*)(uS + i * 16 + 4 * c4);
#pragma unroll
                for (int e = 0; e < 4; ++e) sx += u4[e] * C.bb[4 * c4 + e]; }
            x[i] = sx; }
        const f32x2v A1 = {C.ar, C.ar}, A2 = {-C.ai, C.ai};
        f32x2v h = {0.f, 0.f};
#pragma unroll
        for (int i = 0; i < 32; ++i) { const f32x2v hs = __builtin_shufflevector(h, h, 1, 0); h = A1 * h + (A2 * hs + x[i]); }
        const float hr = h.x, hi = h.y;
        *(LAS f32x2v*)(hend + (wave * 64 + lane) * 2) = (f32x2v){hr, hi};
        __syncthreads();
        float chr = cr, chi = ci, cinr = 0.f, cini = 0.f;
#pragma unroll
        for (int w = 0; w < 8; ++w) { if (w == wave) { cinr = chr; cini = chi; }
            const f32x2v e = *(const LAS f32x2v*)(hend + (w * 64 + lane) * 2);
            const float nr = a32r * chr - a32i * chi + e.x, ni = a32r * chi + a32i * chr + e.y; chr = nr; chi = ni; }
        cr = chr; ci = chi; h = (f32x2v){cinr, cini};
#pragma unroll
        for (int half = 0; half < 2; ++half) {
#pragma unroll
            for (int i = 0; i < 16; ++i) { const int ii = half * 16 + i; const f32x2v hs = __builtin_shufflevector(h, h, 1, 0); h = A1 * h + (A2 * hs + x[ii]);
                *(LAS f32x2v*)(Hs + i * 132 + 2 * lane) = h; }
            WSYNC();
            const f32x4 d = ssm_y16(Hs, C, lane); const int c = lane & 15, q = lane >> 4;
#pragma unroll
            for (int r = 0; r < 4; ++r) { const int tt = half * 16 + 4 * q + r; const float y = d[r] + C.dsk * uS[tt * 16 + c];
                GY[(size_t)(row0 + tt) * 1024 + g * 16 + c] = (bf16)f2bf(gelu_tanh(y)); }
            WSYNC();
        }
        __syncthreads();
    }
    if (wave == 0) { out[O_HRP + (size_t)(b * 64 + g) * 64 + lane] = cr; out[O_HIP + (size_t)(b * 64 + g) * 64 + lane] = ci; }
}
__device__ __forceinline__ void ssm_sample_item(const SsmIn& I, int b, int g, const float* U, const float* h0r, const float* h0i, bf16* GY, float* out, LAS unsigned char* lds, int wave, int lane) {
    SsmC C; ssm_consts(I, g, lane, C);
    LAS float* uS = (LAS float*)(lds + SSM_US) + wave * 512; LAS float* Hs = (LAS float*)(lds + SSM_HS) + wave * 2112;
    const int row0 = MP + b * DEC_T;
    if (lane < 32) { const int tt = lane >> 2; *(LAS f32x4*)(uS + tt * 16 + 4 * (lane & 3)) = *(const f32x4*)(U + (size_t)(row0 + tt) * 1024 + g * 16 + 4 * (lane & 3)); }
    WSYNC();
    float hr = h0r[(size_t)(b * 64 + g) * 64 + lane], hi = h0i[(size_t)(b * 64 + g) * 64 + lane];
#pragma unroll
    for (int i = 0; i < 16; ++i) {
        if (i < DEC_T) { f32x2v sx = {0.f, 0.f};
#pragma unroll
            for (int c4 = 0; c4 < 4; ++c4) { const f32x4 u4 = *(const LAS f32x4*)(uS + i * 16 + 4 * c4);
#pragma unroll
                for (int e = 0; e < 4; ++e) sx += u4[e] * C.bb[4 * c4 + e]; }
            const float nr = C.ar * hr - C.ai * hi + sx.x, ni = C.ar * hi + C.ai * hr + sx.y; hr = nr; hi = ni; }
        *(LAS f32x2v*)(Hs + i * 132 + 2 * lane) = (i < DEC_T) ? (f32x2v){hr, hi} : (f32x2v){0.f, 0.f}; }
    WSYNC();
    out[O_HRS + (size_t)(b * 64 + g) * 64 + lane] = hr; out[O_HIS + (size_t)(b * 64 + g) * 64 + lane] = hi;
    const f32x4 d = ssm_y16(Hs, C, lane); const int c = lane & 15, q = lane >> 4;
#pragma unroll
    for (int r = 0; r < 4; ++r) { const int tt = 4 * q + r; if (tt < DEC_T) { const float y = d[r] + C.dsk * uS[tt * 16 + c];
        GY[(size_t)(row0 + tt) * 1024 + g * 16 + c] = (bf16)f2bf(gelu_tanh(y)); } }
    WSYNC();
}

constexpr int AS_QS = 0, AS_PS = 256, AS_PSUM = 512, AS_IMP = 1536, AS_SEL = 1800, AS_WORDS = 2048;
__device__ __forceinline__ void ld8(bool bf, const void* base, size_t off, float (&k)[8]) {
    if (bf) { const v4u w = *(const v4u*)((const bf16*)base + off);
        k[0] = __uint_as_float(w.x << 16); k[1] = __uint_as_float(w.x & 0xffff0000u); k[2] = __uint_as_float(w.y << 16); k[3] = __uint_as_float(w.y & 0xffff0000u);
        k[4] = __uint_as_float(w.z << 16); k[5] = __uint_as_float(w.z & 0xffff0000u); k[6] = __uint_as_float(w.w << 16); k[7] = __uint_as_float(w.w & 0xffff0000u); }
    else { const f32x4 a = *(const f32x4*)((const float*)base + off), b = *(const f32x4*)((const float*)base + off + 4);
        k[0] = a[0]; k[1] = a[1]; k[2] = a[2]; k[3] = a[3]; k[4] = b[0]; k[5] = b[1]; k[6] = b[2]; k[7] = b[3]; }
}
__device__ __forceinline__ float ld1(bool bf, const void* base, size_t off) { return bf ? bf2f(((const bf16*)base)[off]) : ((const float*)base)[off]; }
template <int MODE> __device__ __forceinline__ void att_chunk(bool bf, const void* kb, int stride, int c_lo, int c_hi, int kp0, int kstep, int pc,
        const float (&sl)[4], LAS float* W, float (&m)[4], float (&l)[4], float (&acc)[4], LAS float* psum, int lane) {
    const bool valid = lane >= c_lo && lane < c_hi;
    float s[4] = {0.f, 0.f, 0.f, 0.f};
    if (valid) {
#pragma unroll 1
        for (int hh = 0; hh < 2; ++hh) {
            float kk[4][8];
#pragma unroll
            for (int i = 0; i < 4; ++i) ld8(bf, kb, (size_t)lane * stride + 32 * hh + 8 * i, kk[i]);
#pragma unroll
            for (int i = 0; i < 4; ++i) { const float (&k)[8] = kk[i];
#pragma unroll
                for (int n = 0; n < 4; ++n) { asm volatile("" ::: "memory");
                    const f32x4 qa = *(const LAS f32x4*)(W + AS_QS + n * 64 + 32 * hh + 8 * i), qb = *(const LAS f32x4*)(W + AS_QS + n * 64 + 32 * hh + 8 * i + 4);
                    s[n] += (k[0] * qa[0] + k[1] * qa[1]) + (k[2] * qa[2] + k[3] * qa[3]) + (k[4] * qb[0] + k[5] * qb[1]) + (k[6] * qb[2] + k[7] * qb[3]); } }
            asm volatile("" ::: "memory"); } }
    const float dist = (float)(pc - (kp0 + kstep * lane));
#pragma unroll
    for (int n = 0; n < 4; ++n) s[n] = valid ? s[n] * 0.125f - sl[n] * dist : -INFINITY;
    if (MODE == 1) {
#pragma unroll
        for (int n = 0; n < 4; ++n) { const float mn = fmaxf(m[n], wave_max(s[n])); const float sc = (m[n] == -INFINITY) ? 0.f : fexp(m[n] - mn);
            l[n] = l[n] * sc + wave_sum(valid ? fexp(s[n] - mn) : 0.f); m[n] = mn; }
        return; }
    f32x4 p;
    if (MODE == 0) {
#pragma unroll
        for (int n = 0; n < 4; ++n) { const float mn = fmaxf(m[n], wave_max(s[n])); const float sc = (m[n] == -INFINITY) ? 0.f : fexp(m[n] - mn);
            p[n] = valid ? fexp(s[n] - mn) : 0.f; l[n] = l[n] * sc + wave_sum(p[n]); acc[n] *= sc; m[n] = mn; }
    } else {
#pragma unroll
        for (int n = 0; n < 4; ++n) p[n] = valid ? fexp(s[n] - m[n]) * l[n] : 0.f;
        psum[lane] = (p[0] + p[1]) + (p[2] + p[3]);
    }
    *(LAS f32x4*)(W + AS_PS + 4 * lane) = p;
    WSYNC();
#pragma unroll 2
    for (int c = c_lo; c < c_hi; ++c) { const float v = ld1(bf, kb, (size_t)c * stride + 256 + lane); const f32x4 pp = *(const LAS f32x4*)(W + AS_PS + 4 * c);
#pragma unroll
        for (int n = 0; n < 4; ++n) acc[n] += pp[n] * v; }
    WSYNC();
}
struct AttnP { const bf16* Qb; const bf16* KVb; const bf16* KCP; const bf16* KCS; const float* GT; const float* cache; const float* swin; const int* pt; bf16* OB; };
__device__ __forceinline__ void attn_item_simple(const AttnP& P, int r, int g, LAS float* W, int lane) {
    const bool sample = r >= MP; const int q_ = r - MP;
    const int b = sample ? (q_ >> 3) : (r >> 11), t = sample ? (q_ & 7) : (r & (SEQ - 1)), pc = sample ? PAST + t : t;
    const int rowbase = sample ? MP + b * DEC_T : b * SEQ;
    float sl[4];
#pragma unroll
    for (int n = 0; n < 4; ++n) { W[AS_QS + n * 64 + lane] = bf2f(P.Qb[(size_t)r * 1024 + (4 * g + n) * 64 + lane]); sl[n] = exp2f(-0.5f * (float)(4 * g + n + 1)); }
    WSYNC();
    float ot[4] = {0.f, 0.f, 0.f, 0.f};
    const int gi = vgpr_i(r * 64 + 4 * g);
    const int ncmax = sample ? NC_S : NC_P; int ncv = pc >= 31 ? (pc - 31) / 16 + 1 : 0; if (ncv > ncmax) ncv = ncmax;
    const bf16* kc = sample ? P.KCS + (size_t)b * NCP_S * 512 : P.KCP + (size_t)b * NCP_P * 512;
    if (ncv > 0) { float m[4] = {-INFINITY, -INFINITY, -INFINITY, -INFINITY}, l[4] = {0.f, 0.f, 0.f, 0.f}, oc[4] = {0.f, 0.f, 0.f, 0.f};
#pragma unroll 1
        for (int c0 = 0; c0 < ncv; c0 += 64) att_chunk<1>(true, kc + (size_t)c0 * 512 + g * 64, 512, 0, (ncv - c0 < 64) ? ncv - c0 : 64, 16 * c0 + 31, 16, pc, sl, W, m, l, oc, nullptr, lane);
#pragma unroll
        for (int n = 0; n < 4; ++n) l[n] = 1.0f / l[n];
#pragma unroll 1
        for (int c0 = 0; c0 < ncv; c0 += 64) att_chunk<2>(true, kc + (size_t)c0 * 512 + g * 64, 512, 0, (ncv - c0 < 64) ? ncv - c0 : 64, 16 * c0 + 31, 16, pc, sl, W, m, l, oc, W + AS_PSUM + c0, lane);
#pragma unroll
        for (int n = 0; n < 4; ++n) ot[n] = P.GT[gi + n] * oc[n]; }
    const int ns = sample ? 257 : 32, cur = pc >> 6;
    for (int s = lane; s < ns; s += 64) { float v;
        if (s > cur) v = -1.f; else if (s == 0 || s == cur || s == cur - 1) v = 1e4f;
        else { v = 0.f; for (int c = 4 * s - 1; c <= 4 * s + 3; ++c) v += W[AS_PSUM + c]; }
        W[AS_IMP + s] = v; }
    WSYNC();
    int nsel = 0;
#pragma unroll 1
    for (int it = 0; it < 16; ++it) { float bv = -3.f; int bi = 1 << 30;
        for (int s = lane; s < ns; s += 64) { const float v = W[AS_IMP + s]; if (v > bv) { bv = v; bi = s; } }
#pragma unroll
        for (int o = 1; o < 64; o <<= 1) { const float ov = __shfl_xor(bv, o); const int oi = __shfl_xor(bi, o); if (ov > bv || (ov == bv && oi < bi)) { bv = ov; bi = oi; } }
        if (bv < 0.f) break;
        if (lane == 0) { ((LAS int*)W)[AS_SEL + nsel] = bi; W[AS_IMP + bi] = -2.f; }
        WSYNC(); ++nsel; }
    const int lo = pc - 511 > 0 ? pc - 511 : 0;
#pragma unroll 1
    for (int br = 0; br < 2; ++br) {
        float m[4] = {-INFINITY, -INFINITY, -INFINITY, -INFINITY}, l[4] = {0.f, 0.f, 0.f, 0.f}, o[4] = {0.f, 0.f, 0.f, 0.f};
        int nch;
        if (br == 0) nch = nsel; else if (!sample) nch = (pc >> 6) - (lo >> 6) + 1; else nch = (512 - ((t + 1) & ~63)) / 64 + 1;
#pragma unroll 1
        for (int i = 0; i < nch; ++i) {
            bool bf = true; const void* kb; int stride = 1536, c_lo = 0, c_hi = 64, kp0;
            const bf16* newrows = P.KVb + (size_t)rowbase * 1536 + (2 + 2 * br) * 256 + g * 64;
            if (br == 0) { const int blk = __builtin_amdgcn_readfirstlane(((LAS int*)W)[AS_SEL + i]); kp0 = blk * 64;
                if (!sample) { kb = newrows + (size_t)kp0 * 1536; c_hi = (pc - kp0 + 1 < 64) ? pc - kp0 + 1 : 64; }
                else if (blk == 256) { kb = newrows; c_hi = t + 1; }
                else { const int phys = P.pt[b * NPAGES + (kp0 >> 7)]; kb = P.cache + ((size_t)phys * PAGE + (kp0 & (PAGE - 1))) * 1024 + 2 * 256 + g * 64; bf = false; stride = 1024; } }
            else if (!sample) { kp0 = (lo & ~63) + 64 * i; kb = newrows + (size_t)kp0 * 1536; c_lo = lo - kp0 > 0 ? lo - kp0 : 0; c_hi = (pc - kp0 + 1 < 64) ? pc - kp0 + 1 : 64; }
            else if (i < nch - 1) { const int i0 = ((t + 1) & ~63) + 64 * i; kb = P.swin + ((size_t)(b * 512 + i0) * 2) * 256 + g * 64; bf = false; stride = 512; c_lo = t + 1 - i0 > 0 ? t + 1 - i0 : 0; kp0 = PAST - 512 + i0; }
            else { kb = newrows; c_hi = t + 1; kp0 = PAST; }
            att_chunk<0>(bf, kb, stride, c_lo, c_hi, kp0, 1, pc, sl, W, m, l, o, nullptr, lane);
        }
#pragma unroll
        for (int n = 0; n < 4; ++n) ot[n] += P.GT[gi + 16 * (br + 1) + n] * o[n] / l[n];
    }
#pragma unroll
    for (int n = 0; n < 4; ++n) P.OB[(size_t)r * 1024 + (4 * g + n) * 64 + lane] = (bf16)f2bf(ot[n]);
    WSYNC();
}
namespace nsa {
typedef float f32x16 __attribute__((ext_vector_type(16)));
typedef short s16x4 __attribute__((ext_vector_type(4)));
typedef short v4i16_t __attribute__((ext_vector_type(4)));
constexpr float LOG2E = 1.4426950408889634f, MFLOOR = -1e20f;
constexpr int A_KS = 0, A_VS = 16384, A_IMPA = 32768, A_IMPB = 65536, A_IMPV = 98304, A_MASK = 106752, A_UNI = 107008, A_TL = 107072, A_WSF = 108096, A_END = 110144, A_OST = A_IMPA;
__device__ __forceinline__ int crow(int r, int hi) { return (r & 3) + 8 * (r >> 2) + 4 * hi; }
#define OPAQUE_PTR(p) asm volatile("" : "+v"(p))
__device__ __forceinline__ unsigned cvtpk(float lo, float hi) { return pg8::cvt_pk_bf16(lo, hi); }
__device__ __forceinline__ float pl32_max(float m) { auto rr = __builtin_amdgcn_permlane32_swap(__float_as_uint(m), __float_as_uint(m), false, false); return fmaxf(__uint_as_float(rr[0]), __uint_as_float(rr[1])); }
__device__ __forceinline__ float pl32_sum(float m) { auto rr = __builtin_amdgcn_permlane32_swap(__float_as_uint(m), __float_as_uint(m), false, false); return __uint_as_float(rr[0]) + __uint_as_float(rr[1]); }
__device__ __forceinline__ s16x4 vtr(const LAS unsigned char* p) { return __builtin_bit_cast(s16x4, __builtin_amdgcn_ds_read_tr16_b64_v4i16((LAS v4i16_t*)p)); }
__device__ __forceinline__ void qkt(f32x16& p0, f32x16& p1, const LAS unsigned char* Ks, const bf16x8 (&qr)[4], int r32, int hi) {
    const LAS unsigned char* kb = Ks + hi * 1024 + r32 * 16;
#pragma unroll
    for (int d0 = 0; d0 < 4; ++d0) { const bf16x8 b0 = *(const LAS bf16x8*)(kb + d0 * 2048), b1 = *(const LAS bf16x8*)(kb + d0 * 2048 + 512);
        p0 = __builtin_amdgcn_mfma_f32_32x32x16_bf16(b0, qr[d0], p0, 0, 0, 0); p1 = __builtin_amdgcn_mfma_f32_32x32x16_bf16(b1, qr[d0], p1, 0, 0, 0); }
}
__device__ __forceinline__ void pv(f32x16& o0, f32x16& o1, const LAS unsigned char* vp, const bf16x8 (&pa)[4]) {
#pragma unroll
    for (int d0 = 0; d0 < 2; ++d0) {
#pragma unroll
        for (int ks = 0; ks < 4; ++ks) { const s16x4 lo = vtr(vp + d0 * 4096 + ks * 1024), hh = vtr(vp + d0 * 4096 + ks * 1024 + 512);
            const bf16x8 B = {lo[0], lo[1], lo[2], lo[3], hh[0], hh[1], hh[2], hh[3]};
            if (d0 == 0) o0 = __builtin_amdgcn_mfma_f32_32x32x16_bf16(pa[ks], B, o0, 0, 0, 0); else o1 = __builtin_amdgcn_mfma_f32_32x32x16_bf16(pa[ks], B, o1, 0, 0, 0); } }
}
__device__ __forceinline__ float rowmax32(const f32x16& p0, const f32x16& p1) {
    float a = fmaxf(p0[0], p1[0]);
#pragma unroll
    for (int r = 1; r < 16; ++r) a = fmaxf(a, fmaxf(p0[r], p1[r]));
    return pl32_max(a);
}
struct Tile { int info, row0, col, kp0; };
struct UnitP { const bf16* QB; const bf16* KVB; const bf16* KC; const float* GT; bf16* OB; };
__device__ __forceinline__ void attn_prompt_unit(const UnitP& P, int b, int g, int i, LAS unsigned char* lds, int tid, int wave, int lane) {
    const int n = wave >> 1, qh = wave & 1, r32 = lane & 31, hi = lane >> 5, qloc = 32 * qh + r32, pos0 = 64 * i, qpos = pos0 + qloc, rowbase = b * SEQ;
    LAS float* wsf = (LAS float*)(lds + A_WSF) + wave * 64; LAS int* TL = (LAS int*)(lds + A_TL);
    LAS float* IA = (LAS float*)(lds + A_IMPA); LAS float* IB = (LAS float*)(lds + A_IMPB); LAS float* IV = (LAS float*)(lds + A_IMPV); LAS unsigned* MK = (LAS unsigned*)(lds + A_MASK); LAS unsigned* UNI = (LAS unsigned*)(lds + A_UNI);
    bf16x8 qr[4];
#pragma unroll
    for (int d0 = 0; d0 < 4; ++d0) { const v4u w = *(const v4u*)(P.QB + (size_t)(rowbase + qpos) * 1024 + (4 * g + n) * 64 + 16 * d0 + 8 * hi);
        v4u o; o.x = cvtpk(__uint_as_float(w.x << 16) * 0.125f, __uint_as_float(w.x & 0xffff0000u) * 0.125f); o.y = cvtpk(__uint_as_float(w.y << 16) * 0.125f, __uint_as_float(w.y & 0xffff0000u) * 0.125f);
        o.z = cvtpk(__uint_as_float(w.z << 16) * 0.125f, __uint_as_float(w.z & 0xffff0000u) * 0.125f); o.w = cvtpk(__uint_as_float(w.w << 16) * 0.125f, __uint_as_float(w.w & 0xffff0000u) * 0.125f);
        qr[d0] = __builtin_bit_cast(bf16x8, o); }
    const float slope = exp2f(-0.5f * (float)(4 * g + n + 1));
    const int gi = vgpr_i((rowbase + qpos) * 64 + 4 * g + n); const float gate0 = P.GT[gi], gate1 = P.GT[gi + 16], gate2 = P.GT[gi + 32];
    f32x16 ot0, ot1;
#pragma unroll
    for (int r = 0; r < 16; ++r) { ot0[r] = 0.f; ot1[r] = 0.f; }
    const LAS unsigned char* vp_l = lds + A_VS + ((lane >> 4) & 1) * 32 + (lane & 3) * 8 + (4 * hi + ((lane & 15) >> 2)) * 64;
    const int ncT = (i < 16) ? 1 : 2;
    if (tid < 2 * ncT) { const int pass = tid / ncT, j = tid % ncT; TL[4 * tid] = pass | (1 << 4) | (1 << 8); TL[4 * tid + 1] = b * NCP_P + 64 * j; TL[4 * tid + 2] = g * 64; TL[4 * tid + 3] = 64 * j; }
    __syncthreads();
    float m_run = MFLOOR, l_run = 0.f, invl = 0.f; f32x16 o0, o1; unsigned mymask = 0u;
#pragma unroll
    for (int r = 0; r < 16; ++r) { o0[r] = 0.f; o1[r] = 0.f; }
    int curbr = 0;
#pragma unroll 1
    for (int seq = 0; seq < 2; ++seq) {
        int NT;
        if (seq == 0) NT = 2 * ncT;
        else {
            { const int q = tid >> 3, part = tid & 7;
#pragma unroll
                for (int e = 0; e < 4; ++e) { const int s = 4 * part + e; float v;
                    if (s > i) v = -1.f; else if (s == 0 || s == i || s == i - 1) v = 1e4f;
                    else { v = 0.f;
#pragma unroll
                        for (int nn = 0; nn < 4; ++nn) v += IA[(nn * 32 + s) * 64 + q] + IB[(nn * 32 + s) * 64 + q]; }
                    IV[q * 33 + s] = v; }
                __syncthreads();
                float vv[32];
#pragma unroll
                for (int s = 0; s < 32; ++s) vv[s] = IV[q * 33 + s];
                unsigned bits = 0u;
#pragma unroll
                for (int e = 0; e < 4; ++e) { const int s = 4 * part + e; const float v = IV[q * 33 + s]; int rank = 0;
#pragma unroll
                    for (int s2 = 0; s2 < 32; ++s2) rank += (vv[s2] > v || (vv[s2] == v && s2 < s)) ? 1 : 0;
                    if (v >= 0.f && rank < 16) bits |= 1u << s; }
                bits |= __shfl_xor(bits, 1); bits |= __shfl_xor(bits, 2); bits |= __shfl_xor(bits, 4);
                if (part == 0) MK[q] = bits;
                bits |= __shfl_xor(bits, 8); bits |= __shfl_xor(bits, 16); bits |= __shfl_xor(bits, 32);
                if (lane == 0) UNI[wave] = bits;
                __syncthreads();
                unsigned uni = 0u;
#pragma unroll
                for (int w = 0; w < 8; ++w) uni |= UNI[w];
                const int nsel = __builtin_popcount(uni), nwin = (i < 8) ? i + 1 : 9;
                NT = nsel + nwin;
                if (tid < NT) { int info, blk;
                    if (tid < nsel) { unsigned u = uni; for (int k = 0; k < tid; ++k) u &= u - 1; blk = __builtin_ctz(u); info = 2 | ((blk == i ? 1 : 0) << 4); TL[4 * tid + 2] = 2 * 256 + g * 64; }
                    else { const int j = tid - nsel; blk = i - j; info = 3 | ((j == 0 ? 1 : (j == 8 ? 2 : 0)) << 4); TL[4 * tid + 2] = 4 * 256 + g * 64; }
                    TL[4 * tid] = info; TL[4 * tid + 1] = rowbase + 64 * blk; TL[4 * tid + 3] = 64 * blk; }
                __syncthreads();
                mymask = MK[qloc]; }
        }
        v4u kreg, vreg;
        { const int info = TL[0], row0 = TL[1], col = TL[2]; const bf16* src = (info & 256) ? P.KC : P.KVB; const int stride = (info & 256) ? 512 : 1536;
            kreg = *(const v4u*)(src + (size_t)(row0 + lane) * stride + col + 8 * wave);
            vreg = *(const v4u*)(src + (size_t)(row0 + 16 * (wave & 3) + (lane >> 2)) * stride + col + 256 + (wave >> 2) * 32 + (lane & 3) * 8);
            *(LAS v4u*)(lds + A_KS + wave * 1024 + lane * 16) = kreg; *(LAS v4u*)(lds + A_VS + wave * 1024 + lane * 16) = vreg; }
        __syncthreads();
#pragma unroll 1
        for (int t = 0; t < NT; ++t) {
            const int slot = (t & 1) * 8192;
            if (t + 1 < NT) { const int info = TL[4 * (t + 1)], row0 = TL[4 * (t + 1) + 1], col = TL[4 * (t + 1) + 2]; const bf16* src = (info & 256) ? P.KC : P.KVB; const int stride = (info & 256) ? 512 : 1536;
                kreg = *(const v4u*)(src + (size_t)(row0 + lane) * stride + col + 8 * wave);
                vreg = *(const v4u*)(src + (size_t)(row0 + 16 * (wave & 3) + (lane >> 2)) * stride + col + 256 + (wave >> 2) * 32 + (lane & 3) * 8); }
            const int info = __builtin_amdgcn_readfirstlane(TL[4 * t]), kp0 = __builtin_amdgcn_readfirstlane(TL[4 * t + 3]);
            const int br = info & 15, mkind = (info >> 4) & 15;
            if (br != curbr) {
                if (curbr == 0) { const float lt = pl32_sum(l_run); invl = (qpos >= 31 && lt > 0.f) ? 1.0f / lt : 0.f; }
                else { float f;
                    if (curbr == 1) f = gate0; else { const float lt = pl32_sum(l_run); f = (curbr == 2 ? gate1 : gate2) / lt; }
                    if (hi == 0) wsf[r32] = f;
                    WSYNC();
                    { const LAS float* wsb = wsf + 4 * hi; OPAQUE_PTR(wsb);
#pragma unroll
                    for (int r = 0; r < 16; ++r) { const float fr = wsb[(r & 3) + 8 * (r >> 2)]; ot0[r] += o0[r] * fr; ot1[r] += o1[r] * fr; o0[r] = 0.f; o1[r] = 0.f; } }
                    WSYNC();
                    m_run = MFLOOR; l_run = 0.f; }
                curbr = br; }
            const float sk = (br < 2) ? 16.f * slope : slope;
            float tb = slope * (float)((br < 2 ? 16 * kp0 + 31 : kp0) - pos0);
            if (br == 2 && !((mymask >> (kp0 >> 6)) & 1u)) tb = -INFINITY;
            const float tbh = tb + sk * (float)(4 * hi);
            f32x16 p0, p1;
#pragma unroll
            for (int r = 0; r < 16; ++r) { p0[r] = tbh + sk * (float)((r & 3) + 8 * (r >> 2)); p1[r] = p0[r] + 32.f * sk; }
            qkt(p0, p1, lds + A_KS + slot, qr, r32, hi);
            if (mkind) { int klo = -1, khi = 64;
                if (br < 2) khi = (qpos >= 31 ? (qpos - 31) >> 4 : -1) - kp0; else if (mkind == 1) khi = qpos - kp0; else klo = qpos - 512 - kp0;
                klo -= 4 * hi; khi -= 4 * hi;
#pragma unroll
                for (int r = 0; r < 16; ++r) { const int k = (r & 3) + 8 * (r >> 2);
                    if (k <= klo || k > khi) p0[r] = -INFINITY;
                    if (k + 32 <= klo || k + 32 > khi) p1[r] = -INFINITY; } }
            if (br != 1) {
                const float rm = rowmax32(p0, p1);
                if (__any(rm > m_run)) { const float mn = fmaxf(m_run, rm); const float alpha = __builtin_amdgcn_exp2f((m_run - mn) * LOG2E); l_run *= alpha; m_run = mn;
                    if (br != 0) { if (hi == 0) wsf[r32] = alpha;
                        WSYNC();
                        { const LAS float* wsb = wsf + 4 * hi; OPAQUE_PTR(wsb);
#pragma unroll
                        for (int r = 0; r < 16; ++r) { const float fr = wsb[(r & 3) + 8 * (r >> 2)]; o0[r] *= fr; o1[r] *= fr; } }
                        WSYNC(); } } }
            const float mL = m_run * LOG2E; float sacc = 0.f;
#pragma unroll
            for (int r = 0; r < 16; ++r) { p0[r] = __builtin_amdgcn_exp2f(p0[r] * LOG2E - mL); p1[r] = __builtin_amdgcn_exp2f(p1[r] * LOG2E - mL); sacc += p0[r] + p1[r]; }
            if (br == 0) l_run += sacc;
            else {
                if (br == 1) {
#pragma unroll
                    for (int r = 0; r < 16; ++r) { p0[r] *= invl; p1[r] *= invl; }
                    const int sb = (kp0 >> 2) + hi;
                    LAS float* ia = IA + (n * 32 + sb) * 64 + qloc; LAS float* ib = IB + (n * 32 + sb + 1) * 64 + qloc; OPAQUE_PTR(ia); OPAQUE_PTR(ib);
#pragma unroll
                    for (int k4 = 0; k4 < 4; ++k4) { const int s0 = sb + 2 * k4, s1 = s0 + 8;
                        const float a0 = (p0[4 * k4] + p0[4 * k4 + 1]) + (p0[4 * k4 + 2] + p0[4 * k4 + 3]), a1 = (p1[4 * k4] + p1[4 * k4 + 1]) + (p1[4 * k4 + 2] + p1[4 * k4 + 3]);
                        ia[2 * k4 * 64] = a0; ia[(2 * k4 + 8) * 64] = a1;
                        if (s0 + 1 < 32) ib[2 * k4 * 64] = p0[4 * k4 + 3];
                        if (s1 + 1 < 32) ib[(2 * k4 + 8) * 64] = p1[4 * k4 + 3]; } }
                else l_run += sacc;
                bf16x8 pa[4];
                { v4u w;
                    w.x = cvtpk(p0[0], p0[1]); w.y = cvtpk(p0[2], p0[3]); w.z = cvtpk(p0[4], p0[5]); w.w = cvtpk(p0[6], p0[7]); pa[0] = __builtin_bit_cast(bf16x8, w);
                    w.x = cvtpk(p0[8], p0[9]); w.y = cvtpk(p0[10], p0[11]); w.z = cvtpk(p0[12], p0[13]); w.w = cvtpk(p0[14], p0[15]); pa[1] = __builtin_bit_cast(bf16x8, w);
                    w.x = cvtpk(p1[0], p1[1]); w.y = cvtpk(p1[2], p1[3]); w.z = cvtpk(p1[4], p1[5]); w.w = cvtpk(p1[6], p1[7]); pa[2] = __builtin_bit_cast(bf16x8, w);
                    w.x = cvtpk(p1[8], p1[9]); w.y = cvtpk(p1[10], p1[11]); w.z = cvtpk(p1[12], p1[13]); w.w = cvtpk(p1[14], p1[15]); pa[3] = __builtin_bit_cast(bf16x8, w); }
                pv(o0, o1, vp_l + slot, pa); }
            if (t + 1 < NT) { const int ns = ((t + 1) & 1) * 8192; *(LAS v4u*)(lds + A_KS + ns + wave * 1024 + lane * 16) = kreg; *(LAS v4u*)(lds + A_VS + ns + wave * 1024 + lane * 16) = vreg; }
            __syncthreads();
        }
        if (seq == 0) {
            if (hi == 0) wsf[r32] = gate0;
            WSYNC();
            { const LAS float* wsb = wsf + 4 * hi; OPAQUE_PTR(wsb);
#pragma unroll
            for (int r = 0; r < 16; ++r) { const float fr = wsb[(r & 3) + 8 * (r >> 2)]; ot0[r] += o0[r] * fr; ot1[r] += o1[r] * fr; o0[r] = 0.f; o1[r] = 0.f; } }
            WSYNC();
            m_run = MFLOOR; l_run = 0.f; curbr = 2; }
    }
    { const float lt = pl32_sum(l_run); const float f = gate2 / lt;
        if (hi == 0) wsf[r32] = f;
        WSYNC();
        { const LAS float* wsb = wsf + 4 * hi; OPAQUE_PTR(wsb);
#pragma unroll
        for (int r = 0; r < 16; ++r) { const float fr = wsb[(r & 3) + 8 * (r >> 2)]; ot0[r] += o0[r] * fr; ot1[r] += o1[r] * fr; } }
        WSYNC(); }
    { LAS bf16* stg = (LAS bf16*)(lds + A_OST) + wave * 2048;
        { LAS bf16* sb2 = stg + 256 * hi + r32; OPAQUE_PTR(sb2);
#pragma unroll
        for (int r = 0; r < 16; ++r) { sb2[((r & 3) + 8 * (r >> 2)) * 64] = (bf16)f2bf(ot0[r]); sb2[((r & 3) + 8 * (r >> 2)) * 64 + 32] = (bf16)f2bf(ot1[r]); } }
        WSYNC();
        bf16* Ow = P.OB + (size_t)(rowbase + pos0 + 32 * qh) * 1024 + (4 * g + n) * 64;
#pragma unroll
        for (int k = 0; k < 4; ++k) { const int row = k * 8 + (lane >> 3), ch = lane & 7; const v4u v = *(const LAS v4u*)(stg + row * 64 + ch * 8); *(v4u*)(Ow + (size_t)row * 1024 + ch * 8) = v; } }
    __syncthreads();
}

constexpr int S_OACC = 0, S_ML = 8192, S_IA = 10240, S_IB = S_IA + 4 * 260 * 8 * 4, S_IMP = S_IB + 4 * 260 * 8 * 4, S_FLAG = S_IMP + 8 * 264 * 4, S_LIST = S_FLAG + 264 * 4, S_WSF = S_LIST + 264 * 4, S_END = S_WSF + 2048;
static_assert(S_END <= 131072, "sample attention LDS map");
__device__ __forceinline__ bf16x8 ldfrag8(bool bf, const void* base, size_t off) {
    if (bf) return __builtin_bit_cast(bf16x8, *(const v4u*)((const bf16*)base + off));
    const f32x4 a = *(const f32x4*)((const float*)base + off), c = *(const f32x4*)((const float*)base + off + 4);
    v4u w; w.x = cvtpk(a[0], a[1]); w.y = cvtpk(a[2], a[3]); w.z = cvtpk(c[0], c[1]); w.w = cvtpk(c[2], c[3]); return __builtin_bit_cast(bf16x8, w);
}
struct SampP { const bf16* QB; const bf16* KVB; const bf16* KCS; const float* GT; const float* cache; const float* swin; const int* pt; bf16* OB; };
__device__ __forceinline__ void samp_tile(int mode, bool bf, const void* kb, int stride, int kmax, float tb, float sk, int klo, int khi, const bf16x8 (&qr)[4],
        float& m_run, float& l_run, float invl, f32x16& o0, f32x16& o1, LAS float* wsf, LAS float* ia, LAS float* ib, int sblk0, int r32, int hi) {
    f32x16 p0, p1;
    { const float tbh = tb + sk * (float)(4 * hi);
#pragma unroll
        for (int r = 0; r < 16; ++r) { p0[r] = tbh + sk * (float)((r & 3) + 8 * (r >> 2)); p1[r] = p0[r] + 32.f * sk; } }
    { const int k0 = r32 < kmax ? r32 : kmax, k1 = r32 + 32 < kmax ? r32 + 32 : kmax;
        bf16x8 kf[8];
#pragma unroll
        for (int d0 = 0; d0 < 4; ++d0) { kf[2 * d0] = ldfrag8(bf, kb, (size_t)k0 * stride + 16 * d0 + 8 * hi); kf[2 * d0 + 1] = ldfrag8(bf, kb, (size_t)k1 * stride + 16 * d0 + 8 * hi); }
#pragma unroll
        for (int d0 = 0; d0 < 4; ++d0) { p0 = __builtin_amdgcn_mfma_f32_32x32x16_bf16(kf[2 * d0], qr[d0], p0, 0, 0, 0); p1 = __builtin_amdgcn_mfma_f32_32x32x16_bf16(kf[2 * d0 + 1], qr[d0], p1, 0, 0, 0); } }
    asm volatile("" ::: "memory");
    { const int kl = klo - 4 * hi, kh = khi - 4 * hi;
#pragma unroll
        for (int r = 0; r < 16; ++r) { const int k = (r & 3) + 8 * (r >> 2);
            if (k <= kl || k > kh) p0[r] = -INFINITY;
            if (k + 32 <= kl || k + 32 > kh) p1[r] = -INFINITY; } }
    if (mode != 2) { const float rm = rowmax32(p0, p1);
        if (__any(rm > m_run)) { const float mn = fmaxf(m_run, rm); const float alpha = __builtin_amdgcn_exp2f((m_run - mn) * LOG2E); l_run *= alpha; m_run = mn;
            if (mode == 0) { if (hi == 0) wsf[r32] = alpha;
                WSYNC();
                { const LAS float* wsb = wsf + 4 * hi; OPAQUE_PTR(wsb);
#pragma unroll
                for (int r = 0; r < 16; ++r) { const float fr = wsb[(r & 3) + 8 * (r >> 2)]; o0[r] *= fr; o1[r] *= fr; } }
                WSYNC(); } } }
    const float mL = m_run * LOG2E; float sacc = 0.f;
#pragma unroll
    for (int r = 0; r < 16; ++r) { p0[r] = __builtin_amdgcn_exp2f(p0[r] * LOG2E - mL); p1[r] = __builtin_amdgcn_exp2f(p1[r] * LOG2E - mL); sacc += p0[r] + p1[r]; }
    if (mode == 1) { l_run += sacc; return; }
    if (mode == 0) l_run += sacc;
    else {
#pragma unroll
        for (int r = 0; r < 16; ++r) { p0[r] *= invl; p1[r] *= invl; }
        LAS float* iap = ia + (sblk0 + hi) * 8; LAS float* ibp = ib + (sblk0 + hi + 1) * 8; OPAQUE_PTR(iap); OPAQUE_PTR(ibp);
#pragma unroll
        for (int k4 = 0; k4 < 4; ++k4) {
            iap[2 * k4 * 8] = (p0[4 * k4] + p0[4 * k4 + 1]) + (p0[4 * k4 + 2] + p0[4 * k4 + 3]); iap[(2 * k4 + 8) * 8] = (p1[4 * k4] + p1[4 * k4 + 1]) + (p1[4 * k4 + 2] + p1[4 * k4 + 3]);
            ibp[2 * k4 * 8] = p0[4 * k4 + 3]; ibp[(2 * k4 + 8) * 8] = p1[4 * k4 + 3]; } }
    bf16x8 pa[4];
    { v4u w;
        w.x = cvtpk(p0[0], p0[1]); w.y = cvtpk(p0[2], p0[3]); w.z = cvtpk(p0[4], p0[5]); w.w = cvtpk(p0[6], p0[7]); pa[0] = __builtin_bit_cast(bf16x8, w);
        w.x = cvtpk(p0[8], p0[9]); w.y = cvtpk(p0[10], p0[11]); w.z = cvtpk(p0[12], p0[13]); w.w = cvtpk(p0[14], p0[15]); pa[1] = __builtin_bit_cast(bf16x8, w);
        w.x = cvtpk(p1[0], p1[1]); w.y = cvtpk(p1[2], p1[3]); w.z = cvtpk(p1[4], p1[5]); w.w = cvtpk(p1[6], p1[7]); pa[2] = __builtin_bit_cast(bf16x8, w);
        w.x = cvtpk(p1[8], p1[9]); w.y = cvtpk(p1[10], p1[11]); w.z = cvtpk(p1[12], p1[13]); w.w = cvtpk(p1[14], p1[15]); pa[3] = __builtin_bit_cast(bf16x8, w); }
#pragma unroll
    for (int d0 = 0; d0 < 2; ++d0) { asm volatile("" ::: "memory");
        unsigned vw[4][4];
        if (bf) { const bf16* vb = (const bf16*)kb + 256 + 32 * d0 + r32;
#pragma unroll
            for (int ks = 0; ks < 4; ++ks)
#pragma unroll
                for (int jj = 0; jj < 4; ++jj) { int ka = 16 * ks + 8 * (jj >> 1) + 4 * hi + 2 * (jj & 1), kc2 = ka + 1; ka = ka < kmax ? ka : kmax; kc2 = kc2 < kmax ? kc2 : kmax;
                    vw[ks][jj] = (unsigned)vb[(size_t)ka * stride] | ((unsigned)vb[(size_t)kc2 * stride] << 16); } }
        else { const float* vb = (const float*)kb + 256 + 32 * d0 + r32;
#pragma unroll
            for (int ks = 0; ks < 4; ++ks)
#pragma unroll
                for (int jj = 0; jj < 4; ++jj) { int ka = 16 * ks + 8 * (jj >> 1) + 4 * hi + 2 * (jj & 1), kc2 = ka + 1; ka = ka < kmax ? ka : kmax; kc2 = kc2 < kmax ? kc2 : kmax;
                    vw[ks][jj] = cvtpk(vb[(size_t)ka * stride], vb[(size_t)kc2 * stride]); } }
#pragma unroll
        for (int ks = 0; ks < 4; ++ks) { const v4u w = {vw[ks][0], vw[ks][1], vw[ks][2], vw[ks][3]}; const bf16x8 B = __builtin_bit_cast(bf16x8, w);
            if (d0 == 0) o0 = __builtin_amdgcn_mfma_f32_32x32x16_bf16(pa[ks], B, o0, 0, 0, 0); else o1 = __builtin_amdgcn_mfma_f32_32x32x16_bf16(pa[ks], B, o1, 0, 0, 0); } }
}
__device__ __forceinline__ float samp_merge(LAS float* ML, float m_run, float l_run, int wave, int r32, int hi, float& M, float& Linv) {
    const float lt = pl32_sum(l_run);
    __syncthreads();
    if (hi == 0) *(LAS f32x2v*)(ML + (wave * 32 + r32) * 2) = (f32x2v){m_run, lt};
    __syncthreads();
    float mm = MFLOOR; f32x2v e[8];
#pragma unroll
    for (int w = 0; w < 8; ++w) { e[w] = *(const LAS f32x2v*)(ML + (w * 32 + r32) * 2); mm = fmaxf(mm, e[w].x); }
    float L = 0.f;
#pragma unroll
    for (int w = 0; w < 8; ++w) L += e[w].y * __builtin_amdgcn_exp2f((e[w].x - mm) * LOG2E);
    M = mm; Linv = L > 0.f ? 1.0f / L : 0.f;
    return __builtin_amdgcn_exp2f((m_run - mm) * LOG2E) * Linv;
}
__device__ __forceinline__ void samp_accum(LAS float* OA, LAS float* wsf, float f, f32x16& o0, f32x16& o1, int r32, int hi) {
    if (hi == 0) wsf[r32] = f;
    WSYNC();
    { const LAS float* wsb = wsf + 4 * hi; LAS float* oa = OA + 256 * hi + r32; OPAQUE_PTR(wsb); OPAQUE_PTR(oa);
#pragma unroll
    for (int r = 0; r < 16; ++r) { const float fr = wsb[(r & 3) + 8 * (r >> 2)]; const int ro = ((r & 3) + 8 * (r >> 2)) * 64;
        __hip_atomic_fetch_add(oa + ro, o0[r] * fr, __ATOMIC_RELAXED, __HIP_MEMORY_SCOPE_WORKGROUP); __hip_atomic_fetch_add(oa + ro + 32, o1[r] * fr, __ATOMIC_RELAXED, __HIP_MEMORY_SCOPE_WORKGROUP); o0[r] = 0.f; o1[r] = 0.f; } }
    WSYNC();
}
__device__ __forceinline__ void attn_sample_item(const SampP& P, int b, int g, LAS unsigned char* lds, int tid, int wave, int lane) {
    const int r32 = lane & 31, hi = lane >> 5, n = r32 >> 3, t = r32 & 7, row = MP + b * DEC_T + t;
    LAS float* OA = (LAS float*)(lds + S_OACC); LAS float* ML = (LAS float*)(lds + S_ML); LAS float* IA = (LAS float*)(lds + S_IA); LAS float* IB = (LAS float*)(lds + S_IB);
    LAS float* IMP = (LAS float*)(lds + S_IMP); LAS unsigned* FLAG = (LAS unsigned*)(lds + S_FLAG); LAS int* LIST = (LAS int*)(lds + S_LIST); LAS float* wsf = (LAS float*)(lds + S_WSF) + wave * 64;
    bf16x8 qr[4];
#pragma unroll
    for (int d0 = 0; d0 < 4; ++d0) { const v4u w = *(const v4u*)(P.QB + (size_t)row * 1024 + (4 * g + n) * 64 + 16 * d0 + 8 * hi);
        v4u o; o.x = cvtpk(__uint_as_float(w.x << 16) * 0.125f, __uint_as_float(w.x & 0xffff0000u) * 0.125f); o.y = cvtpk(__uint_as_float(w.y << 16) * 0.125f, __uint_as_float(w.y & 0xffff0000u) * 0.125f);
        o.z = cvtpk(__uint_as_float(w.z << 16) * 0.125f, __uint_as_float(w.z & 0xffff0000u) * 0.125f); o.w = cvtpk(__uint_as_float(w.w << 16) * 0.125f, __uint_as_float(w.w & 0xffff0000u) * 0.125f);
        qr[d0] = __builtin_bit_cast(bf16x8, o); }
    const float slope = exp2f(-0.5f * (float)(4 * g + n + 1));
    const int gi = vgpr_i(row * 64 + 4 * g + n); const float gate0 = P.GT[gi], gate1 = P.GT[gi + 16], gate2 = P.GT[gi + 32];
    for (int j = tid; j < 2048; j += NWAVES * 64) OA[j] = 0.f;
    for (int j = tid; j < 264; j += NWAVES * 64) FLAG[j] = 0u;
    f32x16 o0, o1;
#pragma unroll
    for (int r = 0; r < 16; ++r) { o0[r] = 0.f; o1[r] = 0.f; }
    float m_run = MFLOOR, l_run = 0.f, M = 0.f, Linv = 0.f;
    const bf16* kc = P.KCS + (size_t)b * NCP_S * 512 + g * 64;
    LAS float* ia = IA + n * 260 * 8 + t; LAS float* ib = IB + n * 260 * 8 + t;
    const bf16* newk = P.KVB + (size_t)(MP + b * DEC_T) * 1536 + g * 64;
#pragma unroll 1
    for (int step = 0; step < 4; ++step) {
        const int nt = (step < 2) ? 16 : (step == 2 ? LIST[0] : 9);
#pragma unroll 1
        for (int e = wave; e < nt; e += 8) {
            int mode = 0, stride = 1536, kmax = 63, klo = -1, khi = 64, sblk0 = 0; bool bf = true; const void* kb; float tb, sk = slope;
            if (step < 2) { mode = step + 1; kb = kc + (size_t)64 * e * 512; stride = 512; tb = slope * (float)(16 * 64 * e + 31 - PAST); sk = 16.f * slope; khi = NC_S - 1 - 64 * e; sblk0 = 16 * e; }
            else if (step == 2) { const int blk = __builtin_amdgcn_readfirstlane(LIST[1 + e]); const bool mine = (FLAG[blk] >> t) & 1u;
                if (blk == 256) { kb = newk + 2 * 256; kmax = DEC_T - 1; khi = t; tb = mine ? 0.f : -INFINITY; }
                else { const int kp0 = blk * 64; const int phys = P.pt[b * NPAGES + (kp0 >> 7)]; kb = P.cache + ((size_t)phys * PAGE + (kp0 & (PAGE - 1))) * 1024 + 2 * 256 + g * 64; bf = false; stride = 1024; tb = mine ? slope * (float)(kp0 - PAST) : -INFINITY; } }
            else if (e < 8) { kb = P.swin + (size_t)b * 512 * 512 + (size_t)(64 * e) * 512 + g * 64; bf = false; stride = 512; tb = slope * (float)(64 * e - 512); if (e == 0) klo = t; }
            else { kb = newk + 4 * 256; kmax = DEC_T - 1; khi = t; tb = 0.f; }
            samp_tile(mode, bf, kb, stride, kmax, tb, sk, klo, khi, qr, m_run, l_run, Linv, o0, o1, wsf, ia, ib, sblk0, r32, hi);
        }
        if (step == 0) { (void)samp_merge(ML, m_run, l_run, wave, r32, hi, M, Linv); m_run = M; }
        else if (step == 1) {
            samp_accum(OA, wsf, gate0, o0, o1, r32, hi);
            __syncthreads();
            { const int tt = wave; LAS float* imp = IMP + tt * 264;
                for (int s = lane; s < 257; s += 64) { float v = -1.f;
                    if (s >= 1 && s <= 254) { v = 0.f;
#pragma unroll
                        for (int nn = 0; nn < 4; ++nn) v += IA[(nn * 260 + s) * 8 + tt] + IB[(nn * 260 + s) * 8 + tt]; }
                    imp[s] = v; }
                WSYNC();
                if (lane == 0) { __hip_atomic_fetch_or(FLAG, 1u << tt, __ATOMIC_RELAXED, __HIP_MEMORY_SCOPE_WORKGROUP); __hip_atomic_fetch_or(FLAG + 255, 1u << tt, __ATOMIC_RELAXED, __HIP_MEMORY_SCOPE_WORKGROUP); __hip_atomic_fetch_or(FLAG + 256, 1u << tt, __ATOMIC_RELAXED, __HIP_MEMORY_SCOPE_WORKGROUP); }
#pragma unroll 1
                for (int it = 0; it < 13; ++it) { float bv = -3.f; int bi = 1 << 30;
                    for (int s = lane; s < 257; s += 64) { const float v = imp[s]; if (v > bv) { bv = v; bi = s; } }
#pragma unroll
                    for (int o = 1; o < 64; o <<= 1) { const float ov = __shfl_xor(bv, o); const int oi = __shfl_xor(bi, o); if (ov > bv || (ov == bv && oi < bi)) { bv = ov; bi = oi; } }
                    if (bv < 0.f) break;
                    if (lane == 0) { __hip_atomic_fetch_or(FLAG + bi, 1u << tt, __ATOMIC_RELAXED, __HIP_MEMORY_SCOPE_WORKGROUP); imp[bi] = -2.f; }
                    WSYNC(); } }
            __syncthreads();
            if (wave == 0) { int cnt = 0;
                for (int s0 = 0; s0 < 257; s0 += 64) { const int s = s0 + lane; const bool on = s < 257 && FLAG[s] != 0u; const unsigned long long bal = __ballot(on);
                    if (on) LIST[1 + cnt + __builtin_popcountll(bal & ((1ull << lane) - 1ull))] = s;
                    cnt += __builtin_popcountll(bal); }
                if (lane == 0) LIST[0] = cnt; }
            __syncthreads();
            m_run = MFLOOR; l_run = 0.f; }
        else { const float f = samp_merge(ML, m_run, l_run, wave, r32, hi, M, Linv);
            samp_accum(OA, wsf, (step == 2 ? gate1 : gate2) * f, o0, o1, r32, hi);
            m_run = MFLOOR; l_run = 0.f; }
    }
    __syncthreads();
    { const int rr = tid >> 4, d4 = (tid & 15) * 4, nn = rr >> 3, tt = rr & 7; const f32x4 v = *(const LAS f32x4*)(OA + rr * 64 + d4);
        unsigned long long w = (unsigned long long)cvtpk(v[0], v[1]) | ((unsigned long long)cvtpk(v[2], v[3]) << 32);
        *(unsigned long long*)(P.OB + (size_t)(MP + b * DEC_T + tt) * 1024 + (4 * g + nn) * 64 + d4) = w; }
    __syncthreads();
}
}
#ifndef MK_N_LAUNCHES
#define MK_N_LAUNCHES 1
#endif
constexpr int N_PHASES = 10;
#ifndef PHASE_MASK
#define PHASE_MASK 0x3ff
#endif
struct Args { const void* in[28]; float* out; unsigned char* ws; int ph_lo, ph_hi; };
__global__ void __launch_bounds__(NWAVES * 64, 2) mega_fwd(Args args) {
    extern __shared__ __attribute__((aligned(16))) unsigned char lds_raw[];
    LAS unsigned char* lds = (LAS unsigned char*)lds_raw;
    volatile LAS unsigned* MISC = (volatile LAS unsigned*)(lds + MISC_OFF);
    const int tid = threadIdx.x, lane = tid & 63, wave = __builtin_amdgcn_readfirstlane(tid >> 6);
    const int G = gridDim.x; const int bx = blockIdx.x; const int vcu = (G % 8 == 0) ? (bx % 8) * (G / 8) + bx / 8 : bx;
    const int gw = vcu * NWAVES + wave, NGW = G * NWAVES;
    unsigned char* ws = args.ws; float* out = args.out;
    gu32* ctl = (gu32*)(ws + WS_CTL);
    const float* x_prompt = (const float*)args.in[0]; const float* x_sample = (const float*)args.in[1]; const float* cache_kv = (const float*)args.in[2]; const float* state_win = (const float*)args.in[3];
    const float* st_re = (const float*)args.in[4]; const float* st_im = (const float*)args.in[5]; const int* page_table = (const int*)args.in[6];
    const float* g_mix = (const float*)args.in[7]; const float* w_in = (const float*)args.in[8]; const float* cmp_pe = (const float*)args.in[9]; const float* cmp_pool = (const float*)args.in[10]; const float* cmp_phi = (const float*)args.in[11];
    const float* w_attn_out = (const float*)args.in[12];
    const SsmIn SI{(const float*)args.in[13], (const float*)args.in[14], (const float*)args.in[15], (const float*)args.in[16], (const float*)args.in[17], (const float*)args.in[18], (const float*)args.in[19], (const float*)args.in[20]};
    const float* w_glu = (const float*)args.in[21]; const float* w_out = (const float*)args.in[22]; const float* g_ffn = (const float*)args.in[23];
    const float* w_gate = (const float*)args.in[24]; const float* w_up = (const float*)args.in[25]; const float* w_down = (const float*)args.in[26]; const float* g_final = (const float*)args.in[27];
    bf16* WIN = (bf16*)(ws + WS_WIN); bf16* WA = (bf16*)(ws + WS_WA); bf16* WGLU = (bf16*)(ws + WS_WGLU); bf16* WOUT = (bf16*)(ws + WS_WOUT); bf16* WGU = (bf16*)(ws + WS_WGU); bf16* WDN = (bf16*)(ws + WS_WDN);
    bf16* XN = (bf16*)(ws + WS_XN); float* RSTD1 = (float*)(ws + WS_RSTD1); bf16* QB = (bf16*)(ws + WS_QB); bf16* KVB = (bf16*)(ws + WS_KVB); float* U = (float*)(ws + WS_U);
    bf16* MG = (bf16*)(ws + WS_MG); float* GT = (float*)(ws + WS_GT); bf16* KCP = (bf16*)(ws + WS_KCP); bf16* KCS = (bf16*)(ws + WS_KCS); bf16* GY = (bf16*)(ws + WS_GY);
    bf16* OB = (bf16*)(ws + WS_OB); bf16* MB = (bf16*)(ws + WS_MB); float* X2 = (float*)(ws + WS_X2); bf16* HH = (bf16*)(ws + WS_HH); float* Y = (float*)(ws + WS_Y);
    float* SS2 = (float*)(ws + WS_CTL) + CW_SS2; float* SS3 = (float*)(ws + WS_CTL) + CW_SS3;

    for (int u = tid; u < (LDS_BYTES - LDSCTL_OFF) / 4; u += NWAVES * 64) ((LAS unsigned*)(lds + LDSCTL_OFF))[u] = 0u;
    __syncthreads();
    const int lo = args.ph_lo, hi = args.ph_hi;
    XcdBarrier bar; bar.bar = (unsigned*)(ctl + CW_BAR); bar.x = 0; bar.st = nullptr;
    if (hi - lo > 1) bar = xcd_barrier_post((unsigned*)(ctl + CW_BAR), MISC + 8);
#define IN(k) (lo <= (k) && (k) < hi)
#define SEAM(k) do { if (IN(k) && IN((k) + 1)) xcd_barrier(bar); } while (0)

    if (((PHASE_MASK >> 0) & 1) && IN(0)) {
        LAS unsigned* scr = (LAS unsigned*)(lds + RING_OFF) + wave * (32 * 65);
        constexpr int I0 = 32 * 124, I1 = 16 * 32, I2 = 16 * 64, I3 = 32 * 32, I4 = 32 * 176, I5 = 88 * 32, ITOT = I0 + I1 + I2 + I3 + I4 + I5;
        for (int it = gw; it < ITOT; it += NGW) { int r = it;
            if (r < I0) { const TrJob j{w_in, nullptr, g_mix, WIN, 2048, IN_COLS, NIN, 1}; tr_item(j, r, scr, lane); continue; } r -= I0;
            if (r < I1) { const TrJob j{w_attn_out, nullptr, nullptr, WA, 1024, 2048, 2048, 0}; tr_item(j, r, scr, lane); continue; } r -= I1;
            if (r < I2) { const TrJob j{w_glu, nullptr, nullptr, WGLU, 1024, 4096, 4096, 2}; tr_item(j, r, scr, lane); continue; } r -= I2;
            if (r < I3) { const TrJob j{w_out, nullptr, nullptr, WOUT, 2048, 2048, 2048, 0}; tr_item(j, r, scr, lane); continue; } r -= I3;
            if (r < I4) { const TrJob j{w_gate, w_up, g_ffn, WGU, 2048, DFF, 2 * DFF, 3}; tr_item(j, r, scr, lane); continue; } r -= I4;
            { const TrJob j{w_down, nullptr, nullptr, WDN, DFF, 2048, 2048, 0}; tr_item(j, r, scr, lane); } }
        for (int m = gw; m < MPAD; m += NGW) xn_row(m < MP ? x_prompt + (size_t)m * D_MODEL : (m < MROWS ? x_sample + (size_t)(m - MP) * D_MODEL : nullptr), XN + (size_t)m * D_MODEL, RSTD1 + m, lane);
        for (int i4 = (vcu * NWAVES * 64 + tid); i4 < DEC_B * 504 * 128; i4 += G * NWAVES * 64) { const int b = i4 / (504 * 128), rem = i4 - b * (504 * 128);
            *(GAS f32x4*)(out + O_WINS + (size_t)b * 512 * 512 + (size_t)rem * 4) = *(const GAS f32x4*)(state_win + (size_t)b * 512 * 512 + 8 * 512 + (size_t)rem * 4); }
        __syncthreads();
        compress_setup(cmp_pe, cmp_pool, cmp_phi, (LAS float*)(lds + RING_OFF), tid);
        for (int it = gw; it < DEC_B * 128; it += NGW) { const int b = it >> 7, i = it & 127; compress_item<true>(cache_kv, page_table, b, i, NC_S, KCS + (size_t)b * NCP_S * 512, (LAS float*)(lds + RING_OFF), wave, lane); }
        __syncthreads();
    }
    SEAM(0);
    if (((PHASE_MASK >> 1) & 1) && IN(1)) {
        pg8::Gemm g{XN, WIN, MPAD, NIN, D_MODEL}; pg8::StaticOrder S; S.init(MPAD, NIN, G, bx);
        epi::EpiInProj E{QB, KVB, U, MG, GT, RSTD1, out};
        pg8::gemm_phase<epi::EpiInProj, pg8::StaticOrder, true, true>(lds + RING_OFF, g, S, E);
    }
    SEAM(1);
    if (((PHASE_MASK >> 2) & 1) && IN(2)) {
#ifndef NO_P2_CMP
        if (vcu < 8) { compress_setup(cmp_pe, cmp_pool, cmp_phi, (LAS float*)(lds + RING_OFF), tid);
            for (int it = gw; it < BATCH * 16; it += NGW) { const int b = it >> 4, i = it & 15; compress_item<false>(out + O_KVP, nullptr, b, i, NC_P, KCP + (size_t)b * NCP_P * 512, (LAS float*)(lds + RING_OFF), wave, lane); } }
#endif
        if (vcu == 8) { for (int j = tid; j < BATCH * 64; j += NWAVES * 64) *(GAS v4u*)(KCP + (size_t)((j >> 6) * NCP_P + 127) * 512 + 8 * (j & 63)) = (v4u){0u, 0u, 0u, 0u}; }
        __syncthreads();
#ifndef NO_P2_SSMP
        for (int it = vcu; it < BATCH * SSM_NG; it += G) ssm_prompt_item(SI, it >> 6, it & 63, U, GY, out, lds + RING_OFF, wave, lane);
#endif
#ifndef NO_P2_SSMS
        for (int it = gw; it < DEC_B * SSM_NG; it += NGW) ssm_sample_item(SI, it >> 6, it & 63, U, st_re, st_im, GY, out, lds + RING_OFF, wave, lane);
#endif
        __syncthreads();
    }
    SEAM(2);
    if (((PHASE_MASK >> 3) & 1) && IN(3)) {
        { const nsa::UnitP UP{QB, KVB, KCP, GT, OB}; LAS int* QS = (LAS int*)(lds + nsa::A_UNI + 32);
            for (;;) { if (tid == 0) QS[0] = (int)__hip_atomic_fetch_add(ctl + CW_Q, 1u, RLX_AGENT); __syncthreads(); const int u = QS[0]; __syncthreads(); if (u >= BATCH * NKV * 32) break;
                nsa::attn_prompt_unit(UP, (u & 15) >> 2, u & 3, 31 - (u >> 4), lds + RING_OFF, tid, wave, lane); } }
#ifdef P3_SIMPLE_SAMPLE
        const AttnP P{QB, KVB, KCP, KCS, GT, cache_kv, state_win, page_table, OB};
        LAS float* W = (LAS float*)(lds + RING_OFF) + wave * AS_WORDS;
        for (int it = gw; it < MS * NKV; it += NGW) attn_item_simple(P, MP + (it >> 2), it & 3, W, lane);
#else
        { const nsa::SampP SP{QB, KVB, KCS, GT, cache_kv, state_win, page_table, OB};
            for (int it = vcu; it < DEC_B * NKV; it += G) nsa::attn_sample_item(SP, it >> 2, it & 3, lds + RING_OFF, tid, wave, lane); }
#endif
        __syncthreads();
    }
    SEAM(3);
    if (((PHASE_MASK >> 4) & 1) && IN(4)) {
        pg8::Gemm g{GY, WGLU, MPAD, 4096, 1024}; pg8::StaticOrder S; S.init(MPAD, 4096, G, bx);
        epi::EpiGlu E{MG, MB};
        pg8::gemm_phase<epi::EpiGlu, pg8::StaticOrder, true, true>(lds + RING_OFF, g, S, E);
    }
    SEAM(4);
    if (((PHASE_MASK >> 5) & 1) && IN(5)) {
        pg8::Gemm g{OB, WA, MPAD, 2048, 1024}; pg8::StaticOrder S; S.init(MPAD, 2048, G, bx);
        epi::EpiAttnOut E{MG, MB};
        pg8::gemm_phase<epi::EpiAttnOut, pg8::StaticOrder, true, true>(lds + RING_OFF, g, S, E);
    }
    SEAM(5);
    if (((PHASE_MASK >> 6) & 1) && IN(6)) {
        pg8::Gemm g{MB, WOUT, MPAD, 2048, 2048}; pg8::StaticOrder S; S.init(MPAD, 2048, G, bx);
        epi::EpiWout E{x_prompt, x_sample, X2, XN, SS2};
        pg8::gemm_phase<epi::EpiWout, pg8::StaticOrder, true, true>(lds + RING_OFF, g, S, E);
    }
    SEAM(6);
    if (((PHASE_MASK >> 7) & 1) && IN(7)) {
        pg8::Gemm g{XN, WGU, MPAD, 2 * DFF, 2048}; pg8::StaticOrder S; S.init(MPAD, 2 * DFF, G, bx);
        epi::EpiGateUp E{SS2, HH};
        pg8::gemm_phase<epi::EpiGateUp, pg8::StaticOrder, true, true>(lds + RING_OFF, g, S, E);
    }
    SEAM(7);
    if (((PHASE_MASK >> 8) & 1) && IN(8)) {
        pg8::Gemm g{HH, WDN, MPAD, 2048, DFF}; pg8::StaticOrder S; S.init(MPAD, 2048, G, bx);
        epi::EpiDown E{X2, Y, SS3};
        pg8::gemm_phase<epi::EpiDown, pg8::StaticOrder, true, true>(lds + RING_OFF, g, S, E);
    }
    SEAM(8);
    if (((PHASE_MASK >> 9) & 1) && IN(9)) {
        for (int r = gw; r < MROWS; r += NGW) {
            const float rs = 1.0f / sqrtf(SS3[vgpr_i(r)] * (1.0f / D_MODEL) + EPS);
#ifdef EXP_Y_FROM_X2
            const GAS f32x4* yr = (const GAS f32x4*)(X2 + (size_t)r * D_MODEL) + lane;
#else
            const GAS f32x4* yr = (const GAS f32x4*)(Y + (size_t)r * D_MODEL) + lane;
#endif
            const GAS f32x4* gf = (const GAS f32x4*)g_final + lane;
            GAS f32x4* o = (GAS f32x4*)(r < MP ? out + O_YP + (size_t)r * D_MODEL : out + O_YS + (size_t)(r - MP) * D_MODEL) + lane;
#pragma unroll
#ifdef EXP_Y_FROM_BF
            for (int j = 0; j < 8; ++j) { const int col = (4 * (lane + 64 * j)) % EXP_BF_LD; const bf16* sp = EXP_Y_FROM_BF + (size_t)r * EXP_BF_LD + col;
                f32x4 ov = (f32x4){bf2f(sp[0]), bf2f(sp[1]), bf2f(sp[2]), bf2f(sp[3])};
#ifdef EXP_SCRUB_NAN
                for (int e = 0; e < 4; ++e) if (!(ov[e] == ov[e]) || fabsf(ov[e]) > 1e30f) ov[e] = 12345.f;
#endif
                o[64 * j] = ov; }
#elif defined(EXP_ZERO_Y)
            for (int j = 0; j < 8; ++j) o[64 * j] = (f32x4){0.f, 0.f, 0.f, 0.f};
#else
            for (int j = 0; j < 8; ++j) o[64 * j] = yr[64 * j] * rs * gf[64 * j];
#endif
        }
    }
#undef IN
#undef SEAM
}

extern "C" void kernel_launch(void* const* d_in, const int* in_sizes, int n_in, void* d_out, int out_size, void* d_ws, size_t ws_size, hipStream_t stream) {
    static int grid = 0;
    if (grid == 0) {
        if (n_in != 28 || ws_size < WS_END) { fprintf(stderr, "kernel_launch: unexpected inputs (n_in %d, ws %zu < %zu)\n", n_in, ws_size, (size_t)WS_END); grid = -1; return; }
        int dev = 0, cus = 0;
        if (hipGetDevice(&dev) != hipSuccess || hipDeviceGetAttribute(&cus, hipDeviceAttributeMultiprocessorCount, dev) != hipSuccess) { grid = -1; return; }
        if (hipFuncSetAttribute((const void*)mega_fwd, hipFuncAttributeMaxDynamicSharedMemorySize, LDS_BYTES) != hipSuccess) { fprintf(stderr, "kernel_launch: hipFuncSetAttribute failed\n"); grid = -1; return; }
        (void)hipGetLastError();
        grid = cus;
    }
    if (grid < 0) return;
    (void)hipMemsetAsync((char*)d_ws + WS_CTL, 0, CTL_ZERO_BYTES, stream);
    Args a{};
    for (int i = 0; i < 28; ++i) a.in[i] = d_in[i];
    a.out = (float*)d_out; a.ws = (unsigned char*)d_ws;
#if MK_N_LAUNCHES == 1
    a.ph_lo = 0; a.ph_hi = N_PHASES;
    hipLaunchKernelGGL(mega_fwd, dim3(grid), dim3(NWAVES * 64), LDS_BYTES, stream, a);
#else
#ifndef EXP_SKIP_LO
#define EXP_SKIP_LO 100
#define EXP_SKIP_HI 100
#endif
    for (int ph = 0; ph < N_PHASES; ++ph) { if (ph >= EXP_SKIP_LO && ph <= EXP_SKIP_HI) continue; a.ph_lo = ph; a.ph_hi = ph + 1; hipLaunchKernelGGL(mega_fwd, dim3(grid), dim3(NWAVES * 64), LDS_BYTES, stream, a); }
#endif
}
```

```cpp
#include <hip/hip_runtime.h>
#include <hip/hip_bf16.h>
#include <cstdio>
#include <cstdint>
constexpr int D_MODEL = 2048, BATCH = 4, SEQ = 2048, DEC_B = 8, DEC_T = 8, PAST = 16384, PAGE = 128, NPAGES = PAST / PAGE;
constexpr int NH = 16, HD = 64, NKV = 4, GRP = 4;
constexpr int SSM_W = 1024, SSM_NG = 64, SSM_P = 64, SSM_C = 16;
constexpr int DFF = 5632;
constexpr int MP = BATCH * SEQ, MS = DEC_B * DEC_T, MROWS = MP + MS, MPAD = 8448;
constexpr int IN_COLS = 7728, NIN = 7936;
constexpr int NC_P = 127, NCP_P = 128, NC_S = 1023, NCP_S = 1024;
constexpr float EPS = 1e-6f;
constexpr size_t O_YP = 0, O_YS = 16777216, O_KVP = 16908288, O_WINP = 25296896, O_HRP = 26345472, O_HIP = 26361856, O_KVS = 26378240, O_WINS = 26443776, O_HRS = 28540928, O_HIS = 28573696;
constexpr size_t al256(size_t x) { return (x + 255) & ~(size_t)255; }
constexpr size_t WS_CTL = 0, CTL_ZERO_BYTES = 1u << 20;
constexpr int CW_TMO = 0, CW_Q = 512, CW_BAR = 4096, CW_SS2 = 65536, CW_SS3 = 81920;
constexpr size_t WS_WIN = CTL_ZERO_BYTES;
constexpr size_t WS_WA = WS_WIN + al256((size_t)NIN * 2048 * 2);
constexpr size_t WS_WGLU = WS_WA + al256((size_t)2048 * 1024 * 2);
constexpr size_t WS_WOUT = WS_WGLU + al256((size_t)4096 * 1024 * 2);
constexpr size_t WS_WGU = WS_WOUT + al256((size_t)2048 * 2048 * 2);
constexpr size_t WS_WDN = WS_WGU + al256((size_t)2 * DFF * 2048 * 2);
constexpr size_t WS_XN = WS_WDN + al256((size_t)2048 * DFF * 2);
constexpr size_t WS_RSTD1 = WS_XN + al256((size_t)MPAD * 2048 * 2);
constexpr size_t WS_QB = WS_RSTD1 + al256((size_t)MPAD * 4);
constexpr size_t WS_KVB = WS_QB + al256((size_t)MPAD * 1024 * 2);
constexpr size_t WS_U = WS_KVB + al256((size_t)MPAD * 1536 * 2);
constexpr size_t WS_MG = WS_U + al256((size_t)MPAD * 1024 * 4);
constexpr size_t WS_GT = WS_MG + al256((size_t)MPAD * 4096 * 2);
constexpr size_t WS_KCP = WS_GT + al256((size_t)MPAD * 64 * 4);
constexpr size_t WS_KCS = WS_KCP + al256((size_t)BATCH * NCP_P * 512 * 4);
constexpr size_t WS_GY = WS_KCS + al256((size_t)DEC_B * NCP_S * 512 * 4);
constexpr size_t WS_OB = WS_GY + al256((size_t)MPAD * 1024 * 2);
constexpr size_t WS_MB = WS_OB + al256((size_t)MPAD * 1024 * 2);
constexpr size_t WS_X2 = WS_MB + al256((size_t)MPAD * 2048 * 2);
constexpr size_t WS_HH = WS_X2 + al256((size_t)MPAD * 2048 * 4);
constexpr size_t WS_Y = WS_HH + al256((size_t)MPAD * DFF * 2);
constexpr size_t WS_END = WS_Y + al256((size_t)MPAD * 2048 * 4);
namespace pg8 {
#define PG8_LAS __attribute__((address_space(3)))
typedef unsigned short bf16_t;
typedef short bf16x8 __attribute__((ext_vector_type(8)));
typedef float f32x4 __attribute__((ext_vector_type(4)));
typedef unsigned u32x4 __attribute__((ext_vector_type(4)));
constexpr int BM = 256, BK = 64, HALF = 128, HTB = HALF * BK * 2  , STAGE_BYTES = 8 * HTB, NXCD = 8, WGM = 8;

__host__ __device__ __forceinline__ int lds_byte(int r, int c) { const int st = (r >> 4) * 2 + (c >> 5), rr = r & 15, cc = c & 31, ob = rr * 64 + cc * 2; return st * 1024 + (ob ^ (((ob >> 9) & 1) << 5)); }
__host__ __device__ __forceinline__ void stage_rc(int b, int& R, int& C) { const int st = b / 1024, sb = b % 1024, swz = sb ^ (((sb >> 9) & 1) << 5); R = (st >> 1) * 16 + swz / 64; C = (st & 1) * 32 + (swz % 64) / 2; }
__host__ __device__ __forceinline__ int perm32(int rho) { const int n = rho >> 4, i = rho & 15; return 8 * (i >> 2) + 4 * n + (i & 3); }

struct Unit { int pm, pn; };
struct Gemm { const bf16_t* A; const bf16_t* Bt; int M, N, K; };

struct StaticOrder {
    int nM, nN, nwg, G, c;
    __host__ __device__ void init(int M, int N, int G_, int c_) { nM = M / BM; nN = N / BM; nwg = nM * nN; G = G_; c = c_; }
    __host__ __device__ bool next(int i, Unit& u) const {
        const long L = (long)i * G + c; if (L >= nwg) return false;
        int wgid = (int)L; { const int q = nwg / NXCD, r = nwg % NXCD, xcd = wgid % NXCD, off = wgid / NXCD; wgid = (xcd < r ? xcd * (q + 1) : r * (q + 1) + (xcd - r) * q) + off; }
        const int nig = WGM * nN, gid = wgid / nig, fm = gid * WGM, gsz = (nM - fm) < WGM ? (nM - fm) : WGM;
        u.pm = fm + ((wgid % nig) % gsz); u.pn = (wgid % nig) / gsz; return true;
    }
    __device__ __forceinline__ void a_ready(const Unit&) const {}
    __device__ __forceinline__ void done(const Unit&) const {}
};

typedef float f32x2_cv __attribute__((ext_vector_type(2))); typedef __bf16 bf16x2_cv __attribute__((ext_vector_type(2)));
__device__ __forceinline__ unsigned cvt_pk_bf16(float lo, float hi) { f32x2_cv v = {lo, hi}; bf16x2_cv b = __builtin_convertvector(v, bf16x2_cv); return __builtin_bit_cast(unsigned, b); }
template <class Epi, class Sched, bool ALIGN_EPI = false, bool SP2 = false>
__device__ __forceinline__ void gemm_phase(PG8_LAS unsigned char* lds, const Gemm g, const Sched& S, const Epi& E) {
    const int tid = threadIdx.x, wid = __builtin_amdgcn_readfirstlane(tid >> 6), lane = tid & 63, wr = wid >> 2, wc = wid & 3, fr = lane & 15, fq = lane >> 4;
    const int K = g.K, nt = K / BK;
    unsigned voffA[2], voffB[2];
#pragma unroll
    for (int i = 0; i < 2; ++i) { int R, C; stage_rc(tid * 16 + i * 8192, R, C); const int Rb = Epi::PERM ? ((R & ~31) + perm32(R & 31)) : R;
        voffA[i] = (unsigned)(R * K + C) * 2u; voffB[i] = (unsigned)(Rb * K + C) * 2u; }
    const size_t kstep = (size_t)(BK * 2);
    const size_t hstep = (size_t)HALF * K * 2;
    const size_t tstep = 2 * hstep;
    const unsigned ldsw = (unsigned)wid * 1024u;
    const int aoff = lds_byte(wr * 64 + fr, fq * 8), boff = lds_byte(wc * 32 + fr, fq * 8);
#define PG8_SA(b, h) (((b) * 2 + (h)) * HTB)
#define PG8_SB(b, h) ((4 + (b) * 2 + (h)) * HTB)
#define PG8_STAGE(bufoff, gbase, voff) do { _Pragma("unroll") for (int _i = 0; _i < 2; ++_i) \
        __builtin_amdgcn_global_load_lds((const unsigned*)((const char*)(gbase) + (voff)[_i]), (PG8_LAS unsigned*)(lds + (bufoff) + ldsw + _i * 8192), 16, 0, 0); } while (0)
#define PG8_LDA(dst, b, h) do { _Pragma("unroll") for (int m = 0; m < 4; ++m) _Pragma("unroll") for (int k = 0; k < 2; ++k) dst[m][k] = *(const PG8_LAS bf16x8*)(lds + PG8_SA(b, h) + aoff + m * 2048 + k * 1024); } while (0)
#define PG8_LDB(dst, b, h) do { _Pragma("unroll") for (int n = 0; n < 2; ++n) _Pragma("unroll") for (int k = 0; k < 2; ++k) dst[n][k] = *(const PG8_LAS bf16x8*)(lds + PG8_SB(b, h) + boff + n * 2048 + k * 1024); } while (0)
#define PG8_MMA(ai, bj, At, Bt) do { __builtin_amdgcn_s_setprio(1); _Pragma("unroll") for (int m = 0; m < 4; ++m) _Pragma("unroll") for (int n = 0; n < 2; ++n) _Pragma("unroll") for (int k = 0; k < 2; ++k) \
        acc[ai][bj][m][n] = __builtin_amdgcn_mfma_f32_16x16x32_bf16(Bt[n][k], At[m][k], acc[ai][bj][m][n], 0, 0, 0); __builtin_amdgcn_s_setprio(0); } while (0)
#define PG8_WAIT_V(n) asm volatile("s_waitcnt vmcnt(" #n ")" ::: "memory")
#define PG8_WAIT_L(n) asm volatile("s_waitcnt lgkmcnt(" #n ")" ::: "memory")
#define PG8_BAR __builtin_amdgcn_s_barrier()
#define PG8_SCHED __builtin_amdgcn_sched_barrier(0)
    Unit cur, nxt; int ui = 0;
    if (!S.next(0, cur)) return;
    f32x4 acc[2][2][4][2];
#pragma unroll
    for (int a = 0; a < 2; ++a)
#pragma unroll
        for (int b = 0; b < 2; ++b)
#pragma unroll
            for (int m = 0; m < 4; ++m)
#pragma unroll
                for (int n = 0; n < 2; ++n) acc[a][b][m][n] = (f32x4){0.f, 0.f, 0.f, 0.f};
    bf16x8 At[4][2], B0[2][2], B1[2][2];
    const char* cA = (const char*)g.A + (size_t)cur.pm * tstep; const char* cB = (const char*)g.Bt + (size_t)cur.pn * tstep;
    S.a_ready(cur);
    if constexpr (SP2) {
        PG8_STAGE(PG8_SB(0, 0), cB, voffB); PG8_STAGE(PG8_SB(0, 1), cB + hstep, voffB); PG8_STAGE(PG8_SA(0, 0), cA, voffA); PG8_STAGE(PG8_SA(0, 1), cA + hstep, voffA);
        if (wr == 1) PG8_BAR;
        PG8_WAIT_V(2); PG8_BAR;
        PG8_STAGE(PG8_SB(1, 0), cB + kstep, voffB); PG8_STAGE(PG8_SA(1, 0), cA + kstep, voffA); PG8_STAGE(PG8_SB(1, 1), cB + hstep + kstep, voffB);
        PG8_WAIT_V(6); PG8_BAR;
    } else {
        PG8_STAGE(PG8_SB(0, 0), cB, voffB); PG8_STAGE(PG8_SA(0, 0), cA, voffA); PG8_STAGE(PG8_SB(0, 1), cB + hstep, voffB); PG8_STAGE(PG8_SA(0, 1), cA + hstep, voffA);
        if (wr == 1) PG8_BAR;
        PG8_WAIT_V(4); PG8_BAR;
        PG8_STAGE(PG8_SB(1, 0), cB + kstep, voffB); PG8_STAGE(PG8_SA(1, 0), cA + kstep, voffA); PG8_STAGE(PG8_SB(1, 1), cB + hstep + kstep, voffB);
        PG8_WAIT_V(6); PG8_BAR;
    }
    for (;;) {
        const bool has_next = S.next(ui + 1, nxt);
        const char* nA = has_next ? (const char*)g.A + (size_t)nxt.pm * tstep : cA; const char* nB = has_next ? (const char*)g.Bt + (size_t)nxt.pn * tstep : cB;
        for (int t = 0; t < nt; t += 2) {
            const bool last = (t == nt - 2);
            const char* a1 = cA + (size_t)(t + 1) * kstep;
            const char* a2 = last ? nA : cA + (size_t)(t + 2) * kstep; const char* b2 = last ? nB : cB + (size_t)(t + 2) * kstep;
            const char* a3 = a2 + kstep; const char* b3 = b2 + kstep;
            if (last && has_next) S.a_ready(nxt);
            if constexpr (SP2) {
            PG8_LDB(B0, 0, 0); PG8_LDB(B1, 0, 1); PG8_SCHED; PG8_LDA(At, 0, 0); PG8_STAGE(PG8_SA(1, 1), a1 + hstep, voffA);
            PG8_WAIT_V(8); PG8_WAIT_L(0); PG8_BAR; PG8_MMA(0, 0, At, B0); PG8_MMA(0, 1, At, B1); PG8_BAR; PG8_SCHED;
            PG8_LDA(At, 0, 1); PG8_STAGE(PG8_SB(0, 0), b2, voffB); PG8_STAGE(PG8_SB(0, 1), b2 + hstep, voffB); PG8_STAGE(PG8_SA(0, 0), a2, voffA);
            PG8_WAIT_V(8); PG8_WAIT_L(0); PG8_BAR; PG8_MMA(1, 0, At, B0); PG8_MMA(1, 1, At, B1); PG8_BAR; PG8_SCHED;
            PG8_LDB(B0, 1, 0); PG8_LDB(B1, 1, 1); PG8_SCHED; PG8_LDA(At, 1, 0); PG8_STAGE(PG8_SA(0, 1), a2 + hstep, voffA);
            PG8_WAIT_V(8); PG8_WAIT_L(0); PG8_BAR; PG8_MMA(0, 0, At, B0); PG8_MMA(0, 1, At, B1); PG8_BAR; PG8_SCHED;
            PG8_LDA(At, 1, 1); PG8_STAGE(PG8_SB(1, 0), b3, voffB); PG8_STAGE(PG8_SB(1, 1), b3 + hstep, voffB); PG8_STAGE(PG8_SA(1, 0), a3, voffA);
            PG8_WAIT_V(8); PG8_WAIT_L(0); PG8_BAR; PG8_MMA(1, 0, At, B0); PG8_MMA(1, 1, At, B1); PG8_BAR; PG8_SCHED;
            } else {
            PG8_LDB(B0, 0, 0); PG8_SCHED; PG8_LDA(At, 0, 0); PG8_STAGE(PG8_SA(1, 1), a1 + hstep, voffA);
            PG8_WAIT_L(8); PG8_BAR; PG8_WAIT_L(0); PG8_MMA(0, 0, At, B0); PG8_BAR; PG8_SCHED;
            PG8_LDB(B1, 0, 1); PG8_STAGE(PG8_SB(0, 0), b2, voffB);
            PG8_BAR; PG8_WAIT_L(0); PG8_MMA(0, 1, At, B1); PG8_BAR;
            PG8_LDA(At, 0, 1); PG8_STAGE(PG8_SA(0, 0), a2, voffA);
            PG8_BAR; PG8_WAIT_L(0); PG8_MMA(1, 0, At, B0); PG8_BAR; PG8_SCHED;
            PG8_STAGE(PG8_SB(0, 1), b2 + hstep, voffB);
            PG8_WAIT_V(6); PG8_BAR; PG8_MMA(1, 1, At, B1); PG8_BAR;
            PG8_LDB(B0, 1, 0); PG8_SCHED; PG8_LDA(At, 1, 0); PG8_STAGE(PG8_SA(0, 1), a2 + hstep, voffA);
            PG8_WAIT_L(8); PG8_BAR; PG8_WAIT_L(0); PG8_MMA(0, 0, At, B0); PG8_BAR; PG8_SCHED;
            PG8_LDB(B1, 1, 1); PG8_STAGE(PG8_SB(1, 0), b3, voffB);
            PG8_BAR; PG8_WAIT_L(0); PG8_MMA(0, 1, At, B1); PG8_BAR;
            PG8_LDA(At, 1, 1); PG8_STAGE(PG8_SA(1, 0), a3, voffA);
            PG8_BAR; PG8_WAIT_L(0); PG8_MMA(1, 0, At, B0); PG8_BAR; PG8_SCHED;
            PG8_STAGE(PG8_SB(1, 1), b3 + hstep, voffB);
            PG8_WAIT_V(6); PG8_BAR; PG8_MMA(1, 1, At, B1); PG8_BAR;
            }
        }
        if constexpr (ALIGN_EPI) { if (wr == 0) PG8_BAR; }
        if constexpr (!Epi::AFTER_DRAIN) { E(acc, cur, wr, wc, fr, fq); S.done(cur); }
        if (!has_next) break;
#pragma unroll
        for (int a = 0; a < 2; ++a)
#pragma unroll
            for (int b = 0; b < 2; ++b)
#pragma unroll
                for (int m = 0; m < 4; ++m)
#pragma unroll
                    for (int n = 0; n < 2; ++n) acc[a][b][m][n] = (f32x4){0.f, 0.f, 0.f, 0.f};
        cur = nxt; cA = nA; cB = nB; ++ui;
        if constexpr (ALIGN_EPI) { if (wr == 1) PG8_BAR; }
    }
    PG8_WAIT_V(0);
    if constexpr (!ALIGN_EPI) { if (wr == 0) PG8_BAR; }
    PG8_BAR;
    if constexpr (Epi::AFTER_DRAIN) { E.fused(acc, cur, wr, wc, fr, fq, lds, wid, lane); S.done(cur); }
#undef PG8_SA
#undef PG8_SB
#undef PG8_STAGE
#undef PG8_LDA
#undef PG8_LDB
#undef PG8_MMA
#undef PG8_WAIT_V
#undef PG8_WAIT_L
#undef PG8_BAR
#undef PG8_SCHED
}
}
#define GAS __attribute__((address_space(1)))
#define LAS __attribute__((address_space(3)))
typedef unsigned short bf16;
typedef unsigned v4u __attribute__((ext_vector_type(4)));
typedef float f32x4 __attribute__((ext_vector_type(4)));
typedef short bf16x8 __attribute__((ext_vector_type(8)));
typedef GAS unsigned gu32;
typedef GAS unsigned long long gu64;
#define RLX_AGENT __ATOMIC_RELAXED, __HIP_MEMORY_SCOPE_AGENT
#define LDS_WAIT() asm volatile("s_waitcnt lgkmcnt(0)" ::: "memory")
#define VM_WAIT() asm volatile("s_waitcnt vmcnt(0)" ::: "memory")
__device__ __forceinline__ unsigned long long rt() { return __builtin_amdgcn_s_memrealtime(); }
__device__ __forceinline__ unsigned f2bf(float f) { unsigned u = __builtin_bit_cast(unsigned, f); return (u + 0x7fffu + ((u >> 16) & 1u)) >> 16; }
__device__ __forceinline__ unsigned pk2(float lo, float hi) { return f2bf(lo) | (f2bf(hi) << 16); }

#define XB_TMO      128
#define XB_XCNT(j)  (256  + 64 * (j))
#define XB_XSUB(j)  (1280 + 64 * (j))
#define XB_XGEN(j)  (2304 + 64 * (j))
#define XB_TOP      3328
#define XB_TOPGEN   3392
#define XCD_BAR_WORDS 3456
#define XB_SPIN_CAP (1u << 18)

__device__ __forceinline__ unsigned xb_ld(unsigned* p)              { return __hip_atomic_load(p, __ATOMIC_RELAXED, __HIP_MEMORY_SCOPE_AGENT); }
__device__ __forceinline__ unsigned xb_add(unsigned* p, unsigned v) { return __hip_atomic_fetch_add(p, v, __ATOMIC_RELAXED, __HIP_MEMORY_SCOPE_AGENT); }
__device__ __forceinline__ unsigned xb_xcc_id() { return (unsigned)__builtin_amdgcn_s_getreg((3 << 11) | 20) & 0xFu; }
#define XB_SPIN(cond, bar) do { unsigned _sp = 0; while (cond) { __builtin_amdgcn_s_sleep(1); \
    if ((++_sp & 255u) == 0u) { if (xb_ld(&(bar)[XB_TMO])) break; if (_sp > XB_SPIN_CAP) { atomicAdd(&(bar)[XB_TMO], 1u); break; } } } } while (0)

struct XcdBarrier {
    unsigned* bar; unsigned x;
    volatile LAS unsigned* st;
};

__device__ __forceinline__ XcdBarrier xcd_barrier_post(unsigned* bar, volatile LAS unsigned* st) {
    XcdBarrier b; b.bar = bar; b.x = xb_xcc_id(); b.st = st;
    if (threadIdx.x == 0) (void)xb_add(&bar[XB_XCNT(b.x)], 1u);
    return b;
}
__device__ __forceinline__ void xcd_barrier_complete(unsigned* bar, unsigned x, unsigned& nloc, unsigned& nx) {
    const unsigned G = gridDim.x * gridDim.y * gridDim.z;
    unsigned sum, cnt, mine, sp = 0u;
    for (;;) {
        sum = 0u; cnt = 0u; mine = 0u;
#pragma unroll
        for (unsigned j = 0; j < 16; ++j) { const unsigned c = xb_ld(&bar[XB_XCNT(j)]); sum += c; cnt += (c > 0u) ? 1u : 0u; mine = (j == x) ? c : mine; }
        if (sum == G) break;
        __builtin_amdgcn_s_sleep(1);
        if ((++sp & 255u) == 0u) { if (xb_ld(&bar[XB_TMO])) break; if (sp > XB_SPIN_CAP) { atomicAdd(&bar[XB_TMO], 1u); break; } }
    }
    nloc = mine > 0u ? mine : 1u; nx = cnt > 0u ? cnt : 1u;
}

__device__ __forceinline__ void xcd_barrier(const XcdBarrier& b) {
    asm volatile("s_waitcnt vmcnt(0)" ::: "memory");
    __syncthreads();
    if (threadIdx.x == 0) {
        unsigned* bar = b.bar;
        __builtin_amdgcn_s_waitcnt(0);
        unsigned nloc = b.st[0], nx = b.st[1];
        if (nloc == 0u) { xcd_barrier_complete(bar, b.x, nloc, nx); b.st[0] = nloc; b.st[1] = nx; }
        const unsigned old = xb_add(&bar[XB_XSUB(b.x)], 1u);
        const unsigned gen = old / nloc;
        if (old + 1u == (gen + 1u) * nloc) {
            __builtin_amdgcn_fence(__ATOMIC_RELEASE, "agent");
            asm volatile("s_waitcnt vmcnt(0)" ::: "memory");
            const unsigned og = xb_add(&bar[XB_TOP], 1u);
            const unsigned tg = og / nx;
            if (og + 1u == (tg + 1u) * nx) xb_add(&bar[XB_TOPGEN], 1u);
            else XB_SPIN(xb_ld(&bar[XB_TOPGEN]) == tg, bar);
            __builtin_amdgcn_fence(__ATOMIC_ACQUIRE, "agent");
            xb_add(&bar[XB_XGEN(b.x)], 1u);
            asm volatile("s_waitcnt vmcnt(0)" ::: "memory");
        } else {
            XB_SPIN(xb_ld(&bar[XB_XGEN(b.x)]) == gen, bar);
            __builtin_amdgcn_fence(__ATOMIC_ACQUIRE, "agent");
            asm volatile("s_waitcnt vmcnt(0)" ::: "memory");
        }
    }
    __syncthreads();
}
namespace epi {
using pg8::f32x4; using pg8::Unit; using pg8::bf16_t; using pg8::u32x4; using pg8::cvt_pk_bf16;
__device__ __forceinline__ float sigm(float x) { return __builtin_amdgcn_rcpf(1.f + __builtin_amdgcn_exp2f(-1.4426950408889634f * x)); }
__device__ __forceinline__ f32x4 sigm4(f32x4 v) { return (f32x4){sigm(v[0]), sigm(v[1]), sigm(v[2]), sigm(v[3])}; }
__device__ __forceinline__ u32x4 pack8(f32x4 a, f32x4 b) { u32x4 w; w.x = cvt_pk_bf16(a[0], a[1]); w.y = cvt_pk_bf16(a[2], a[3]); w.z = cvt_pk_bf16(b[0], b[1]); w.w = cvt_pk_bf16(b[2], b[3]); return w; }
__device__ __forceinline__ void unpack8(u32x4 w, f32x4& a, f32x4& b) {
    a[0] = __uint_as_float(w.x << 16); a[1] = __uint_as_float(w.x & 0xffff0000u); a[2] = __uint_as_float(w.y << 16); a[3] = __uint_as_float(w.y & 0xffff0000u);
    b[0] = __uint_as_float(w.z << 16); b[1] = __uint_as_float(w.z & 0xffff0000u); b[2] = __uint_as_float(w.w << 16); b[3] = __uint_as_float(w.w & 0xffff0000u); }

struct EpiInProj { static constexpr bool PERM = true, AFTER_DRAIN = false;
    bf16_t* Qb; bf16_t* KVb; float* U; bf16_t* MG; float* GT; const float* rstd; float* out;
    __device__ __forceinline__ void operator()(const f32x4 (&acc)[2][2][4][2], const Unit& u, int wr, int wc, int fr, int fq) const {
        const int pn = u.pn, row0 = u.pm * 256 + wr * 64 + fr, c0 = wc * 32 + 8 * fq;
#pragma unroll
        for (int ai = 0; ai < 2; ++ai)
#pragma unroll
            for (int m = 0; m < 4; ++m) { const int r = row0 + ai * 128 + m * 16; const bool ok = r < MROWS; const float rs = rstd[r];
#pragma unroll
                for (int bj = 0; bj < 2; ++bj) { f32x4 v0 = acc[ai][bj][m][0] * rs, v1 = acc[ai][bj][m][1] * rs; const int c = c0 + bj * 128;
                    if (!ok) continue;
                    if (pn < 4) { *(u32x4*)(Qb + (size_t)r * 1024 + pn * 256 + c) = pack8(v0, v1); }
                    else if (pn < 10) { const int slot = pn - 4; *(u32x4*)(KVb + (size_t)r * 1536 + slot * 256 + c) = pack8(v0, v1);
                        float* dst = nullptr;
                        if (slot < 4) dst = (r < MP) ? out + O_KVP + (size_t)r * 1024 + slot * 256 + c : out + O_KVS + (size_t)(r - MP) * 1024 + slot * 256 + c;
                        else if (r < MP) { const int t = r & (SEQ - 1); if (t >= SEQ - 512) dst = out + O_WINP + ((size_t)((r >> 11) * 512 + (t - (SEQ - 512))) * 2 + (slot - 4)) * 256 + c; }
                        else { const int q = r - MP; dst = out + O_WINS + ((size_t)((q >> 3) * 512 + 504 + (q & 7)) * 2 + (slot - 4)) * 256 + c; }
                        if (dst) { *(f32x4*)dst = v0; *(f32x4*)(dst + 4) = v1; } }
                    else if (pn < 14) { float* dst = U + (size_t)r * 1024 + (pn - 10) * 256 + c; *(f32x4*)dst = v0; *(f32x4*)(dst + 4) = v1; }
                    else if (pn < 30) { *(u32x4*)(MG + (size_t)r * 4096 + (pn - 14) * 256 + c) = pack8(sigm4(v0), sigm4(v1)); }
                    else if (c < 48) { float* dst = GT + (size_t)r * 64 + c; *(f32x4*)dst = sigm4(v0); *(f32x4*)(dst + 4) = sigm4(v1); } } }
    }
};
struct EpiGlu { static constexpr bool PERM = true, AFTER_DRAIN = false;
    const bf16_t* MG; bf16_t* MB;
    __device__ __forceinline__ void operator()(const f32x4 (&acc)[2][2][4][2], const Unit& u, int wr, int wc, int fr, int fq) const {
        const int row0 = u.pm * 256 + wr * 64 + fr, col = u.pn * 128 + wc * 32 + 8 * fq;
#pragma unroll
        for (int ai = 0; ai < 2; ++ai)
#pragma unroll
            for (int m = 0; m < 4; ++m) { const int r = row0 + ai * 128 + m * 16; if (r >= MROWS) continue;
                f32x4 s0, s1; unpack8(*(const u32x4*)(MG + (size_t)r * 4096 + 2048 + col), s0, s1);
                const f32x4 y0 = acc[ai][0][m][0] * sigm4(acc[ai][1][m][0]) * s0, y1 = acc[ai][0][m][1] * sigm4(acc[ai][1][m][1]) * s1;
                *(u32x4*)(MB + (size_t)r * 2048 + col) = pack8(y0, y1); }
    }
};
struct EpiAttnOut { static constexpr bool PERM = true, AFTER_DRAIN = false;
    const bf16_t* MG; bf16_t* MB;
    __device__ __forceinline__ void operator()(const f32x4 (&acc)[2][2][4][2], const Unit& u, int wr, int wc, int fr, int fq) const {
        const int row0 = u.pm * 256 + wr * 64 + fr, col0 = u.pn * 256 + wc * 32 + 8 * fq;
#pragma unroll
        for (int ai = 0; ai < 2; ++ai)
#pragma unroll
            for (int m = 0; m < 4; ++m) { const int r = row0 + ai * 128 + m * 16; if (r >= MROWS) continue;
#pragma unroll
                for (int bj = 0; bj < 2; ++bj) { const int col = col0 + bj * 128;
                    f32x4 s0, s1, b0, b1; unpack8(*(const u32x4*)(MG + (size_t)r * 4096 + col), s0, s1); unpack8(*(const u32x4*)(MB + (size_t)r * 2048 + col), b0, b1);
                    *(u32x4*)(MB + (size_t)r * 2048 + col) = pack8(b0 + s0 * acc[ai][bj][m][0], b1 + s1 * acc[ai][bj][m][1]); } }
    }
};
struct EpiWout { static constexpr bool PERM = true, AFTER_DRAIN = false;
    const float* xp; const float* xs; float* X2; bf16_t* XN; float* ss;
    __device__ __forceinline__ void operator()(const f32x4 (&acc)[2][2][4][2], const Unit& u, int wr, int wc, int fr, int fq) const {
        const int row0 = u.pm * 256 + wr * 64 + fr, col0 = u.pn * 256 + wc * 32 + 8 * fq;
#pragma unroll
        for (int ai = 0; ai < 2; ++ai)
#pragma unroll
            for (int m = 0; m < 4; ++m) { const int r = row0 + ai * 128 + m * 16; const bool ok = r < MROWS; float s = 0.f;
                const float* xr = (r < MP) ? xp + (size_t)r * 2048 : xs + (size_t)(ok ? r - MP : 0) * 2048;
#pragma unroll
                for (int bj = 0; bj < 2; ++bj) { const int col = col0 + bj * 128;
                    f32x4 v0 = acc[ai][bj][m][0], v1 = acc[ai][bj][m][1];
                    if (ok) { v0 += *(const f32x4*)(xr + col); v1 += *(const f32x4*)(xr + col + 4);
                        float* d = X2 + (size_t)r * 2048 + col; *(f32x4*)d = v0; *(f32x4*)(d + 4) = v1; *(u32x4*)(XN + (size_t)r * 2048 + col) = pack8(v0, v1); }
                    s += (v0[0] * v0[0] + v0[1] * v0[1]) + (v0[2] * v0[2] + v0[3] * v0[3]) + (v1[0] * v1[0] + v1[1] * v1[1]) + (v1[2] * v1[2] + v1[3] * v1[3]); }
                s += __shfl_xor(s, 16); s += __shfl_xor(s, 32);
                if (ok && fq == 0) atomicAdd(ss + r, s); }
    }
};
struct EpiGateUp { static constexpr bool PERM = true, AFTER_DRAIN = false;
    const float* ss; bf16_t* HH;
    __device__ __forceinline__ void operator()(const f32x4 (&acc)[2][2][4][2], const Unit& u, int wr, int wc, int fr, int fq) const {
        const int row0 = u.pm * 256 + wr * 64 + fr, col = u.pn * 128 + wc * 32 + 8 * fq;
#pragma unroll
        for (int ai = 0; ai < 2; ++ai)
#pragma unroll
            for (int m = 0; m < 4; ++m) { const int r = row0 + ai * 128 + m * 16; if (r >= MROWS) continue;
                const float rs = 1.0f / sqrtf(ss[r] * (1.0f / 2048.0f) + EPS);
                const f32x4 g0 = acc[ai][0][m][0] * rs, g1 = acc[ai][0][m][1] * rs, u0 = acc[ai][1][m][0] * rs, u1 = acc[ai][1][m][1] * rs;
                *(u32x4*)(HH + (size_t)r * DFF + col) = pack8(g0 * sigm4(g0) * u0, g1 * sigm4(g1) * u1); }
    }
};
struct EpiDown { static constexpr bool PERM = true, AFTER_DRAIN = false;
    const float* X2; float* Y; float* ss;
    __device__ __forceinline__ void operator()(const f32x4 (&acc)[2][2][4][2], const Unit& u, int wr, int wc, int fr, int fq) const {
        const int row0 = u.pm * 256 + wr * 64 + fr, col0 = u.pn * 256 + wc * 32 + 8 * fq;
#pragma unroll
        for (int ai = 0; ai < 2; ++ai)
#pragma unroll
            for (int m = 0; m < 4; ++m) { const int r = row0 + ai * 128 + m * 16; const bool ok = r < MROWS; float s = 0.f;
#pragma unroll
                for (int bj = 0; bj < 2; ++bj) { const int col = col0 + bj * 128;
                    f32x4 v0 = acc[ai][bj][m][0], v1 = acc[ai][bj][m][1];
                    if (ok) { const float* xr = X2 + (size_t)r * 2048 + col; v0 += *(const f32x4*)xr; v1 += *(const f32x4*)(xr + 4);
                        float* d = Y + (size_t)r * 2048 + col; *(f32x4*)d = v0; *(f32x4*)(d + 4) = v1; }
                    s += (v0[0] * v0[0] + v0[1] * v0[1]) + (v0[2] * v0[2] + v0[3] * v0[3]) + (v1[0] * v1[0] + v1[1] * v1[1]) + (v1[2] * v1[2] + v1[3] * v1[3]); }
                s += __shfl_xor(s, 16); s += __shfl_xor(s, 32);
                if (ok && fq == 0) atomicAdd(ss + r, s); }
    }
};
}
constexpr int RING_OFF = 0, RING_BYTES = 131072;
constexpr int LDSCTL_OFF = RING_BYTES, MISC_OFF = LDSCTL_OFF + 320;
constexpr int LDS_BYTES = 147456;
constexpr int NWAVES = 8;
typedef float f32x2v __attribute__((ext_vector_type(2)));

#define WSYNC() do { asm volatile("s_waitcnt lgkmcnt(0)" ::: "memory"); __builtin_amdgcn_wave_barrier(); asm volatile("" ::: "memory"); } while (0)
__device__ __forceinline__ int vgpr_i(int x) { asm volatile("" : "+v"(x)); return x; }
__device__ __forceinline__ float bf2f(unsigned short h) { return __uint_as_float((unsigned)h << 16); }
__device__ __forceinline__ float wave_sum(float v) {
#pragma unroll
    for (int o = 1; o < 64; o <<= 1) v += __shfl_xor(v, o);
    return v; }
__device__ __forceinline__ float wave_max(float v) {
#pragma unroll
    for (int o = 1; o < 64; o <<= 1) v = fmaxf(v, __shfl_xor(v, o));
    return v; }
__device__ __forceinline__ float fsigm(float x) { return __builtin_amdgcn_rcpf(1.f + __builtin_amdgcn_exp2f(-1.4426950408889634f * x)); }
__device__ __forceinline__ float gelu_tanh(float x) { return x * fsigm(1.5957691216057308f * (x + 0.044715f * x * x * x)); }
__device__ __forceinline__ float fexp(float x) { return __builtin_amdgcn_exp2f(1.4426950408889634f * x); }

struct TrJob { const float* W0; const float* W1; const float* g; bf16* WT; int K, Nsrc, Ndst, kind; };
__device__ __forceinline__ const float* tr_src(const TrJob& j, int n) {
    switch (j.kind) {
    default: return n < j.Nsrc ? j.W0 + n : nullptr;
    case 1: { if (n < 2560) return j.W0 + n; if (n < 3584) return j.W0 + 2608 + (n - 2560); if (n < 7680) return j.W0 + 3632 + (n - 3584); if (n < 7728) return j.W0 + 2560 + (n - 7680); return nullptr; }
    case 2: { const int pn = n >> 8, w = n & 255; return j.W0 + (w < 128 ? 128 * pn + w : 2048 + 128 * pn + (w - 128)); }
    case 3: { const int pn = n >> 8, w = n & 255; return w < 128 ? j.W0 + 128 * pn + w : j.W1 + 128 * pn + (w - 128); }
    }
}
__device__ __forceinline__ void tr_item(const TrJob& j, int item, LAS unsigned* scr, int lane) {
    (void)scr;
    const int nblk = j.Ndst / 64, kb = item / nblk, nb = item % nblk, kq = lane >> 4, n4 = 4 * (lane & 15), k0 = 64 * kb + 16 * kq, n0 = 64 * nb + n4;
    const float* src = tr_src(j, n0); const float msk = src ? 1.f : 0.f; if (!src) src = j.W0;
    src += (size_t)k0 * j.Nsrc;
    f32x4 v[16];
#pragma unroll
    for (int i = 0; i < 16; ++i) v[i] = *(const GAS f32x4*)(src + (size_t)i * j.Nsrc);
    f32x4 gg[4];
#pragma unroll
    for (int i = 0; i < 4; ++i) gg[i] = j.g ? *(const f32x4*)(j.g + k0 + 4 * i) * msk : (f32x4){msk, msk, msk, msk};
#pragma unroll
    for (int e = 0; e < 4; ++e) { v4u o0, o1;
        o0.x = pk2(v[0][e] * gg[0][0], v[1][e] * gg[0][1]); o0.y = pk2(v[2][e] * gg[0][2], v[3][e] * gg[0][3]); o0.z = pk2(v[4][e] * gg[1][0], v[5][e] * gg[1][1]); o0.w = pk2(v[6][e] * gg[1][2], v[7][e] * gg[1][3]);
        o1.x = pk2(v[8][e] * gg[2][0], v[9][e] * gg[2][1]); o1.y = pk2(v[10][e] * gg[2][2], v[11][e] * gg[2][3]); o1.z = pk2(v[12][e] * gg[3][0], v[13][e] * gg[3][1]); o1.w = pk2(v[14][e] * gg[3][2], v[15][e] * gg[3][3]);
        GAS v4u* d = (GAS v4u*)(j.WT + (size_t)(n0 + e) * j.K + k0); d[0] = o0; d[1] = o1; }
}
__device__ __forceinline__ void xn_row(const float* xrow, bf16* orow, float* rstd_out, int lane) {
    GAS unsigned long long* o8 = (GAS unsigned long long*)orow + lane;
    if (!xrow) {
#pragma unroll
        for (int j = 0; j < 8; ++j) o8[64 * j] = 0ull;
        if (lane == 0) *rstd_out = 0.f; return; }
    const GAS f32x4* xr = (const GAS f32x4*)xrow + lane; f32x4 v[8]; float s = 0.f;
#pragma unroll
    for (int j = 0; j < 8; ++j) { v[j] = xr[64 * j]; s += (v[j].x * v[j].x + v[j].y * v[j].y) + (v[j].z * v[j].z + v[j].w * v[j].w); }
    s = wave_sum(s);
#pragma unroll
    for (int j = 0; j < 8; ++j) o8[64 * j] = (unsigned long long)pk2(v[j].x, v[j].y) | ((unsigned long long)pk2(v[j].z, v[j].w) << 32);
    if (lane == 0) *rstd_out = 1.0f / sqrtf(s * (1.0f / D_MODEL) + EPS);
}

constexpr int CMP_PHI = 0, CMP_POOL = 8192, CMP_CST = 8256, CMP_GS = 8384;
__device__ __forceinline__ void compress_setup(const float* pe, const float* pool, const float* phi, LAS float* L, int tid) {
    for (int i = tid; i < 8192; i += NWAVES * 64) L[CMP_PHI + i] = phi[i];
    if (tid < 64) L[CMP_POOL + tid] = pool[tid];
    if (tid < 128) { const int w = tid >> 6, d = tid & 63; float s = 0.f;
        for (int j = 0; j < 32; ++j) s += pool[w * 32 + j] * pe[(w * 32 + j) * 64 + d];
        L[CMP_CST + tid] = s; }
    __syncthreads();
}
template <bool SAMPLE, int BLK> __device__ __forceinline__ void compress_item(const float* rows, const int* pt, int b, int i, int nc, bf16* KC, LAS float* L, int wave, int lane) {
    const int which = lane >> 5;
    f32x4 plo0 = {0.f, 0.f, 0.f, 0.f}, plo1 = plo0;
    const int m_end = (BLK * i + BLK < nc) ? BLK * i + BLK : nc;
    for (int m = BLK * i; m <= m_end; ++m) {
        const float* base;
        if (SAMPLE) { const int pos = 16 * m; const int phys = pt[b * NPAGES + (pos >> 7)]; base = rows + ((size_t)phys * PAGE + (pos & (PAGE - 1))) * 1024 + 8 * lane; }
        else base = rows + ((size_t)b * SEQ + 16 * m) * 1024 + 8 * lane;
        f32x4 lo0 = {0.f, 0.f, 0.f, 0.f}, lo1 = lo0, hi0 = lo0, hi1 = lo0;
#pragma unroll
        for (int j = 0; j < 16; ++j) { const f32x4 v0 = *(const f32x4*)(base + (size_t)j * 1024), v1 = *(const f32x4*)(base + (size_t)j * 1024 + 4);
            const float pl = L[CMP_POOL + which * 32 + j], ph = L[CMP_POOL + which * 32 + 16 + j];
            lo0 += pl * v0; lo1 += pl * v1; hi0 += ph * v0; hi1 += ph * v1; }
        if (m > BLK * i) { const int c = m - 1;
            const f32x4 c0 = *(const LAS f32x4*)(L + CMP_CST + which * 64 + 8 * (lane & 7)), c1 = *(const LAS f32x4*)(L + CMP_CST + which * 64 + 8 * (lane & 7) + 4);
            f32x4 g0 = plo0 + hi0 + c0, g1 = plo1 + hi1 + c1;
#pragma unroll
            for (int e = 0; e < 4; ++e) { g0[e] = gelu_tanh(g0[e]); g1[e] = gelu_tanh(g1[e]); }
            LAS float* Gs = L + CMP_GS + wave * 512;
            *(LAS f32x4*)(Gs + 8 * lane) = g0; *(LAS f32x4*)(Gs + 8 * lane + 4) = g1;
            WSYNC();
            f32x4 a0 = {0.f, 0.f, 0.f, 0.f}, a1 = a0; const LAS float* gr = Gs + (lane >> 3) * 64; const LAS float* ph = L + CMP_PHI + which * 4096 + 8 * (lane & 7);
#pragma unroll 8
            for (int d = 0; d < 64; ++d) { const float gv = gr[d]; a0 += gv * *(const LAS f32x4*)(ph + d * 64); a1 += gv * *(const LAS f32x4*)(ph + d * 64 + 4); }
            { v4u w; w.x = pk2(a0[0], a0[1]); w.y = pk2(a0[2], a0[3]); w.z = pk2(a1[0], a1[1]); w.w = pk2(a1[2], a1[3]); *(GAS v4u*)(KC + (size_t)c * 512 + 8 * lane) = w; }
            WSYNC(); }
        plo0 = lo0; plo1 = lo1;
    }
}

struct SsmIn { const float *lam_re, *lam_im, *log_dt, *b_re, *b_im, *c_re, *c_im, *dsk; };
struct SsmC { float ar, ai, dsk; f32x2v bb[16]; float cm[32]; };
__device__ __forceinline__ void ssm_consts(const SsmIn& I, int g, int lane, SsmC& C) {
    const int p = lane; const float dt = expf(I.log_dt[g]), lr = I.lam_re[g * 64 + p], li = I.lam_im[g * 64 + p];
    const float mag = expf(lr * dt); float sn, cs; sincosf(li * dt, &sn, &cs);
    C.ar = mag * cs; C.ai = mag * sn;
    const float den = lr * lr + li * li, fr = ((C.ar - 1.f) * lr + C.ai * li) / den, fi = (C.ai * lr - (C.ar - 1.f) * li) / den;
#pragma unroll
    for (int c4 = 0; c4 < 4; ++c4) { const f32x4 br = *(const f32x4*)(I.b_re + (size_t)(g * 64 + p) * 16 + 4 * c4), bi = *(const f32x4*)(I.b_im + (size_t)(g * 64 + p) * 16 + 4 * c4);
#pragma unroll
        for (int e = 0; e < 4; ++e) C.bb[4 * c4 + e] = (f32x2v){fr * br[e] - fi * bi[e], fr * bi[e] + fi * br[e]}; }
    const int c = lane & 15, q = lane >> 4;
#pragma unroll
    for (int k4 = 0; k4 < 4; ++k4) { const f32x4 cr = *(const f32x4*)(I.c_re + (size_t)(g * 16 + c) * 64 + 16 * q + 4 * k4), ci = *(const f32x4*)(I.c_im + (size_t)(g * 16 + c) * 64 + 16 * q + 4 * k4);
#pragma unroll
        for (int e = 0; e < 4; ++e) { C.cm[8 * k4 + 2 * e] = cr[e]; C.cm[8 * k4 + 2 * e + 1] = -ci[e]; } }
    C.dsk = I.dsk[g * 16 + c];
}
__device__ __forceinline__ f32x4 ssm_y16(const LAS float* Hs, const SsmC& C, int lane) {
    const int trow = lane & 15, q = lane >> 4; f32x4 d = {0.f, 0.f, 0.f, 0.f};
#pragma unroll
    for (int k4 = 0; k4 < 8; ++k4) { const f32x4 a = *(const LAS f32x4*)(Hs + trow * 132 + 32 * q + 4 * k4);
#pragma unroll
        for (int e = 0; e < 4; ++e) d = __builtin_amdgcn_mfma_f32_16x16x4f32(a[e], C.cm[4 * k4 + e], d, 0, 0, 0); }
    return d;
}
constexpr int SSM_US = 0, SSM_HS = 16384, SSM_HEND = SSM_HS + 8 * 8448;
__device__ __forceinline__ void ssm_prompt_item(const SsmIn& I, int b, int g, const float* U, bf16* GY, float* out, LAS unsigned char* lds, int wave, int lane) {
    SsmC C; ssm_consts(I, g, lane, C);
    float a32r = C.ar, a32i = C.ai;
#pragma unroll
    for (int s = 0; s < 5; ++s) { const float nr = a32r * a32r - a32i * a32i, ni = 2.f * a32r * a32i; a32r = nr; a32i = ni; }
    LAS float* uS = (LAS float*)(lds + SSM_US) + wave * 512; LAS float* Hs = (LAS float*)(lds + SSM_HS) + wave * 2112; LAS float* hend = (LAS float*)(lds + SSM_HEND);
    float cr = 0.f, ci = 0.f;
#pragma unroll 1
    for (int sb = 0; sb < SEQ / 256; ++sb) {
        const int row0 = b * SEQ + sb * 256 + wave * 32;
#pragma unroll
        for (int h = 0; h < 2; ++h) { const int tt = (lane >> 2) + 16 * h; *(LAS f32x4*)(uS + tt * 16 + 4 * (lane & 3)) = *(const f32x4*)(U + (size_t)(row0 + tt) * 1024 + g * 16 + 4 * (lane & 3)); }
        WSYNC();
        f32x2v x[32];
#pragma unroll
        for (int i = 0; i < 32; ++i) { f32x2v sx = {0.f, 0.f}; asm volatile("" ::: "memory");
#pragma unroll
            for (int c4 = 0; c4 < 4; ++c4) { const f32x4 u4 = *(const LAS f32x4*)(uS + i * 16 + 4 * c4);
#pragma unroll
                for (int e = 0; e < 4; ++e) sx += u4[e] * C.bb[4 * c4 + e]; }
            x[i] = sx; }
        const f32x2v A1 = {C.ar, C.ar}, A2 = {-C.ai, C.ai};
        f32x2v h = {0.f, 0.f};
#pragma unroll
        for (int i = 0; i < 32; ++i) { const f32x2v hs = __builtin_shufflevector(h, h, 1, 0); h = A1 * h + (A2 * hs + x[i]); }
        const float hr = h.x, hi = h.y;
        *(LAS f32x2v*)(hend + (wave * 64 + lane) * 2) = (f32x2v){hr, hi};
        __syncthreads();
        float chr = cr, chi = ci, cinr = 0.f, cini = 0.f;
#pragma unroll
        for (int w = 0; w < 8; ++w) { if (w == wave) { cinr = chr; cini = chi; }
            const f32x2v e = *(const LAS f32x2v*)(hend + (w * 64 + lane) * 2);
            const float nr = a32r * chr - a32i * chi + e.x, ni = a32r * chi + a32i * chr + e.y; chr = nr; chi = ni; }
        cr = chr; ci = chi; h = (f32x2v){cinr, cini};
#pragma unroll
        for (int half = 0; half < 2; ++half) {
#pragma unroll
            for (int i = 0; i < 16; ++i) { const int ii = half * 16 + i; const f32x2v hs = __builtin_shufflevector(h, h, 1, 0); h = A1 * h + (A2 * hs + x[ii]);
                *(LAS f32x2v*)(Hs + i * 132 + 2 * lane) = h; }
            WSYNC();
            const f32x4 d = ssm_y16(Hs, C, lane); const int c = lane & 15, q = lane >> 4;
#pragma unroll
            for (int r = 0; r < 4; ++r) { const int tt = half * 16 + 4 * q + r; const float y = d[r] + C.dsk * uS[tt * 16 + c];
                GY[(size_t)(row0 + tt) * 1024 + g * 16 + c] = (bf16)f2bf(gelu_tanh(y)); }
            WSYNC();
        }
        __syncthreads();
    }
    if (wave == 0) { out[O_HRP + (size_t)(b * 64 + g) * 64 + lane] = cr; out[O_HIP + (size_t)(b * 64 + g) * 64 + lane] = ci; }
}
__device__ __forceinline__ void ssm_sample_item(const SsmIn& I, int b, int g, const float* U, const float* h0r, const float* h0i, bf16* GY, float* out, LAS unsigned char* lds, int wave, int lane) {
    SsmC C; ssm_consts(I, g, lane, C);
    LAS float* uS = (LAS float*)(lds + SSM_US) + wave * 512; LAS float* Hs = (LAS float*)(lds + SSM_HS) + wave * 2112;
    const int row0 = MP + b * DEC_T;
    if (lane < 32) { const int tt = lane >> 2; *(LAS f32x4*)(uS + tt * 16 + 4 * (lane & 3)) = *(const f32x4*)(U + (size_t)(row0 + tt) * 1024 + g * 16 + 4 * (lane & 3)); }
    WSYNC();
    float hr = h0r[(size_t)(b * 64 + g) * 64 + lane], hi = h0i[(size_t)(b * 64 + g) * 64 + lane];
#pragma unroll
    for (int i = 0; i < 16; ++i) {
        if (i < DEC_T) { f32x2v sx = {0.f, 0.f};
#pragma unroll
            for (int c4 = 0; c4 < 4; ++c4) { const f32x4 u4 = *(const LAS f32x4*)(uS + i * 16 + 4 * c4);
#pragma unroll
                for (int e = 0; e < 4; ++e) sx += u4[e] * C.bb[4 * c4 + e]; }
            const float nr = C.ar * hr - C.ai * hi + sx.x, ni = C.ar * hi + C.ai * hr + sx.y; hr = nr; hi = ni; }
        *(LAS f32x2v*)(Hs + i * 132 + 2 * lane) = (i < DEC_T) ? (f32x2v){hr, hi} : (f32x2v){0.f, 0.f}; }
    WSYNC();
    out[O_HRS + (size_t)(b * 64 + g) * 64 + lane] = hr; out[O_HIS + (size_t)(b * 64 + g) * 64 + lane] = hi;
    const f32x4 d = ssm_y16(Hs, C, lane); const int c = lane & 15, q = lane >> 4;
#pragma unroll
    for (int r = 0; r < 4; ++r) { const int tt = 4 * q + r; if (tt < DEC_T) { const float y = d[r] + C.dsk * uS[tt * 16 + c];
        GY[(size_t)(row0 + tt) * 1024 + g * 16 + c] = (bf16)f2bf(gelu_tanh(y)); } }
    WSYNC();
}

constexpr int AS_QS = 0, AS_PS = 256, AS_PSUM = 512, AS_IMP = 1536, AS_SEL = 1800, AS_WORDS = 2048;
__device__ __forceinline__ void ld8(bool bf, const void* base, size_t off, float (&k)[8]) {
    if (bf) { const v4u w = *(const v4u*)((const bf16*)base + off);
        k[0] = __uint_as_float(w.x << 16); k[1] = __uint_as_float(w.x & 0xffff0000u); k[2] = __uint_as_float(w.y << 16); k[3] = __uint_as_float(w.y & 0xffff0000u);
        k[4] = __uint_as_float(w.z << 16); k[5] = __uint_as_float(w.z & 0xffff0000u); k[6] = __uint_as_float(w.w << 16); k[7] = __uint_as_float(w.w & 0xffff0000u); }
    else { const f32x4 a = *(const f32x4*)((const float*)base + off), b = *(const f32x4*)((const float*)base + off + 4);
        k[0] = a[0]; k[1] = a[1]; k[2] = a[2]; k[3] = a[3]; k[4] = b[0]; k[5] = b[1]; k[6] = b[2]; k[7] = b[3]; }
}
__device__ __forceinline__ float ld1(bool bf, const void* base, size_t off) { return bf ? bf2f(((const bf16*)base)[off]) : ((const float*)base)[off]; }
template <int MODE> __device__ __forceinline__ void att_chunk(bool bf, const void* kb, int stride, int c_lo, int c_hi, int kp0, int kstep, int pc,
        const float (&sl)[4], LAS float* W, float (&m)[4], float (&l)[4], float (&acc)[4], LAS float* psum, int lane) {
    const bool valid = lane >= c_lo && lane < c_hi;
    float s[4] = {0.f, 0.f, 0.f, 0.f};
    if (valid) {
#pragma unroll 1
        for (int hh = 0; hh < 2; ++hh) {
            float kk[4][8];
#pragma unroll
            for (int i = 0; i < 4; ++i) ld8(bf, kb, (size_t)lane * stride + 32 * hh + 8 * i, kk[i]);
#pragma unroll
            for (int i = 0; i < 4; ++i) { const float (&k)[8] = kk[i];
#pragma unroll
                for (int n = 0; n < 4; ++n) { asm volatile("" ::: "memory");
                    const f32x4 qa = *(const LAS f32x4*)(W + AS_QS + n * 64 + 32 * hh + 8 * i), qb = *(const LAS f32x4*)(W + AS_QS + n * 64 + 32 * hh + 8 * i + 4);
                    s[n] += (k[0] * qa[0] + k[1] * qa[1]) + (k[2] * qa[2] + k[3] * qa[3]) + (k[4] * qb[0] + k[5] * qb[1]) + (k[6] * qb[2] + k[7] * qb[3]); } }
            asm volatile("" ::: "memory"); } }
    const float dist = (float)(pc - (kp0 + kstep * lane));
#pragma unroll
    for (int n = 0; n < 4; ++n) s[n] = valid ? s[n] * 0.125f - sl[n] * dist : -INFINITY;
    if (MODE == 1) {
#pragma unroll
        for (int n = 0; n < 4; ++n) { const float mn = fmaxf(m[n], wave_max(s[n])); const float sc = (m[n] == -INFINITY) ? 0.f : fexp(m[n] - mn);
            l[n] = l[n] * sc + wave_sum(valid ? fexp(s[n] - mn) : 0.f); m[n] = mn; }
        return; }
    f32x4 p;
    if (MODE == 0) {
#pragma unroll
        for (int n = 0; n < 4; ++n) { const float mn = fmaxf(m[n], wave_max(s[n])); const float sc = (m[n] == -INFINITY) ? 0.f : fexp(m[n] - mn);
            p[n] = valid ? fexp(s[n] - mn) : 0.f; l[n] = l[n] * sc + wave_sum(p[n]); acc[n] *= sc; m[n] = mn; }
    } else {
#pragma unroll
        for (int n = 0; n < 4; ++n) p[n] = valid ? fexp(s[n] - m[n]) * l[n] : 0.f;
        psum[lane] = (p[0] + p[1]) + (p[2] + p[3]);
    }
    *(LAS f32x4*)(W + AS_PS + 4 * lane) = p;
    WSYNC();
#pragma unroll 2
    for (int c = c_lo; c < c_hi; ++c) { const float v = ld1(bf, kb, (size_t)c * stride + 256 + lane); const f32x4 pp = *(const LAS f32x4*)(W + AS_PS + 4 * c);
#pragma unroll
        for (int n = 0; n < 4; ++n) acc[n] += pp[n] * v; }
    WSYNC();
}
struct AttnP { const bf16* Qb; const bf16* KVb; const bf16* KCP; const bf16* KCS; const float* GT; const float* cache; const float* swin; const int* pt; bf16* OB; };
__device__ __forceinline__ void attn_item_simple(const AttnP& P, int r, int g, LAS float* W, int lane) {
    const bool sample = r >= MP; const int q_ = r - MP;
    const int b = sample ? (q_ >> 3) : (r >> 11), t = sample ? (q_ & 7) : (r & (SEQ - 1)), pc = sample ? PAST + t : t;
    const int rowbase = sample ? MP + b * DEC_T : b * SEQ;
    float sl[4];
#pragma unroll
    for (int n = 0; n < 4; ++n) { W[AS_QS + n * 64 + lane] = bf2f(P.Qb[(size_t)r * 1024 + (4 * g + n) * 64 + lane]); sl[n] = exp2f(-0.5f * (float)(4 * g + n + 1)); }
    WSYNC();
    float ot[4] = {0.f, 0.f, 0.f, 0.f};
    const int gi = vgpr_i(r * 64 + 4 * g);
    const int ncmax = sample ? NC_S : NC_P; int ncv = pc >= 31 ? (pc - 31) / 16 + 1 : 0; if (ncv > ncmax) ncv = ncmax;
    const bf16* kc = sample ? P.KCS + (size_t)b * NCP_S * 512 : P.KCP + (size_t)b * NCP_P * 512;
    if (ncv > 0) { float m[4] = {-INFINITY, -INFINITY, -INFINITY, -INFINITY}, l[4] = {0.f, 0.f, 0.f, 0.f}, oc[4] = {0.f, 0.f, 0.f, 0.f};
#pragma unroll 1
        for (int c0 = 0; c0 < ncv; c0 += 64) att_chunk<1>(true, kc + (size_t)c0 * 512 + g * 64, 512, 0, (ncv - c0 < 64) ? ncv - c0 : 64, 16 * c0 + 31, 16, pc, sl, W, m, l, oc, nullptr, lane);
#pragma unroll
        for (int n = 0; n < 4; ++n) l[n] = 1.0f / l[n];
#pragma unroll 1
        for (int c0 = 0; c0 < ncv; c0 += 64) att_chunk<2>(true, kc + (size_t)c0 * 512 + g * 64, 512, 0, (ncv - c0 < 64) ? ncv - c0 : 64, 16 * c0 + 31, 16, pc, sl, W, m, l, oc, W + AS_PSUM + c0, lane);
#pragma unroll
        for (int n = 0; n < 4; ++n) ot[n] = P.GT[gi + n] * oc[n]; }
    const int ns = sample ? 257 : 32, cur = pc >> 6;
    for (int s = lane; s < ns; s += 64) { float v;
        if (s > cur) v = -1.f; else if (s == 0 || s == cur || s == cur - 1) v = 1e4f;
        else { v = 0.f; for (int c = 4 * s - 1; c <= 4 * s + 3; ++c) v += W[AS_PSUM + c]; }
        W[AS_IMP + s] = v; }
    WSYNC();
    int nsel = 0;
#pragma unroll 1
    for (int it = 0; it < 16; ++it) { float bv = -3.f; int bi = 1 << 30;
        for (int s = lane; s < ns; s += 64) { const float v = W[AS_IMP + s]; if (v > bv) { bv = v; bi = s; } }
#pragma unroll
        for (int o = 1; o < 64; o <<= 1) { const float ov = __shfl_xor(bv, o); const int oi = __shfl_xor(bi, o); if (ov > bv || (ov == bv && oi < bi)) { bv = ov; bi = oi; } }
        if (bv < 0.f) break;
        if (lane == 0) { ((LAS int*)W)[AS_SEL + nsel] = bi; W[AS_IMP + bi] = -2.f; }
        WSYNC(); ++nsel; }
    const int lo = pc - 511 > 0 ? pc - 511 : 0;
#pragma unroll 1
    for (int br = 0; br < 2; ++br) {
        float m[4] = {-INFINITY, -INFINITY, -INFINITY, -INFINITY}, l[4] = {0.f, 0.f, 0.f, 0.f}, o[4] = {0.f, 0.f, 0.f, 0.f};
        int nch;
        if (br == 0) nch = nsel; else if (!sample) nch = (pc >> 6) - (lo >> 6) + 1; else nch = (512 - ((t + 1) & ~63)) / 64 + 1;
#pragma unroll 1
        for (int i = 0; i < nch; ++i) {
            bool bf = true; const void* kb; int stride = 1536, c_lo = 0, c_hi = 64, kp0;
            const bf16* newrows = P.KVb + (size_t)rowbase * 1536 + (2 + 2 * br) * 256 + g * 64;
            if (br == 0) { const int blk = __builtin_amdgcn_readfirstlane(((LAS int*)W)[AS_SEL + i]); kp0 = blk * 64;
                if (!sample) { kb = newrows + (size_t)kp0 * 1536; c_hi = (pc - kp0 + 1 < 64) ? pc - kp0 + 1 : 64; }
                else if (blk == 256) { kb = newrows; c_hi = t + 1; }
                else { const int phys = P.pt[b * NPAGES + (kp0 >> 7)]; kb = P.cache + ((size_t)phys * PAGE + (kp0 & (PAGE - 1))) * 1024 + 2 * 256 + g * 64; bf = false; stride = 1024; } }
            else if (!sample) { kp0 = (lo & ~63) + 64 * i; kb = newrows + (size_t)kp0 * 1536; c_lo = lo - kp0 > 0 ? lo - kp0 : 0; c_hi = (pc - kp0 + 1 < 64) ? pc - kp0 + 1 : 64; }
            else if (i < nch - 1) { const int i0 = ((t + 1) & ~63) + 64 * i; kb = P.swin + ((size_t)(b * 512 + i0) * 2) * 256 + g * 64; bf = false; stride = 512; c_lo = t + 1 - i0 > 0 ? t + 1 - i0 : 0; kp0 = PAST - 512 + i0; }
            else { kb = newrows; c_hi = t + 1; kp0 = PAST; }
            att_chunk<0>(bf, kb, stride, c_lo, c_hi, kp0, 1, pc, sl, W, m, l, o, nullptr, lane);
        }
#pragma unroll
        for (int n = 0; n < 4; ++n) ot[n] += P.GT[gi + 16 * (br + 1) + n] * o[n] / l[n];
    }
#pragma unroll
    for (int n = 0; n < 4; ++n) P.OB[(size_t)r * 1024 + (4 * g + n) * 64 + lane] = (bf16)f2bf(ot[n]);
    WSYNC();
}
namespace nsa {
typedef float f32x16 __attribute__((ext_vector_type(16)));
typedef short s16x4 __attribute__((ext_vector_type(4)));
typedef short v4i16_t __attribute__((ext_vector_type(4)));
constexpr float LOG2E = 1.4426950408889634f, MFLOOR = -1e20f;
constexpr int A_KS = 0, A_VS = 16384, A_IMPA = 32768, A_IMPB = 65536, A_IMPV = 98304, A_MASK = 106752, A_UNI = 107008, A_TL = 107072, A_WSF = 108096, A_END = 110144, A_OT = A_IMPA  , A_OST = A_KS  ;
__device__ __forceinline__ int crow(int r, int hi) { return (r & 3) + 8 * (r >> 2) + 4 * hi; }
#define OPAQUE_PTR(p) asm volatile("" : "+v"(p))
__device__ __forceinline__ unsigned cvtpk(float lo, float hi) { return pg8::cvt_pk_bf16(lo, hi); }
__device__ __forceinline__ float pl32_max(float m) { auto rr = __builtin_amdgcn_permlane32_swap(__float_as_uint(m), __float_as_uint(m), false, false); return fmaxf(__uint_as_float(rr[0]), __uint_as_float(rr[1])); }
__device__ __forceinline__ float pl32_sum(float m) { auto rr = __builtin_amdgcn_permlane32_swap(__float_as_uint(m), __float_as_uint(m), false, false); return __uint_as_float(rr[0]) + __uint_as_float(rr[1]); }
__device__ __forceinline__ s16x4 vtr(const LAS unsigned char* p) { return __builtin_bit_cast(s16x4, __builtin_amdgcn_ds_read_tr16_b64_v4i16((LAS v4i16_t*)p)); }
__device__ __forceinline__ void qkt(f32x16& p0, f32x16& p1, const LAS unsigned char* Ks, const bf16x8 (&qr)[4], int r32, int hi) {
    const LAS unsigned char* kb = Ks + hi * 1024 + r32 * 16;
#pragma unroll
    for (int d0 = 0; d0 < 4; ++d0) { const bf16x8 b0 = *(const LAS bf16x8*)(kb + d0 * 2048), b1 = *(const LAS bf16x8*)(kb + d0 * 2048 + 512);
        p0 = __builtin_amdgcn_mfma_f32_32x32x16_bf16(b0, qr[d0], p0, 0, 0, 0); p1 = __builtin_amdgcn_mfma_f32_32x32x16_bf16(b1, qr[d0], p1, 0, 0, 0); }
}
__device__ __forceinline__ void pv(f32x16& o0, f32x16& o1, const LAS unsigned char* vp, const bf16x8 (&pa)[4]) {
#pragma unroll
    for (int d0 = 0; d0 < 2; ++d0) { asm volatile("" ::: "memory");
#pragma unroll
        for (int ks = 0; ks < 4; ++ks) { const s16x4 lo = vtr(vp + d0 * 4096 + ks * 1024), hh = vtr(vp + d0 * 4096 + ks * 1024 + 512);
            const bf16x8 B = {lo[0], lo[1], lo[2], lo[3], hh[0], hh[1], hh[2], hh[3]};
            if (d0 == 0) o0 = __builtin_amdgcn_mfma_f32_32x32x16_bf16(pa[ks], B, o0, 0, 0, 0); else o1 = __builtin_amdgcn_mfma_f32_32x32x16_bf16(pa[ks], B, o1, 0, 0, 0); } }
}
__device__ __forceinline__ float rowmax32(const f32x16& p0, const f32x16& p1) {
    float a = fmaxf(p0[0], p1[0]);
#pragma unroll
    for (int r = 1; r < 16; ++r) a = fmaxf(a, fmaxf(p0[r], p1[r]));
    return pl32_max(a);
}
struct Tile { int info, row0, col, kp0; };
struct UnitP { const bf16* QB; const bf16* KVB; const bf16* KC; const float* GT; bf16* OB; };
__device__ __forceinline__ void attn_prompt_unit(const UnitP& P, int b, int g, int i, LAS unsigned char* lds, int tid, int wave, int lane) {
    const int n = wave >> 1, qh = wave & 1, r32 = lane & 31, hi = lane >> 5, qloc = 32 * qh + r32, pos0 = 64 * i, qpos = pos0 + qloc, rowbase = b * SEQ;
    LAS float* wsf = (LAS float*)(lds + A_WSF) + wave * 64; LAS int* TL = (LAS int*)(lds + A_TL);
    LAS float* IA = (LAS float*)(lds + A_IMPA); LAS float* IB = (LAS float*)(lds + A_IMPB); LAS float* IV = (LAS float*)(lds + A_IMPV); LAS unsigned* MK = (LAS unsigned*)(lds + A_MASK); LAS unsigned* UNI = (LAS unsigned*)(lds + A_UNI);
    bf16x8 qr[4];
#pragma unroll
    for (int d0 = 0; d0 < 4; ++d0) { const v4u w = *(const v4u*)(P.QB + (size_t)(rowbase + qpos) * 1024 + (4 * g + n) * 64 + 16 * d0 + 8 * hi);
        v4u o; o.x = cvtpk(__uint_as_float(w.x << 16) * 0.125f, __uint_as_float(w.x & 0xffff0000u) * 0.125f); o.y = cvtpk(__uint_as_float(w.y << 16) * 0.125f, __uint_as_float(w.y & 0xffff0000u) * 0.125f);
        o.z = cvtpk(__uint_as_float(w.z << 16) * 0.125f, __uint_as_float(w.z & 0xffff0000u) * 0.125f); o.w = cvtpk(__uint_as_float(w.w << 16) * 0.125f, __uint_as_float(w.w & 0xffff0000u) * 0.125f);
        qr[d0] = __builtin_bit_cast(bf16x8, o); }
    const float slope = exp2f(-0.5f * (float)(4 * g + n + 1));
#define GATE(k) (P.GT[vgpr_i((rowbase + qpos) * 64 + 4 * g + n) + 16 * (k)])
    LAS float* otw = (LAS float*)(lds + A_OT) + wave * 2048 + 256 * hi + r32;
    const LAS unsigned char* vp_l = lds + A_VS + ((lane >> 4) & 1) * 32 + (lane & 3) * 8 + (4 * hi + ((lane & 15) >> 2)) * 64;
    const int ncT = (i < 16) ? 1 : 2;
    if (tid < 2 * ncT) { const int pass = tid / ncT, j = tid % ncT; TL[4 * tid] = pass | (1 << 4) | (1 << 8); TL[4 * tid + 1] = b * NCP_P + 64 * j; TL[4 * tid + 2] = g * 64; TL[4 * tid + 3] = 64 * j; }
    __syncthreads();
    float m_run = MFLOOR, l_run = 0.f, invl = 0.f; f32x16 o0, o1; unsigned mymask = 0u;
#pragma unroll
    for (int r = 0; r < 16; ++r) { o0[r] = 0.f; o1[r] = 0.f; }
    int curbr = 0;
#pragma unroll 1
    for (int seq = 0; seq < 2; ++seq) {
        int NT;
        if (seq == 0) NT = 2 * ncT;
        else {
            { const int q = tid >> 3, part = tid & 7;
#pragma unroll
                for (int e = 0; e < 4; ++e) { const int s = 4 * part + e; float v;
                    if (s > i) v = -1.f; else if (s == 0 || s == i || s == i - 1) v = 1e4f;
                    else { v = 0.f;
#pragma unroll
                        for (int nn = 0; nn < 4; ++nn) v += IA[(nn * 32 + s) * 64 + q] + IB[(nn * 32 + s) * 64 + q]; }
                    IV[q * 33 + s] = v; }
                __syncthreads();
                float vv[32];
#pragma unroll
                for (int s = 0; s < 32; ++s) vv[s] = IV[q * 33 + s];
                unsigned bits = 0u;
#pragma unroll
                for (int e = 0; e < 4; ++e) { const int s = 4 * part + e; const float v = IV[q * 33 + s]; int rank = 0;
#pragma unroll
                    for (int s2 = 0; s2 < 32; ++s2) rank += (vv[s2] > v || (vv[s2] == v && s2 < s)) ? 1 : 0;
                    if (v >= 0.f && rank < 16) bits |= 1u << s; }
                bits |= __shfl_xor(bits, 1); bits |= __shfl_xor(bits, 2); bits |= __shfl_xor(bits, 4);
                if (part == 0) MK[q] = bits;
                bits |= __shfl_xor(bits, 8); bits |= __shfl_xor(bits, 16); bits |= __shfl_xor(bits, 32);
                if (lane == 0) UNI[wave] = bits;
                __syncthreads();
                unsigned uni = 0u;
#pragma unroll
                for (int w = 0; w < 8; ++w) uni |= UNI[w];
                const int nsel = __builtin_popcount(uni), nwin = (i < 8) ? i + 1 : 9;
                NT = nsel + nwin;
                if (tid < NT) { int info, blk;
                    if (tid < nsel) { unsigned u = uni; for (int k = 0; k < nsel - 1 - tid; ++k) u &= u - 1; blk = __builtin_ctz(u); info = 2 | ((blk == i ? 1 : 0) << 4); TL[4 * tid + 2] = 2 * 256 + g * 64; }
                    else { const int j = tid - nsel; blk = i - j; info = 3 | ((j == 0 ? 1 : (j == 8 ? 2 : 0)) << 4); TL[4 * tid + 2] = 4 * 256 + g * 64; }
                    TL[4 * tid] = info; TL[4 * tid + 1] = rowbase + 64 * blk; TL[4 * tid + 3] = 64 * blk; }
                __syncthreads();
                mymask = MK[qloc]; }
            if (hi == 0) wsf[r32] = GATE(0);
            WSYNC();
            { const LAS float* wsb = wsf + 4 * hi; LAS float* otp = otw; OPAQUE_PTR(wsb); OPAQUE_PTR(otp);
#pragma unroll
            for (int r = 0; r < 16; ++r) { const int ro = (r & 3) + 8 * (r >> 2); const float fr = wsb[ro]; otp[64 * ro] = o0[r] * fr; otp[64 * ro + 32] = o1[r] * fr; o0[r] = 0.f; o1[r] = 0.f; } }
            WSYNC();
        }
        v4u kreg, vreg;
        { const int info = TL[0], row0 = TL[1], col = TL[2]; const bf16* src = (info & 256) ? P.KC : P.KVB; const int stride = (info & 256) ? 512 : 1536;
            kreg = *(const v4u*)(src + (size_t)(row0 + lane) * stride + col + 8 * wave);
            vreg = *(const v4u*)(src + (size_t)(row0 + 16 * (wave & 3) + (lane >> 2)) * stride + col + 256 + (wave >> 2) * 32 + (lane & 3) * 8);
            *(LAS v4u*)(lds + A_KS + wave * 1024 + lane * 16) = kreg; *(LAS v4u*)(lds + A_VS + wave * 1024 + lane * 16) = vreg; }
        __syncthreads();
#pragma unroll 1
        for (int t = 0; t < NT; ++t) {
            const int slot = (t & 1) * 8192;
            if (t + 1 < NT) { const int info = TL[4 * (t + 1)], row0 = TL[4 * (t + 1) + 1], col = TL[4 * (t + 1) + 2]; const bf16* src = (info & 256) ? P.KC : P.KVB; const int stride = (info & 256) ? 512 : 1536;
                kreg = *(const v4u*)(src + (size_t)(row0 + lane) * stride + col + 8 * wave);
                vreg = *(const v4u*)(src + (size_t)(row0 + 16 * (wave & 3) + (lane >> 2)) * stride + col + 256 + (wave >> 2) * 32 + (lane & 3) * 8); }
            const int info = __builtin_amdgcn_readfirstlane(TL[4 * t]), kp0 = __builtin_amdgcn_readfirstlane(TL[4 * t + 3]);
            const int br = info & 15, mkind = (info >> 4) & 15;
            if (br != curbr) {
                if (curbr == 0) { const float lt = pl32_sum(l_run); invl = (qpos >= 31 && lt > 0.f) ? 1.0f / lt : 0.f; }
                else { float f;
                    if (curbr == 1) f = GATE(0); else { const float lt = pl32_sum(l_run); f = GATE(curbr - 1) / lt; }
                    if (hi == 0) wsf[r32] = f;
                    WSYNC();
                    { const LAS float* wsb = wsf + 4 * hi; LAS float* otp = otw; OPAQUE_PTR(wsb); OPAQUE_PTR(otp);
#pragma unroll
                    for (int r = 0; r < 16; ++r) { const int ro = (r & 3) + 8 * (r >> 2); const float fr = wsb[ro]; otp[64 * ro] += o0[r] * fr; otp[64 * ro + 32] += o1[r] * fr; o0[r] = 0.f; o1[r] = 0.f; } }
                    WSYNC();
                    m_run = MFLOOR; l_run = 0.f; }
                curbr = br; }
            const float sk = (br < 2) ? 16.f * slope : slope;
            float tb = slope * (float)((br < 2 ? 16 * kp0 + 31 : kp0) - pos0);
            if (br == 2 && !((mymask >> (kp0 >> 6)) & 1u)) tb = -INFINITY;
            const float tbh = tb + sk * (float)(4 * hi);
            f32x16 p0, p1;
#pragma unroll
            for (int r = 0; r < 16; ++r) { p0[r] = tbh + sk * (float)((r & 3) + 8 * (r >> 2)); p1[r] = p0[r] + 32.f * sk; }
            asm volatile("" ::: "memory"); qkt(p0, p1, lds + A_KS + slot, qr, r32, hi); asm volatile("" ::: "memory");
            if (mkind) { int klo = -1, khi = 64;
                if (br < 2) khi = (qpos >= 31 ? (qpos - 31) >> 4 : -1) - kp0; else if (mkind == 1) khi = qpos - kp0; else klo = qpos - 512 - kp0;
                const float khf = (float)(khi - 4 * hi) + 0.5f, klf = (float)(klo - 4 * hi) + 0.5f;
#pragma unroll
                for (int r = 0; r < 16; ++r) { const float k = (float)((r & 3) + 8 * (r >> 2));
                    p0[r] += 1e30f * (fminf(khf - k, 0.f) + fminf(k - klf, 0.f));
                    p1[r] += 1e30f * (fminf(khf - (k + 32.f), 0.f) + fminf((k + 32.f) - klf, 0.f)); } }
            if (br != 1) {
                const float rm = rowmax32(p0, p1);
                if (__any(rm > m_run)) { const float mn = fmaxf(m_run, rm); const float alpha = __builtin_amdgcn_exp2f((m_run - mn) * LOG2E); l_run *= alpha; m_run = mn;
                    if (br != 0) { if (hi == 0) wsf[r32] = alpha;
                        WSYNC();
                        { const LAS float* wsb = wsf + 4 * hi; OPAQUE_PTR(wsb);
#pragma unroll
                        for (int r = 0; r < 16; ++r) { const float fr = wsb[(r & 3) + 8 * (r >> 2)]; o0[r] *= fr; o1[r] *= fr; } }
                        WSYNC(); } } }
            const float mL = m_run * LOG2E; float sacc = 0.f;
#pragma unroll
            for (int r = 0; r < 16; ++r) { p0[r] = __builtin_amdgcn_exp2f(p0[r] * LOG2E - mL); p1[r] = __builtin_amdgcn_exp2f(p1[r] * LOG2E - mL); sacc += p0[r] + p1[r]; }
            if (br == 0) l_run += sacc;
            else {
                if (br == 1) {
#pragma unroll
                    for (int r = 0; r < 16; ++r) { p0[r] *= invl; p1[r] *= invl; }
                    const int sb = (kp0 >> 2) + hi;
                    LAS float* ia = IA + (n * 32 + sb) * 64 + qloc; LAS float* ib = IB + (n * 32 + sb + 1) * 64 + qloc; OPAQUE_PTR(ia); OPAQUE_PTR(ib);
#pragma unroll
                    for (int k4 = 0; k4 < 4; ++k4) { const int s0 = sb + 2 * k4, s1 = s0 + 8;
                        const float a0 = (p0[4 * k4] + p0[4 * k4 + 1]) + (p0[4 * k4 + 2] + p0[4 * k4 + 3]), a1 = (p1[4 * k4] + p1[4 * k4 + 1]) + (p1[4 * k4 + 2] + p1[4 * k4 + 3]);
                        ia[2 * k4 * 64] = a0; ia[(2 * k4 + 8) * 64] = a1;
                        if (s0 + 1 < 32) ib[2 * k4 * 64] = p0[4 * k4 + 3];
                        if (s1 + 1 < 32) ib[(2 * k4 + 8) * 64] = p1[4 * k4 + 3]; } }
                else l_run += sacc;
                bf16x8 pa[4];
                { v4u w;
                    w.x = cvtpk(p0[0], p0[1]); w.y = cvtpk(p0[2], p0[3]); w.z = cvtpk(p0[4], p0[5]); w.w = cvtpk(p0[6], p0[7]); pa[0] = __builtin_bit_cast(bf16x8, w);
                    w.x = cvtpk(p0[8], p0[9]); w.y = cvtpk(p0[10], p0[11]); w.z = cvtpk(p0[12], p0[13]); w.w = cvtpk(p0[14], p0[15]); pa[1] = __builtin_bit_cast(bf16x8, w);
                    w.x = cvtpk(p1[0], p1[1]); w.y = cvtpk(p1[2], p1[3]); w.z = cvtpk(p1[4], p1[5]); w.w = cvtpk(p1[6], p1[7]); pa[2] = __builtin_bit_cast(bf16x8, w);
                    w.x = cvtpk(p1[8], p1[9]); w.y = cvtpk(p1[10], p1[11]); w.z = cvtpk(p1[12], p1[13]); w.w = cvtpk(p1[14], p1[15]); pa[3] = __builtin_bit_cast(bf16x8, w); }
                asm volatile("" ::: "memory"); pv(o0, o1, vp_l + slot, pa); asm volatile("" ::: "memory"); }
            if (t + 1 < NT) { const int ns = ((t + 1) & 1) * 8192; *(LAS v4u*)(lds + A_KS + ns + wave * 1024 + lane * 16) = kreg; *(LAS v4u*)(lds + A_VS + ns + wave * 1024 + lane * 16) = vreg; }
            __syncthreads();
        }
        if (seq == 0) { m_run = MFLOOR; l_run = 0.f; curbr = 2; }
    }
    { const float lt = pl32_sum(l_run); const float f = GATE(2) / lt;
        if (hi == 0) wsf[r32] = f;
        WSYNC();
        LAS bf16* stg = (LAS bf16*)(lds + A_OST) + wave * 2048;
        { const LAS float* wsb = wsf + 4 * hi; const LAS float* otp = otw; LAS bf16* sb2 = stg + 256 * hi + r32; OPAQUE_PTR(wsb); OPAQUE_PTR(otp); OPAQUE_PTR(sb2);
#pragma unroll
        for (int r = 0; r < 16; ++r) { const int ro = (r & 3) + 8 * (r >> 2); const float fr = wsb[ro];
            sb2[64 * ro] = (bf16)f2bf(otp[64 * ro] + o0[r] * fr); sb2[64 * ro + 32] = (bf16)f2bf(otp[64 * ro + 32] + o1[r] * fr); } }
        WSYNC();
        bf16* Ow = P.OB + (size_t)(rowbase + pos0 + 32 * qh) * 1024 + (4 * g + n) * 64;
#pragma unroll
        for (int k = 0; k < 4; ++k) { const int row = k * 8 + (lane >> 3), ch = lane & 7; const v4u v = *(const LAS v4u*)(stg + row * 64 + ch * 8); *(v4u*)(Ow + (size_t)row * 1024 + ch * 8) = v; } }
    __syncthreads();
#undef GATE
}

constexpr int S_OACC = 0, S_ML = 8192, S_IA = 10240, S_IB = S_IA + 4 * 260 * 8 * 4, S_IMP = S_IB + 4 * 260 * 8 * 4, S_FLAG = S_IMP + 8 * 264 * 4, S_LIST = S_FLAG + 264 * 4, S_WSF = S_LIST + 264 * 4, S_END = S_WSF + 2048;
static_assert(S_END <= 131072, "sample attention LDS map");
__device__ __forceinline__ bf16x8 ldfrag8(bool bf, const char* base, int boff) {
    if (bf) return __builtin_bit_cast(bf16x8, *(const v4u*)(base + boff));
    const f32x4 a = *(const f32x4*)(base + boff), c = *(const f32x4*)(base + boff + 16);
    v4u w; w.x = cvtpk(a[0], a[1]); w.y = cvtpk(a[2], a[3]); w.z = cvtpk(c[0], c[1]); w.w = cvtpk(c[2], c[3]); return __builtin_bit_cast(bf16x8, w);
}
struct SampP { const bf16* QB; const bf16* KVB; const bf16* KCS; const float* GT; const float* cache; const float* swin; const int* pt; bf16* OB; };
__device__ __forceinline__ void samp_tile(int mode, bool bf, const void* kb, int stride, int kmax, float tb, float sk, int klo, int khi, const bf16x8 (&qr)[4],
        float& m_run, float& l_run, float invl, f32x16& o0, f32x16& o1, LAS float* wsf, LAS float* ia, LAS float* ib, int sblk0, int r32, int hi) {
    f32x16 p0, p1;
    { const float tbh = tb + sk * (float)(4 * hi);
#pragma unroll
        for (int r = 0; r < 16; ++r) { p0[r] = tbh + sk * (float)((r & 3) + 8 * (r >> 2)); p1[r] = p0[r] + 32.f * sk; } }
    const char* kbu; { const unsigned long long a = (unsigned long long)kb; const unsigned lo_ = __builtin_amdgcn_readfirstlane((unsigned)a), hi_ = __builtin_amdgcn_readfirstlane((unsigned)(a >> 32)); kbu = (const char*)(((unsigned long long)hi_ << 32) | lo_); }
    const int esz = bf ? 2 : 4; const int strideB = stride * esz;
    bf16x8 kf[8]; unsigned vw[2][4][4];
    { const int lofs = r32 * strideB + 8 * hi * esz;
#pragma unroll
        for (int d0 = 0; d0 < 4; ++d0) { kf[2 * d0] = ldfrag8(bf, kbu + 16 * d0 * esz, lofs); kf[2 * d0 + 1] = ldfrag8(bf, kbu + 32 * strideB + 16 * d0 * esz, lofs); } }
    if (mode != 1) {
#pragma unroll
        for (int d0 = 0; d0 < 2; ++d0) { const int vofs = 4 * hi * strideB + (256 + 32 * d0 + r32) * esz;
            if (bf) {
#pragma unroll
                for (int ks = 0; ks < 4; ++ks)
#pragma unroll
                    for (int jj = 0; jj < 4; ++jj) { const int ka = 16 * ks + 8 * (jj >> 1) + 2 * (jj & 1);
                        vw[d0][ks][jj] = (unsigned)*(const bf16*)(kbu + ka * strideB + vofs) | ((unsigned)*(const bf16*)(kbu + (ka + 1) * strideB + vofs) << 16); } }
            else {
#pragma unroll
                for (int ks = 0; ks < 4; ++ks)
#pragma unroll
                    for (int jj = 0; jj < 4; ++jj) { const int ka = 16 * ks + 8 * (jj >> 1) + 2 * (jj & 1);
                        vw[d0][ks][jj] = cvtpk(*(const float*)(kbu + ka * strideB + vofs), *(const float*)(kbu + (ka + 1) * strideB + vofs)); } } } }
#pragma unroll
    for (int d0 = 0; d0 < 4; ++d0) { p0 = __builtin_amdgcn_mfma_f32_32x32x16_bf16(kf[2 * d0], qr[d0], p0, 0, 0, 0); p1 = __builtin_amdgcn_mfma_f32_32x32x16_bf16(kf[2 * d0 + 1], qr[d0], p1, 0, 0, 0); }
    { const float khf = (float)(khi - 4 * hi) + 0.5f, klf = (float)(klo - 4 * hi) + 0.5f;
#pragma unroll
        for (int r = 0; r < 16; ++r) { const float k = (float)((r & 3) + 8 * (r >> 2));
            p0[r] += 1e30f * (fminf(khf - k, 0.f) + fminf(k - klf, 0.f));
            p1[r] += 1e30f * (fminf(khf - (k + 32.f), 0.f) + fminf((k + 32.f) - klf, 0.f)); } }
    if (mode != 2) { const float rm = rowmax32(p0, p1);
        if (__any(rm > m_run)) { const float mn = fmaxf(m_run, rm); const float alpha = __builtin_amdgcn_exp2f((m_run - mn) * LOG2E); l_run *= alpha; m_run = mn;
            if (mode == 0) { if (hi == 0) wsf[r32] = alpha;
                WSYNC();
                { const LAS float* wsb = wsf + 4 * hi; OPAQUE_PTR(wsb);
#pragma unroll
                for (int r = 0; r < 16; ++r) { const float fr = wsb[(r & 3) + 8 * (r >> 2)]; o0[r] *= fr; o1[r] *= fr; } }
                WSYNC(); } } }
    const float mL = m_run * LOG2E; float sacc = 0.f;
#pragma unroll
    for (int r = 0; r < 16; ++r) { p0[r] = __builtin_amdgcn_exp2f(p0[r] * LOG2E - mL); p1[r] = __builtin_amdgcn_exp2f(p1[r] * LOG2E - mL); sacc += p0[r] + p1[r]; }
    if (mode == 1) { l_run += sacc; return; }
    if (mode == 0) l_run += sacc;
    else {
#pragma unroll
        for (int r = 0; r < 16; ++r) { p0[r] *= invl; p1[r] *= invl; }
        LAS float* iap = ia + (sblk0 + hi) * 8; LAS float* ibp = ib + (sblk0 + hi + 1) * 8; OPAQUE_PTR(iap); OPAQUE_PTR(ibp);
#pragma unroll
        for (int k4 = 0; k4 < 4; ++k4) {
            iap[2 * k4 * 8] = (p0[4 * k4] + p0[4 * k4 + 1]) + (p0[4 * k4 + 2] + p0[4 * k4 + 3]); iap[(2 * k4 + 8) * 8] = (p1[4 * k4] + p1[4 * k4 + 1]) + (p1[4 * k4 + 2] + p1[4 * k4 + 3]);
            ibp[2 * k4 * 8] = p0[4 * k4 + 3]; ibp[(2 * k4 + 8) * 8] = p1[4 * k4 + 3]; } }
    bf16x8 pa[4];
    { v4u w;
        w.x = cvtpk(p0[0], p0[1]); w.y = cvtpk(p0[2], p0[3]); w.z = cvtpk(p0[4], p0[5]); w.w = cvtpk(p0[6], p0[7]); pa[0] = __builtin_bit_cast(bf16x8, w);
        w.x = cvtpk(p0[8], p0[9]); w.y = cvtpk(p0[10], p0[11]); w.z = cvtpk(p0[12], p0[13]); w.w = cvtpk(p0[14], p0[15]); pa[1] = __builtin_bit_cast(bf16x8, w);
        w.x = cvtpk(p1[0], p1[1]); w.y = cvtpk(p1[2], p1[3]); w.z = cvtpk(p1[4], p1[5]); w.w = cvtpk(p1[6], p1[7]); pa[2] = __builtin_bit_cast(bf16x8, w);
        w.x = cvtpk(p1[8], p1[9]); w.y = cvtpk(p1[10], p1[11]); w.z = cvtpk(p1[12], p1[13]); w.w = cvtpk(p1[14], p1[15]); pa[3] = __builtin_bit_cast(bf16x8, w); }
#pragma unroll
    for (int d0 = 0; d0 < 2; ++d0)
#pragma unroll
        for (int ks = 0; ks < 4; ++ks) { const v4u w = {vw[d0][ks][0], vw[d0][ks][1], vw[d0][ks][2], vw[d0][ks][3]}; const bf16x8 B = __builtin_bit_cast(bf16x8, w);
            if (d0 == 0) o0 = __builtin_amdgcn_mfma_f32_32x32x16_bf16(pa[ks], B, o0, 0, 0, 0); else o1 = __builtin_amdgcn_mfma_f32_32x32x16_bf16(pa[ks], B, o1, 0, 0, 0); }
}
__device__ __forceinline__ float samp_merge(LAS float* ML, float m_run, float l_run, int wave, int r32, int hi, float& M, float& Linv) {
    const float lt = pl32_sum(l_run);
    __syncthreads();
    if (hi == 0) *(LAS f32x2v*)(ML + (wave * 32 + r32) * 2) = (f32x2v){m_run, lt};
    __syncthreads();
    float mm = MFLOOR; f32x2v e[8];
#pragma unroll
    for (int w = 0; w < 8; ++w) { e[w] = *(const LAS f32x2v*)(ML + (w * 32 + r32) * 2); mm = fmaxf(mm, e[w].x); }
    float L = 0.f;
#pragma unroll
    for (int w = 0; w < 8; ++w) L += e[w].y * __builtin_amdgcn_exp2f((e[w].x - mm) * LOG2E);
    M = mm; Linv = L > 0.f ? 1.0f / L : 0.f;
    return __builtin_amdgcn_exp2f((m_run - mm) * LOG2E) * Linv;
}
__device__ __forceinline__ void samp_accum(LAS float* OA, LAS float* wsf, float f, f32x16& o0, f32x16& o1, int r32, int hi) {
    if (hi == 0) wsf[r32] = f;
    WSYNC();
    { const LAS float* wsb = wsf + 4 * hi; LAS float* oa = OA + 256 * hi + r32; OPAQUE_PTR(wsb); OPAQUE_PTR(oa);
#pragma unroll
    for (int r = 0; r < 16; ++r) { const float fr = wsb[(r & 3) + 8 * (r >> 2)]; const int ro = ((r & 3) + 8 * (r >> 2)) * 64;
        __hip_atomic_fetch_add(oa + ro, o0[r] * fr, __ATOMIC_RELAXED, __HIP_MEMORY_SCOPE_WORKGROUP); __hip_atomic_fetch_add(oa + ro + 32, o1[r] * fr, __ATOMIC_RELAXED, __HIP_MEMORY_SCOPE_WORKGROUP); o0[r] = 0.f; o1[r] = 0.f; } }
    WSYNC();
}
__device__ __forceinline__ void attn_sample_item(const SampP& P, int b, int g, LAS unsigned char* lds, int tid, int wave, int lane, int nsteps = 4) {
    const int r32 = lane & 31, hi = lane >> 5, n = r32 >> 3, t = r32 & 7, row = MP + b * DEC_T + t;
    LAS float* OA = (LAS float*)(lds + S_OACC); LAS float* ML = (LAS float*)(lds + S_ML); LAS float* IA = (LAS float*)(lds + S_IA); LAS float* IB = (LAS float*)(lds + S_IB);
    LAS float* IMP = (LAS float*)(lds + S_IMP); LAS unsigned* FLAG = (LAS unsigned*)(lds + S_FLAG); LAS int* LIST = (LAS int*)(lds + S_LIST); LAS float* wsf = (LAS float*)(lds + S_WSF) + wave * 64;
    bf16x8 qr[4];
#pragma unroll
    for (int d0 = 0; d0 < 4; ++d0) { const v4u w = *(const v4u*)(P.QB + (size_t)row * 1024 + (4 * g + n) * 64 + 16 * d0 + 8 * hi);
        v4u o; o.x = cvtpk(__uint_as_float(w.x << 16) * 0.125f, __uint_as_float(w.x & 0xffff0000u) * 0.125f); o.y = cvtpk(__uint_as_float(w.y << 16) * 0.125f, __uint_as_float(w.y & 0xffff0000u) * 0.125f);
        o.z = cvtpk(__uint_as_float(w.z << 16) * 0.125f, __uint_as_float(w.z & 0xffff0000u) * 0.125f); o.w = cvtpk(__uint_as_float(w.w << 16) * 0.125f, __uint_as_float(w.w & 0xffff0000u) * 0.125f);
        qr[d0] = __builtin_bit_cast(bf16x8, o); }
    const float slope = exp2f(-0.5f * (float)(4 * g + n + 1));
    const int gi = vgpr_i(row * 64 + 4 * g + n); const float gate0 = P.GT[gi], gate1 = P.GT[gi + 16], gate2 = P.GT[gi + 32];
    for (int j = tid; j < 2048; j += NWAVES * 64) OA[j] = 0.f;
    for (int j = tid; j < 264; j += NWAVES * 64) FLAG[j] = 0u;
    f32x16 o0, o1;
#pragma unroll
    for (int r = 0; r < 16; ++r) { o0[r] = 0.f; o1[r] = 0.f; }
    float m_run = MFLOOR, l_run = 0.f, M = 0.f, Linv = 0.f;
    const bf16* kc = P.KCS + (size_t)b * NCP_S * 512 + g * 64;
    LAS float* ia = IA + n * 260 * 8 + t; LAS float* ib = IB + n * 260 * 8 + t;
    const bf16* newk = P.KVB + (size_t)(MP + b * DEC_T) * 1536 + g * 64;
#pragma unroll 1
    for (int step = 0; step < nsteps; ++step) {
        const int nt = (step < 2) ? 16 : (step == 2 ? LIST[0] : 9);
#pragma unroll 1
        for (int e = wave; e < nt; e += 8) {
            int mode = 0, stride = 1536, kmax = 63, klo = -1, khi = 64, sblk0 = 0; bool bf = true; const void* kb; float tb, sk = slope;
            if (step < 2) { mode = step + 1; kb = kc + (size_t)64 * e * 512; stride = 512; tb = slope * (float)(16 * 64 * e + 31 - PAST); sk = 16.f * slope; khi = NC_S - 1 - 64 * e; sblk0 = 16 * e; }
            else if (step == 2) { const int blk = __builtin_amdgcn_readfirstlane(LIST[1 + e]); const bool mine = (FLAG[blk] >> t) & 1u;
                if (blk == 256) { kb = newk + 2 * 256; kmax = DEC_T - 1; khi = t; tb = mine ? 0.f : -INFINITY; }
                else { const int kp0 = blk * 64; const int phys = P.pt[b * NPAGES + (kp0 >> 7)]; kb = P.cache + ((size_t)phys * PAGE + (kp0 & (PAGE - 1))) * 1024 + 2 * 256 + g * 64; bf = false; stride = 1024; tb = mine ? slope * (float)(kp0 - PAST) : -INFINITY; } }
            else if (e < 8) { kb = P.swin + (size_t)b * 512 * 512 + (size_t)(64 * e) * 512 + g * 64; bf = false; stride = 512; tb = slope * (float)(64 * e - 512); if (e == 0) klo = t; }
            else { kb = newk + 4 * 256; kmax = DEC_T - 1; khi = t; tb = 0.f; }
            samp_tile(mode, bf, kb, stride, kmax, tb, sk, klo, khi, qr, m_run, l_run, Linv, o0, o1, wsf, ia, ib, sblk0, r32, hi);
        }
        if (step == 0) { (void)samp_merge(ML, m_run, l_run, wave, r32, hi, M, Linv); m_run = M; }
        else if (step == 1) {
            samp_accum(OA, wsf, gate0, o0, o1, r32, hi);
            __syncthreads();
            { const int tt = wave; LAS float* imp = IMP + tt * 264;
                for (int s = lane; s < 257; s += 64) { float v = -1.f;
                    if (s >= 1 && s <= 254) { v = 0.f;
#pragma unroll
                        for (int nn = 0; nn < 4; ++nn) v += IA[(nn * 260 + s) * 8 + tt] + IB[(nn * 260 + s) * 8 + tt]; }
                    imp[s] = v; }
                WSYNC();
                if (lane == 0) { __hip_atomic_fetch_or(FLAG, 1u << tt, __ATOMIC_RELAXED, __HIP_MEMORY_SCOPE_WORKGROUP); __hip_atomic_fetch_or(FLAG + 255, 1u << tt, __ATOMIC_RELAXED, __HIP_MEMORY_SCOPE_WORKGROUP); __hip_atomic_fetch_or(FLAG + 256, 1u << tt, __ATOMIC_RELAXED, __HIP_MEMORY_SCOPE_WORKGROUP); }
#pragma unroll 1
                for (int it = 0; it < 13; ++it) { float bv = -3.f; int bi = 1 << 30;
                    for (int s = lane; s < 257; s += 64) { const float v = imp[s]; if (v > bv) { bv = v; bi = s; } }
#pragma unroll
                    for (int o = 1; o < 64; o <<= 1) { const float ov = __shfl_xor(bv, o); const int oi = __shfl_xor(bi, o); if (ov > bv || (ov == bv && oi < bi)) { bv = ov; bi = oi; } }
                    if (bv < 0.f) break;
                    if (lane == 0) { __hip_atomic_fetch_or(FLAG + bi, 1u << tt, __ATOMIC_RELAXED, __HIP_MEMORY_SCOPE_WORKGROUP); imp[bi] = -2.f; }
                    WSYNC(); } }
            __syncthreads();
            if (wave == 0) { int cnt = 0;
                for (int s0 = 0; s0 < 257; s0 += 64) { const int s = s0 + lane; const bool on = s < 257 && FLAG[s] != 0u; const unsigned long long bal = __ballot(on);
                    if (on) LIST[1 + cnt + __builtin_popcountll(bal & ((1ull << lane) - 1ull))] = s;
                    cnt += __builtin_popcountll(bal); }
                if (lane == 0) LIST[0] = cnt; }
            __syncthreads();
            m_run = MFLOOR; l_run = 0.f; }
        else { const float f = samp_merge(ML, m_run, l_run, wave, r32, hi, M, Linv);
            samp_accum(OA, wsf, (step == 2 ? gate1 : gate2) * f, o0, o1, r32, hi);
            m_run = MFLOOR; l_run = 0.f; }
    }
    __syncthreads();
    if (nsteps == 4) { const int rr = tid >> 4, d4 = (tid & 15) * 4, nn = rr >> 3, tt = rr & 7; const f32x4 v = *(const LAS f32x4*)(OA + rr * 64 + d4);
        unsigned long long w = (unsigned long long)cvtpk(v[0], v[1]) | ((unsigned long long)cvtpk(v[2], v[3]) << 32);
        *(unsigned long long*)(P.OB + (size_t)(MP + b * DEC_T + tt) * 1024 + (4 * g + nn) * 64 + d4) = w; }
    __syncthreads();
}
}
namespace skinny {
typedef float f32x16 __attribute__((ext_vector_type(16)));
template <int NB, class F> __device__ __forceinline__ void item(const bf16* A, int K, const bf16* B0, const bf16* B1, LAS float* red, int tid, int wave, int lane, const F& epi) {
    const int r32 = lane & 31, hi = lane >> 5, kw = K >> 3;
    const bf16* ap = A + (size_t)r32 * K + wave * kw + 8 * hi; const bf16* b0p = B0 + (size_t)r32 * K + wave * kw + 8 * hi; const bf16* b1p = B1 + (size_t)r32 * K + wave * kw + 8 * hi;
    f32x16 acc0, acc1;
#pragma unroll
    for (int r = 0; r < 16; ++r) { acc0[r] = 0.f; acc1[r] = 0.f; }
    for (int j = tid; j < NB * 1024; j += NWAVES * 64) red[j] = 0.f;
#pragma unroll 8
    for (int ks = 0; ks < kw / 16; ++ks) { const bf16x8 a = *(const bf16x8*)(ap + 16 * ks), b0 = *(const bf16x8*)(b0p + 16 * ks);
        acc0 = __builtin_amdgcn_mfma_f32_32x32x16_bf16(a, b0, acc0, 0, 0, 0);
        if (NB == 2) { const bf16x8 b1 = *(const bf16x8*)(b1p + 16 * ks); acc1 = __builtin_amdgcn_mfma_f32_32x32x16_bf16(a, b1, acc1, 0, 0, 0); } }
    __syncthreads();
    { LAS float* rp = red + 128 * hi + r32; asm volatile("" : "+v"(rp));
#pragma unroll
        for (int r = 0; r < 16; ++r) { const int ro = ((r & 3) + 8 * (r >> 2)) * 32;
            __hip_atomic_fetch_add(rp + ro, acc0[r], __ATOMIC_RELAXED, __HIP_MEMORY_SCOPE_WORKGROUP);
            if (NB == 2) __hip_atomic_fetch_add(rp + 1024 + ro, acc1[r], __ATOMIC_RELAXED, __HIP_MEMORY_SCOPE_WORKGROUP); } }
    __syncthreads();
    if (tid < 256) { const int row = tid >> 3, c4 = (tid & 7) * 4; const f32x4 v0 = *(const LAS f32x4*)(red + row * 32 + c4); f32x4 v1 = {0.f, 0.f, 0.f, 0.f};
        if (NB == 2) v1 = *(const LAS f32x4*)(red + 1024 + row * 32 + c4);
        epi(row, c4, v0, v1); }
    __syncthreads();
}
__device__ __forceinline__ f32x4 ld4bf(const bf16* p) { const unsigned long long w = *(const unsigned long long*)p; return (f32x4){__uint_as_float((unsigned)w << 16), __uint_as_float((unsigned)w & 0xffff0000u), __uint_as_float((unsigned)(w >> 32) << 16), __uint_as_float((unsigned)(w >> 32) & 0xffff0000u)}; }
__device__ __forceinline__ void st4bf(bf16* p, f32x4 v) { *(unsigned long long*)p = (unsigned long long)pg8::cvt_pk_bf16(v[0], v[1]) | ((unsigned long long)pg8::cvt_pk_bf16(v[2], v[3]) << 32); }
__device__ __forceinline__ float rowsum8(float s) { s += __shfl_xor(s, 1); s += __shfl_xor(s, 2); s += __shfl_xor(s, 4); return s; }
struct EGlu { const bf16* MG; bf16* MB; int r0, col0;
    __device__ __forceinline__ void operator()(int row, int c4, f32x4 v0, f32x4 v1) const { const int r = r0 + row, col = col0 + c4;
        st4bf(MB + (size_t)r * 2048 + col, v0 * epi::sigm4(v1) * ld4bf(MG + (size_t)r * 4096 + 2048 + col)); } };
struct EAttnOut { const bf16* MG; bf16* MB; int r0, col0;
    __device__ __forceinline__ void operator()(int row, int c4, f32x4 v0, f32x4) const { const int r = r0 + row, col = col0 + c4;
        st4bf(MB + (size_t)r * 2048 + col, ld4bf(MB + (size_t)r * 2048 + col) + ld4bf(MG + (size_t)r * 4096 + col) * v0); } };
struct EWout { const float* xs; float* X2; bf16* XN; float* ss; int r0, col0; int lane;
    __device__ __forceinline__ void operator()(int row, int c4, f32x4 v0, f32x4) const { const int r = r0 + row, col = col0 + c4;
        const f32x4 x2 = v0 + *(const f32x4*)(xs + (size_t)(r - MP) * 2048 + col); *(f32x4*)(X2 + (size_t)r * 2048 + col) = x2; st4bf(XN + (size_t)r * 2048 + col, x2);
        const float s = rowsum8((x2[0] * x2[0] + x2[1] * x2[1]) + (x2[2] * x2[2] + x2[3] * x2[3])); if ((lane & 7) == 0) atomicAdd(ss + r, s); } };
struct EDown { const float* X2; float* Y; float* ss; int r0, col0; int lane;
    __device__ __forceinline__ void operator()(int row, int c4, f32x4 v0, f32x4) const { const int r = r0 + row, col = col0 + c4;
        const f32x4 y = v0 + *(const f32x4*)(X2 + (size_t)r * 2048 + col); *(f32x4*)(Y + (size_t)r * 2048 + col) = y;
        const float s = rowsum8((y[0] * y[0] + y[1] * y[1]) + (y[2] * y[2] + y[3] * y[3])); if ((lane & 7) == 0) atomicAdd(ss + r, s); } };
}
#ifndef MK_N_LAUNCHES
#define MK_N_LAUNCHES 1
#endif
constexpr int N_PHASES = 10;
#ifndef PHASE_MASK
#define PHASE_MASK 0x3ff
#endif
struct Args { const void* in[28]; float* o_; unsigned char* w_; int ph_lo, ph_hi, flags, pad; };
__global__ void __launch_bounds__(NWAVES * 64, 2) mega_fwd(Args args) {
    extern __shared__ __attribute__((aligned(16))) unsigned char lds_raw[];
    LAS unsigned char* lds = (LAS unsigned char*)lds_raw;
    volatile LAS unsigned* MISC = (volatile LAS unsigned*)(lds + MISC_OFF);
    const int tid0 = threadIdx.x, wave = __builtin_amdgcn_readfirstlane(tid0 >> 6);
    const int G = gridDim.x; const int bx = blockIdx.x; const int vcu = (G % 8 == 0) ? (bx % 8) * (G / 8) + bx / 8 : bx;
    const int gw = vcu * NWAVES + wave, NGW = G * NWAVES;
#define ws (args.w_)
#define out (args.o_)
#define ctl ((gu32*)(args.w_ + WS_CTL))
#define x_prompt ((const float*)args.in[0])
#define x_sample ((const float*)args.in[1])
#define cache_kv ((const float*)args.in[2])
#define state_win ((const float*)args.in[3])
#define st_re ((const float*)args.in[4])
#define st_im ((const float*)args.in[5])
#define page_table ((const int*)args.in[6])
#define g_mix ((const float*)args.in[7])
#define w_in ((const float*)args.in[8])
#define cmp_pe ((const float*)args.in[9])
#define cmp_pool ((const float*)args.in[10])
#define cmp_phi ((const float*)args.in[11])
#define w_attn_out ((const float*)args.in[12])
#define SI (SsmIn{(const float*)args.in[13], (const float*)args.in[14], (const float*)args.in[15], (const float*)args.in[16], (const float*)args.in[17], (const float*)args.in[18], (const float*)args.in[19], (const float*)args.in[20]})
#define w_glu ((const float*)args.in[21])
#define w_out ((const float*)args.in[22])
#define g_ffn ((const float*)args.in[23])
#define w_gate ((const float*)args.in[24])
#define w_up ((const float*)args.in[25])
#define w_down ((const float*)args.in[26])
#define g_final ((const float*)args.in[27])
#define WIN ((bf16*)(args.w_ + WS_WIN))
#define WA ((bf16*)(args.w_ + WS_WA))
#define WGLU ((bf16*)(args.w_ + WS_WGLU))
#define WOUT ((bf16*)(args.w_ + WS_WOUT))
#define WGU ((bf16*)(args.w_ + WS_WGU))
#define WDN ((bf16*)(args.w_ + WS_WDN))
#define XN ((bf16*)(args.w_ + WS_XN))
#define RSTD1 ((float*)(args.w_ + WS_RSTD1))
#define QB ((bf16*)(args.w_ + WS_QB))
#define KVB ((bf16*)(args.w_ + WS_KVB))
#define U ((float*)(args.w_ + WS_U))
#define MG ((bf16*)(args.w_ + WS_MG))
#define GT ((float*)(args.w_ + WS_GT))
#define KCP ((bf16*)(args.w_ + WS_KCP))
#define KCS ((bf16*)(args.w_ + WS_KCS))
#define GY ((bf16*)(args.w_ + WS_GY))
#define OB ((bf16*)(args.w_ + WS_OB))
#define MB ((bf16*)(args.w_ + WS_MB))
#define X2 ((float*)(args.w_ + WS_X2))
#define HH ((bf16*)(args.w_ + WS_HH))
#define Y ((float*)(args.w_ + WS_Y))
#define SS2 ((float*)(args.w_ + WS_CTL) + CW_SS2)
#define SS3 ((float*)(args.w_ + WS_CTL) + CW_SS3)

    for (int u = tid0; u < (LDS_BYTES - LDSCTL_OFF) / 4; u += NWAVES * 64) ((LAS unsigned*)(lds + LDSCTL_OFF))[u] = 0u;
    __syncthreads();
    const int lo = args.ph_lo, hi = args.ph_hi;
    XcdBarrier bar; bar.bar = (unsigned*)(ctl + CW_BAR); bar.x = 0; bar.st = nullptr;
    if (hi - lo > 1) bar = xcd_barrier_post((unsigned*)(ctl + CW_BAR), MISC + 8);
#define IN(k) (lo <= (k) && (k) < hi)
#define SEAM(k) do { if (IN(k) && IN((k) + 1)) xcd_barrier(bar); } while (0)

    if (((PHASE_MASK >> 0) & 1) && IN(0)) {
        int tid = threadIdx.x; asm volatile("" : "+v"(tid)); const int lane = tid & 63;
        LAS unsigned* scr = nullptr;
        compress_setup(cmp_pe, cmp_pool, cmp_phi, (LAS float*)(lds + RING_OFF), tid);
        if (!(args.flags & 64)) for (int it = gw; it < DEC_B * 256; it += NGW) { const int b = it >> 8, i = it & 255; compress_item<true, 4>(cache_kv, page_table, b, i, NC_S, KCS + (size_t)b * NCP_S * 512, (LAS float*)(lds + RING_OFF), wave, lane); }
        constexpr int I0 = 32 * 124, I1 = 16 * 32, I2 = 16 * 64, I3 = 32 * 32, I4 = 32 * 176, I5 = 88 * 32, ITOT = I0 + I1 + I2 + I3 + I4 + I5;
        if (!(args.flags & 16)) for (int it = gw; it < ITOT; it += NGW) { int r = it;
            if (r < I0) { const TrJob j{w_in, nullptr, g_mix, WIN, 2048, IN_COLS, NIN, 1}; tr_item(j, r, scr, lane); continue; } r -= I0;
            if (r < I1) { const TrJob j{w_attn_out, nullptr, nullptr, WA, 1024, 2048, 2048, 0}; tr_item(j, r, scr, lane); continue; } r -= I1;
            if (r < I2) { const TrJob j{w_glu, nullptr, nullptr, WGLU, 1024, 4096, 4096, 2}; tr_item(j, r, scr, lane); continue; } r -= I2;
            if (r < I3) { const TrJob j{w_out, nullptr, nullptr, WOUT, 2048, 2048, 2048, 0}; tr_item(j, r, scr, lane); continue; } r -= I3;
            if (r < I4) { const TrJob j{w_gate, w_up, g_ffn, WGU, 2048, DFF, 2 * DFF, 3}; tr_item(j, r, scr, lane); continue; } r -= I4;
            { const TrJob j{w_down, nullptr, nullptr, WDN, DFF, 2048, 2048, 0}; tr_item(j, r, scr, lane); } }
        if (!(args.flags & 32)) for (int m = gw; m < MPAD; m += NGW) xn_row(m < MP ? x_prompt + (size_t)m * D_MODEL : (m < MROWS ? x_sample + (size_t)(m - MP) * D_MODEL : nullptr), XN + (size_t)m * D_MODEL, RSTD1 + m, lane);
        for (int j = vcu * NWAVES * 64 + tid; j < (MPAD - MROWS) * 1536 / 8; j += G * NWAVES * 64) *(GAS v4u*)(KVB + (size_t)MROWS * 1536 + (size_t)j * 8) = (v4u){0u, 0u, 0u, 0u};
        if (vcu == 0) { for (int j = tid; j < DEC_B * 64; j += NWAVES * 64) *(GAS v4u*)(KCS + (size_t)((j >> 6) * NCP_S + 1023) * 512 + 8 * (j & 63)) = (v4u){0u, 0u, 0u, 0u}; }
        for (int i4 = (vcu * NWAVES * 64 + tid); i4 < DEC_B * 504 * 128; i4 += G * NWAVES * 64) { const int b = i4 / (504 * 128), rem = i4 - b * (504 * 128);
            *(GAS f32x4*)(out + O_WINS + (size_t)b * 512 * 512 + (size_t)rem * 4) = *(const GAS f32x4*)(state_win + (size_t)b * 512 * 512 + 8 * 512 + (size_t)rem * 4); }
        __syncthreads();
    }
    SEAM(0);
    if (((PHASE_MASK >> 1) & 1) && IN(1)) {
        int tid = threadIdx.x; asm volatile("" : "+v"(tid)); const int lane = tid & 63;
        pg8::Gemm g{XN, WIN, MPAD, NIN, D_MODEL}; pg8::StaticOrder S; S.init(MPAD, NIN, G, bx);
        epi::EpiInProj E{QB, KVB, U, MG, GT, RSTD1, out};
        pg8::gemm_phase<epi::EpiInProj, pg8::StaticOrder, true, true>(lds + RING_OFF, g, S, E);
    }
    SEAM(1);
    if (((PHASE_MASK >> 2) & 1) && IN(2)) {
        int tid = threadIdx.x; asm volatile("" : "+v"(tid)); const int lane = tid & 63;
#ifndef NO_P2_CMP
        if (vcu < 32) { compress_setup(cmp_pe, cmp_pool, cmp_phi, (LAS float*)(lds + RING_OFF), tid);
            for (int it = gw; it < BATCH * 64; it += NGW) { const int b = it >> 6, i = it & 63; compress_item<false, 2>(out + O_KVP, nullptr, b, i, NC_P, KCP + (size_t)b * NCP_P * 512, (LAS float*)(lds + RING_OFF), wave, lane); } }
#endif
        if (vcu == 32) { for (int j = tid; j < BATCH * 64; j += NWAVES * 64) *(GAS v4u*)(KCP + (size_t)((j >> 6) * NCP_P + 127) * 512 + 8 * (j & 63)) = (v4u){0u, 0u, 0u, 0u}; }
        __syncthreads();
#ifndef NO_P2_SSMP
        if (!(args.flags & 4)) for (int it = vcu; it < BATCH * SSM_NG; it += G) ssm_prompt_item(SI, it >> 6, it & 63, U, GY, out, lds + RING_OFF, wave, lane);
#endif
#ifndef NO_P2_SSMS
        if (!(args.flags & 8)) for (int it = gw; it < DEC_B * SSM_NG; it += NGW) ssm_sample_item(SI, it >> 6, it & 63, U, st_re, st_im, GY, out, lds + RING_OFF, wave, lane);
#endif
        __syncthreads();
    }
    SEAM(2);
    if (((PHASE_MASK >> 3) & 1) && IN(3)) {
        int tid = threadIdx.x; asm volatile("" : "+v"(tid)); const int lane = tid & 63;
#ifdef P3_SIMPLE_SAMPLE
        const AttnP P{QB, KVB, KCP, KCS, GT, cache_kv, state_win, page_table, OB};
        LAS float* W = (LAS float*)(lds + RING_OFF) + wave * AS_WORDS;
        for (int it = gw; it < MS * NKV; it += NGW) attn_item_simple(P, MP + (it >> 2), it & 3, W, lane);
#elif !defined(NO_P3_SAMPLE)
        if (!(args.flags & 2)) { const nsa::SampP SP{QB, KVB, KCS, GT, cache_kv, state_win, page_table, OB};
            for (int it = vcu; it < DEC_B * NKV; it += G) nsa::attn_sample_item(SP, it >> 2, it & 3, lds + RING_OFF, tid, wave, lane, (args.flags >> 8) ? (args.flags >> 8) : 4); }
#endif
#ifndef NO_P3_PROMPT
        if (!(args.flags & 1)) { const nsa::UnitP UP{QB, KVB, KCP, GT, OB}; LAS int* QS = (LAS int*)(lds + nsa::A_UNI + 32);
            for (;;) { if (tid == 0) QS[0] = (int)__hip_atomic_fetch_add(ctl + CW_Q, 1u, RLX_AGENT); __syncthreads(); const int u = QS[0]; __syncthreads(); if (u >= BATCH * NKV * 32) break;
                nsa::attn_prompt_unit(UP, (u & 15) >> 2, u & 3, 31 - (u >> 4), lds + RING_OFF, tid, wave, lane); } }
#endif
        __syncthreads();
    }
    SEAM(3);
    if (((PHASE_MASK >> 4) & 1) && IN(4)) {
        int tid = threadIdx.x; asm volatile("" : "+v"(tid)); const int lane = tid & 63;
        pg8::Gemm g{GY, WGLU, MP, 4096, 1024}; pg8::StaticOrder S; S.init(MP, 4096, G, bx);
        epi::EpiGlu E{MG, MB};
        pg8::gemm_phase<epi::EpiGlu, pg8::StaticOrder, true, true>(lds + RING_OFF, g, S, E);
        for (int it = bx; it < 128; it += G) { const int rh = it & 1, j = it >> 1; const bf16* B0 = WGLU + (size_t)(256 * (j >> 2) + 32 * (j & 3)) * 1024;
            skinny::item<2>(GY + (size_t)(MP + 32 * rh) * 1024, 1024, B0, B0 + 128 * 1024, (LAS float*)(lds + RING_OFF), tid, wave, lane, skinny::EGlu{MG, MB, MP + 32 * rh, 32 * j}); }
    }
    SEAM(4);
    if (((PHASE_MASK >> 5) & 1) && IN(5)) {
        int tid = threadIdx.x; asm volatile("" : "+v"(tid)); const int lane = tid & 63;
        pg8::Gemm g{OB, WA, MP, 2048, 1024}; pg8::StaticOrder S; S.init(MP, 2048, G, bx);
        epi::EpiAttnOut E{MG, MB};
        pg8::gemm_phase<epi::EpiAttnOut, pg8::StaticOrder, true, true>(lds + RING_OFF, g, S, E);
        for (int it = bx; it < 128; it += G) { const int rh = it & 1, j = it >> 1; const bf16* B0 = WA + (size_t)(32 * j) * 1024;
            skinny::item<1>(OB + (size_t)(MP + 32 * rh) * 1024, 1024, B0, B0, (LAS float*)(lds + RING_OFF), tid, wave, lane, skinny::EAttnOut{MG, MB, MP + 32 * rh, 32 * j}); }
    }
    SEAM(5);
    if (((PHASE_MASK >> 6) & 1) && IN(6)) {
        int tid = threadIdx.x; asm volatile("" : "+v"(tid)); const int lane = tid & 63;
        pg8::Gemm g{MB, WOUT, MP, 2048, 2048}; pg8::StaticOrder S; S.init(MP, 2048, G, bx);
        epi::EpiWout E{x_prompt, x_sample, X2, XN, SS2};
        pg8::gemm_phase<epi::EpiWout, pg8::StaticOrder, true, true>(lds + RING_OFF, g, S, E);
        for (int it = bx; it < 128; it += G) { const int rh = it & 1, j = it >> 1; const bf16* B0 = WOUT + (size_t)(32 * j) * 2048;
            skinny::item<1>(MB + (size_t)(MP + 32 * rh) * 2048, 2048, B0, B0, (LAS float*)(lds + RING_OFF), tid, wave, lane, skinny::EWout{x_sample, X2, XN, SS2, MP + 32 * rh, 32 * j, lane}); }
    }
    SEAM(6);
    if (((PHASE_MASK >> 7) & 1) && IN(7)) {
        int tid = threadIdx.x; asm volatile("" : "+v"(tid)); const int lane = tid & 63;
        pg8::Gemm g{XN, WGU, MPAD, 2 * DFF, 2048}; pg8::StaticOrder S; S.init(MPAD, 2 * DFF, G, bx);
        epi::EpiGateUp E{SS2, HH};
        pg8::gemm_phase<epi::EpiGateUp, pg8::StaticOrder, true, true>(lds + RING_OFF, g, S, E);
    }
    SEAM(7);
    if (((PHASE_MASK >> 8) & 1) && IN(8)) {
        int tid = threadIdx.x; asm volatile("" : "+v"(tid)); const int lane = tid & 63;
        pg8::Gemm g{HH, WDN, MP, 2048, DFF}; pg8::StaticOrder S; S.init(MP, 2048, G, bx);
        epi::EpiDown E{X2, Y, SS3};
        pg8::gemm_phase<epi::EpiDown, pg8::StaticOrder, true, true>(lds + RING_OFF, g, S, E);
        for (int it = bx; it < 128; it += G) { const int rh = it & 1, j = it >> 1; const bf16* B0 = WDN + (size_t)(32 * j) * DFF;
            skinny::item<1>(HH + (size_t)(MP + 32 * rh) * DFF, DFF, B0, B0, (LAS float*)(lds + RING_OFF), tid, wave, lane, skinny::EDown{X2, Y, SS3, MP + 32 * rh, 32 * j, lane}); }
    }
    SEAM(8);
    if (((PHASE_MASK >> 9) & 1) && IN(9)) {
        int tid = threadIdx.x; asm volatile("" : "+v"(tid)); const int lane = tid & 63;
        for (int r = gw; r < MROWS; r += NGW) {
            const float rs = 1.0f / sqrtf(SS3[vgpr_i(r)] * (1.0f / D_MODEL) + EPS);
#ifdef EXP_Y_FROM_X2
            const GAS f32x4* yr = (const GAS f32x4*)(X2 + (size_t)r * D_MODEL) + lane;
#else
            const GAS f32x4* yr = (const GAS f32x4*)(Y + (size_t)r * D_MODEL) + lane;
#endif
            const GAS f32x4* gf = (const GAS f32x4*)g_final + lane;
            GAS f32x4* o = (GAS f32x4*)(r < MP ? out + O_YP + (size_t)r * D_MODEL : out + O_YS + (size_t)(r - MP) * D_MODEL) + lane;
#pragma unroll
#ifdef EXP_Y_FROM_BF
            for (int j = 0; j < 8; ++j) { const int col = (4 * (lane + 64 * j)) % EXP_BF_LD; const bf16* sp = EXP_Y_FROM_BF + (size_t)r * EXP_BF_LD + col;
                f32x4 ov = (f32x4){bf2f(sp[0]), bf2f(sp[1]), bf2f(sp[2]), bf2f(sp[3])};
#ifdef EXP_SCRUB_NAN
                for (int e = 0; e < 4; ++e) if (!(ov[e] == ov[e]) || fabsf(ov[e]) > 1e30f) ov[e] = 12345.f;
#endif
                o[64 * j] = ov; }
#elif defined(EXP_ZERO_Y)
            for (int j = 0; j < 8; ++j) o[64 * j] = (f32x4){0.f, 0.f, 0.f, 0.f};
#else
            for (int j = 0; j < 8; ++j) o[64 * j] = yr[64 * j] * rs * gf[64 * j];
#endif
        }
    }
#undef IN
#undef SEAM
#undef ws
#undef out
#undef ctl
#undef x_prompt
#undef x_sample
#undef cache_kv
#undef state_win
#undef st_re
#undef st_im
#undef page_table
#undef g_mix
#undef w_in
#undef cmp_pe
#undef cmp_pool
#undef cmp_phi
#undef w_attn_out
#undef SI
#undef w_glu
#undef w_out
#undef g_ffn
#undef w_gate
#undef w_up
#undef w_down
#undef g_final
#undef WIN
#undef WA
#undef WGLU
#undef WOUT
#undef WGU
#undef WDN
#undef XN
#undef RSTD1
#undef QB
#undef KVB
#undef U
#undef MG
#undef GT
#undef KCP
#undef KCS
#undef GY
#undef OB
#undef MB
#undef X2
#undef HH
#undef Y
#undef SS2
#undef SS3
}

extern "C" void kernel_launch(void* const* d_in, const int* in_sizes, int n_in, void* d_out, int out_size, void* d_ws, size_t ws_size, hipStream_t stream) {
    static int grid = 0;
    if (grid == 0) {
        if (n_in != 28 || ws_size < WS_END) { fprintf(stderr, "kernel_launch: unexpected inputs (n_in %d, ws %zu < %zu)\n", n_in, ws_size, (size_t)WS_END); grid = -1; return; }
        int dev = 0, cus = 0;
        if (hipGetDevice(&dev) != hipSuccess || hipDeviceGetAttribute(&cus, hipDeviceAttributeMultiprocessorCount, dev) != hipSuccess) { grid = -1; return; }
        if (hipFuncSetAttribute((const void*)mega_fwd, hipFuncAttributeMaxDynamicSharedMemorySize, LDS_BYTES) != hipSuccess) { fprintf(stderr, "kernel_launch: hipFuncSetAttribute failed\n"); grid = -1; return; }
        (void)hipGetLastError();
        grid = cus;
    }
    if (grid < 0) return;
    (void)hipMemsetAsync((char*)d_ws + WS_CTL, 0, CTL_ZERO_BYTES, stream);
    Args a{};
    for (int i = 0; i < 28; ++i) a.in[i] = d_in[i];
    a.o_ = (float*)d_out; a.w_ = (unsigned char*)d_ws;
#if MK_N_LAUNCHES == 1
    a.ph_lo = 0; a.ph_hi = N_PHASES;
    hipLaunchKernelGGL(mega_fwd, dim3(grid), dim3(NWAVES * 64), LDS_BYTES, stream, a);
#else
#ifndef EXP_SKIP_LO
#define EXP_SKIP_LO 100
#define EXP_SKIP_HI 100
#endif
#ifndef EXP_DOUBLE
#define EXP_DOUBLE 100
#endif
    for (int ph = 0; ph < N_PHASES; ++ph) { if (ph >= EXP_SKIP_LO && ph <= EXP_SKIP_HI) continue; a.ph_lo = ph; a.ph_hi = ph + 1; hipLaunchKernelGGL(mega_fwd, dim3(grid), dim3(NWAVES * 64), LDS_BYTES, stream, a);
        if (ph == EXP_DOUBLE) { if (ph == 3) (void)hipMemsetAsync((char*)d_ws + WS_CTL + CW_Q * 4, 0, 4, stream);
            if (ph == 6) (void)hipMemsetAsync((char*)d_ws + WS_CTL + CW_SS2 * 4, 0, MPAD * 4, stream);
            if (ph == 8) (void)hipMemsetAsync((char*)d_ws + WS_CTL + CW_SS3 * 4, 0, MPAD * 4, stream);
            if (ph == 5) { a.ph_lo = 4; a.ph_hi = 5; hipLaunchKernelGGL(mega_fwd, dim3(grid), dim3(NWAVES * 64), LDS_BYTES, stream, a); a.ph_lo = 5; a.ph_hi = 6; }
#ifdef EXP_FLAGS
            a.flags = EXP_FLAGS;
#endif
            hipLaunchKernelGGL(mega_fwd, dim3(grid), dim3(NWAVES * 64), LDS_BYTES, stream, a); a.flags = 0; } }
#endif
}
```
